# Optimizing an MI355X kernel written in HIP

```python
import math
import jax
import jax.numpy as jnp
from jax import lax
import numpy as np

D_MODEL = 2048
BATCH = 4
SEQ = 4096
DEPTH = 2

MEM_LEN = 256
MAX_POS_OFFSET = 4096

S5_WIDTH = D_MODEL // 4
S5_CH_PER_GROUP = 16
S5_GROUPS = S5_WIDTH // S5_CH_PER_GROUP
S5_STATE = 64
S5_LAMBDA_RE_MAX = -1e-4

MLA_HEADS = D_MODEL // 256
MLA_NOPE = 128
MLA_ROPE = 64
MLA_V = 128
MLA_Q_RANK = D_MODEL // 4
MLA_KV_RANK = D_MODEL // 4
MLA_WIDTH = MLA_HEADS * MLA_V
ROPE_THETA = 10000.0
Q_BLOCK = 128

GDN_HEADS = D_MODEL // 512
GDN_DK = 128
GDN_DV = 128
GDN_WIDTH = GDN_HEADS * GDN_DV
GDN_QKV = 2 * GDN_HEADS * GDN_DK + GDN_WIDTH
GDN_CONV = 4
GDN_CHUNK = 64

XA_HEADS = 4
XA_DH = 128
XA_WIDTH = XA_HEADS * XA_DH

MOE_GROUPS = 4
MOE_PER_GROUP = 8
MOE_EXPERTS = MOE_GROUPS * MOE_PER_GROUP
MOE_TOPK = 2
MOE_FF = D_MODEL // 4
MOE_ROW_BLOCK = 128

DN_ALPHA = (2 * DEPTH) ** 0.25
DN_BETA = (8 * DEPTH) ** -0.25

IN_SIZES = (S5_WIDTH, MLA_Q_RANK, MLA_KV_RANK, MLA_ROPE,
            GDN_HEADS * GDN_DK, GDN_HEADS * GDN_DK, GDN_WIDTH, GDN_WIDTH,
            GDN_HEADS, GDN_HEADS)
IN_COLS = sum(IN_SIZES)
MIX_WIDTH = S5_WIDTH + MLA_WIDTH + GDN_WIDTH

kernel_name = 'hybrid_s5_mla_gdn_hmoe_deepnorm'


def _rms(x, g, eps=1e-6):
    xf = x.astype(jnp.float32)
    y = xf * lax.rsqrt(jnp.mean(xf * xf, axis=-1, keepdims=True) + eps)
    return (y * g.astype(jnp.float32)).astype(x.dtype)


def _layernorm(x, g, b, eps=1e-5):
    xf = x.astype(jnp.float32)
    mu = jnp.mean(xf, axis=-1, keepdims=True)
    var = jnp.mean(jnp.square(xf - mu), axis=-1, keepdims=True)
    y = (xf - mu) * lax.rsqrt(var + eps)
    return (y * g.astype(jnp.float32) + b.astype(jnp.float32)).astype(x.dtype)


def _l2norm(x, eps=1e-6):
    xf = x.astype(jnp.float32)
    return xf * lax.rsqrt(jnp.sum(xf * xf, axis=-1, keepdims=True) + eps)


def _rope(x, positions):
    rdim = x.shape[-1]
    half = rdim // 2
    inv_freq = 1.0 / (ROPE_THETA ** (jnp.arange(half, dtype=jnp.float32) * (2.0 / rdim)))
    ang = positions.astype(jnp.float32)[..., None] * inv_freq
    ang = ang.reshape(ang.shape[:2] + (1,) * (x.ndim - 3) + (half,))
    cos, sin = jnp.cos(ang), jnp.sin(ang)
    xf = x.astype(jnp.float32)
    x1, x2 = xf[..., :half], xf[..., half:]
    return jnp.concatenate([x1 * cos - x2 * sin, x2 * cos + x1 * sin], axis=-1).astype(x.dtype)


def _split_in_proj(proj):
    idx = np.cumsum(np.array(IN_SIZES))[:-1].tolist()
    return jnp.split(proj, idx, axis=-1)


def _cmul(ar, ai, br, bi):
    return ar * br - ai * bi, ar * bi + ai * br


def _s5_scan(u, lam_re, lam_im, log_step, b_re, b_im, c_re, c_im, d_skip):
    f32 = jnp.float32
    lr = jnp.minimum(lam_re.astype(f32), S5_LAMBDA_RE_MAX)
    li = lam_im.astype(f32)
    dt = jnp.exp(log_step.astype(f32))[:, None]
    mag = jnp.exp(lr * dt)
    ab_re, ab_im = mag * jnp.cos(li * dt), mag * jnp.sin(li * dt)
    den = lr * lr + li * li
    nr, ni = ab_re - 1.0, ab_im
    fr = (nr * lr + ni * li) / den
    fi = (ni * lr - nr * li) / den
    br, bi = b_re.astype(f32), b_im.astype(f32)
    bb_re = fr[..., None] * br - fi[..., None] * bi
    bb_im = fr[..., None] * bi + fi[..., None] * br
    uf = u.astype(f32)
    bu_re = jnp.einsum('bsgh,gph->bsgp', uf, bb_re)
    bu_im = jnp.einsum('bsgh,gph->bsgp', uf, bb_im)
    a_re = jnp.broadcast_to(ab_re, bu_re.shape)
    a_im = jnp.broadcast_to(ab_im, bu_im.shape)

    def combine(e1, e2):
        a1r, a1i, b1r, b1i = e1
        a2r, a2i, b2r, b2i = e2
        ar, ai = _cmul(a2r, a2i, a1r, a1i)
        tr, ti = _cmul(a2r, a2i, b1r, b1i)
        return ar, ai, tr + b2r, ti + b2i

    _, _, xr, xi = lax.associative_scan(combine, (a_re, a_im, bu_re, bu_im), axis=1)
    y = (jnp.einsum('bsgp,ghp->bsgh', xr, c_re.astype(f32))
         - jnp.einsum('bsgp,ghp->bsgh', xi, c_im.astype(f32)))
    y = y + d_skip.astype(f32) * uf
    return y.astype(u.dtype)


def _s5_group(u, lam_re, lam_im, log_step, b_re, b_im, c_re, c_im, d_skip, w_glu, b_glu, g_out):
    bsz, seq, _ = u.shape
    y = _s5_scan(u.reshape(bsz, seq, S5_GROUPS, S5_CH_PER_GROUP),
                 lam_re, lam_im, log_step, b_re, b_im, c_re, c_im, d_skip)
    y = jax.nn.gelu(y.reshape(bsz, seq, S5_WIDTH))
    y = y * jax.nn.sigmoid(y @ w_glu + b_glu)
    return _rms(y, g_out)


def _causal_attention(q, k, v, scale):
    bsz, seq, heads, dk = q.shape
    nb = seq // Q_BLOCK
    qb = jnp.moveaxis(q.reshape(bsz, nb, Q_BLOCK, heads, dk), 1, 0)
    kpos = jnp.arange(seq)

    def one_block(args):
        qi, i = args
        s = jnp.einsum('bqhd,bkhd->bhqk', qi, k).astype(jnp.float32) * scale
        qpos = i * Q_BLOCK + jnp.arange(Q_BLOCK)
        s = jnp.where(kpos[None, :] <= qpos[:, None], s, -jnp.inf)
        p = jax.nn.softmax(s, axis=-1).astype(v.dtype)
        return jnp.einsum('bhqk,bkhd->bqhd', p, v)

    out = lax.map(one_block, (qb, jnp.arange(nb)))
    return jnp.moveaxis(out, 0, 1).reshape(bsz, seq, heads, v.shape[-1])


def _mla_group(cq, ckv, kr, positions, q_norm, w_uq, kv_norm, w_ukv, g_out):
    bsz, seq, _ = cq.shape
    q = (_rms(cq, q_norm) @ w_uq).reshape(bsz, seq, MLA_HEADS, MLA_NOPE + MLA_ROPE)
    q = jnp.concatenate([q[..., :MLA_NOPE], _rope(q[..., MLA_NOPE:], positions)], axis=-1)
    kv = (_rms(ckv, kv_norm) @ w_ukv).reshape(bsz, seq, MLA_HEADS, MLA_NOPE + MLA_V)
    k_pe = jnp.broadcast_to(_rope(kr, positions)[:, :, None, :], (bsz, seq, MLA_HEADS, MLA_ROPE))
    k = jnp.concatenate([kv[..., :MLA_NOPE], k_pe], axis=-1)
    v = kv[..., MLA_NOPE:]
    o = _causal_attention(q, k, v, (MLA_NOPE + MLA_ROPE) ** -0.5)
    return _rms(o.reshape(bsz, seq, MLA_WIDTH), g_out)


def _causal_dwconv(x, w):
    taps, ch = w.shape
    return lax.conv_general_dilated(x, w.astype(x.dtype)[:, None, :], window_strides=(1,),
                                    padding=((taps - 1, 0),),
                                    dimension_numbers=('NWC', 'WIO', 'NWC'),
                                    feature_group_count=ch)


def _gated_delta_chunked(q, k, v, g, beta):
    f32 = jnp.float32
    bsz, seq, heads, dk = q.shape
    dv = v.shape[-1]
    c = GDN_CHUNK
    n = seq // c

    def to_chunks(t):
        t = t.astype(f32).reshape((bsz, n, c, heads) + t.shape[3:])
        return jnp.moveaxis(t, 3, 1)

    q = to_chunks(q) * (dk ** -0.5)
    k, v, g, beta = to_chunks(k), to_chunks(v), to_chunks(g), to_chunks(beta)
    gc = jnp.cumsum(g, axis=-1)
    tri = jnp.tril(jnp.ones((c, c), dtype=bool))
    strict = jnp.tril(jnp.ones((c, c), dtype=bool), -1)
    decay = jnp.where(tri, jnp.exp(jnp.where(tri, gc[..., :, None] - gc[..., None, :], 0.0)), 0.0)
    kb = k * beta[..., None]
    vb = v * beta[..., None]
    lmat = jnp.where(strict, jnp.einsum('bhncd,bhnjd->bhncj', kb, k) * decay, 0.0)
    eye = jnp.eye(c, dtype=f32)
    tmat = lax.linalg.triangular_solve(eye + lmat, jnp.broadcast_to(eye, lmat.shape),
                                       left_side=True, lower=True, unit_diagonal=True)
    u = tmat @ vb
    w = tmat @ (kb * jnp.exp(gc)[..., None])
    a_intra = jnp.where(tri, jnp.einsum('bhncd,bhnjd->bhncj', q, k) * decay, 0.0)
    g_last = gc[..., -1]
    k_end = k * jnp.exp(g_last[..., None] - gc)[..., None]
    q_dec = q * jnp.exp(gc)[..., None]
    xs = tuple(jnp.moveaxis(t, 2, 0) for t in (q_dec, w, u, a_intra, k_end, g_last))

    def step(state, inp):
        qd, wi, ui, ai, ke, gl = inp
        v_new = ui - jnp.einsum('bhcd,bhde->bhce', wi, state)
        o = jnp.einsum('bhcd,bhde->bhce', qd, state) + jnp.einsum('bhcj,bhje->bhce', ai, v_new)
        state = state * jnp.exp(gl)[..., None, None] + jnp.einsum('bhcd,bhce->bhde', ke, v_new)
        return state, o

    s0 = jnp.zeros((bsz, heads, dk, dv), f32)
    _, o = lax.scan(step, s0, xs)
    o = jnp.moveaxis(o, 0, 2)
    return jnp.moveaxis(o, 1, 3).reshape(bsz, seq, heads, dv)


def _gdn_group(gq, gk, gv, gz, ga, gb, w_conv, a_log, dt_bias, g_out):
    f32 = jnp.float32
    bsz, seq, _ = gq.shape
    nqk = GDN_HEADS * GDN_DK
    qkv = jax.nn.silu(_causal_dwconv(jnp.concatenate([gq, gk, gv], axis=-1), w_conv))
    q = _l2norm(qkv[..., :nqk].reshape(bsz, seq, GDN_HEADS, GDN_DK))
    k = _l2norm(qkv[..., nqk:2 * nqk].reshape(bsz, seq, GDN_HEADS, GDN_DK))
    v = qkv[..., 2 * nqk:].reshape(bsz, seq, GDN_HEADS, GDN_DV)
    beta = jax.nn.sigmoid(gb.astype(f32))
    g = -jnp.exp(a_log.astype(f32)) * jax.nn.softplus(ga.astype(f32) + dt_bias.astype(f32))
    o = _gated_delta_chunked(q, k, v, g, beta)
    o = _rms(o, g_out) * jax.nn.silu(gz.astype(f32).reshape(bsz, seq, GDN_HEADS, GDN_DV))
    return o.reshape(bsz, seq, GDN_WIDTH).astype(gq.dtype)


def _memory_xattn(x, mem, w_q, w_k, w_v, w_o):
    bsz, seq, _ = x.shape
    mlen = mem.shape[1]
    q = (x @ w_q).reshape(bsz, seq, XA_HEADS, XA_DH)
    k = (mem @ w_k).reshape(bsz, mlen, XA_HEADS, XA_DH)
    v = (mem @ w_v).reshape(bsz, mlen, XA_HEADS, XA_DH)
    s = jnp.einsum('bshd,bmhd->bhsm', q, k).astype(jnp.float32) * (XA_DH ** -0.5)
    p = jax.nn.softmax(s, axis=-1).astype(v.dtype)
    o = jnp.einsum('bhsm,bmhd->bshd', p, v).reshape(bsz, seq, XA_WIDTH)
    return o @ w_o


def _hier_moe(x, w_group, b_group, w_expert, b_expert, w_gate_up, w_down):
    f32 = jnp.float32
    bsz, seq, dm = x.shape
    ntok = bsz * seq
    xt = x.reshape(ntok, dm)
    pg = jax.nn.softmax((xt @ w_group + b_group).astype(f32), axis=-1)
    pg_top, gsel = lax.top_k(pg, 1)
    le = (xt @ w_expert + b_expert).astype(f32).reshape(ntok, MOE_GROUPS, MOE_PER_GROUP)
    idx = jnp.broadcast_to(gsel[:, :, None], (ntok, 1, MOE_PER_GROUP))
    le = jnp.take_along_axis(le, idx, axis=1)[:, 0]
    pe_top, esel = lax.top_k(jax.nn.softmax(le, axis=-1), MOE_TOPK)
    gate = pg_top * pe_top / jnp.sum(pe_top, axis=-1, keepdims=True)
    eid = gsel * MOE_PER_GROUP + esel

    m = ntok * MOE_TOPK
    flat_e = eid.reshape(m)
    flat_tok = jnp.repeat(jnp.arange(ntok, dtype=jnp.int32), MOE_TOPK)
    flat_g = gate.reshape(m)
    order = jnp.argsort(flat_e)
    se = flat_e[order]
    counts = jnp.zeros((MOE_EXPERTS,), jnp.int32).at[flat_e].add(1)
    starts = jnp.cumsum(counts) - counts
    pcounts = (counts + MOE_ROW_BLOCK - 1) // MOE_ROW_BLOCK * MOE_ROW_BLOCK
    pends = jnp.cumsum(pcounts)
    pstarts = pends - pcounts
    dest = pstarts[se] + (jnp.arange(m, dtype=jnp.int32) - starts[se])
    nblk = (m + MOE_ROW_BLOCK - 1) // MOE_ROW_BLOCK + MOE_EXPERTS
    rows = nblk * MOE_ROW_BLOCK
    row_tok = jnp.full((rows,), ntok, jnp.int32).at[dest].set(flat_tok[order])
    row_gate = jnp.zeros((rows,), f32).at[dest].set(flat_g[order])
    blk_start = jnp.arange(nblk, dtype=jnp.int32) * MOE_ROW_BLOCK
    blk_exp = jnp.minimum(jnp.searchsorted(pends, blk_start, side='right'), MOE_EXPERTS - 1)
    xpad = jnp.concatenate([xt, jnp.zeros((1, dm), xt.dtype)], axis=0)
    xr = xpad[row_tok].reshape(nblk, MOE_ROW_BLOCK, dm)

    def expert_block(args):
        xb, e = args
        gu = xb @ w_gate_up[e]
        h = jax.nn.silu(gu[:, :MOE_FF]) * gu[:, MOE_FF:]
        return h @ w_down[e]

    yr = lax.map(expert_block, (xr, blk_exp)).reshape(rows, dm)
    yr = yr * row_gate[:, None].astype(yr.dtype)
    y = jax.ops.segment_sum(yr, row_tok, num_segments=ntok + 1)[:ntok]
    return y.reshape(bsz, seq, dm)


def setup_inputs(seed: int = 0) -> dict:
    key = jax.random.key(seed)
    keys = iter(jax.random.split(key, 64))
    f32 = jnp.float32
    L = DEPTH

    def normal(shape, scale):
        return scale * jax.random.normal(next(keys), shape, f32)

    def gain(shape):
        return 1.0 + normal(shape, 0.02)

    def log_uniform(shape, lo, hi):
        return jax.random.uniform(next(keys), shape, f32, math.log(lo), math.log(hi))

    x = normal((BATCH, SEQ, D_MODEL), 1.0)
    mem = normal((BATCH, MEM_LEN, D_MODEL), 1.0)
    positions = (jax.random.randint(next(keys), (BATCH, 1), 0, MAX_POS_OFFSET, dtype=jnp.int32)
                 + jnp.arange(SEQ, dtype=jnp.int32)[None, :])
    w_in = normal((L, D_MODEL, IN_COLS), D_MODEL ** -0.5)
    s5_lambda_re = -0.5 + normal((L, S5_GROUPS, S5_STATE), 0.01)
    s5_lambda_im = math.pi * jnp.arange(S5_STATE, dtype=f32) + normal((L, S5_GROUPS, S5_STATE), 0.01)
    s5_log_step = log_uniform((L, S5_GROUPS), 1e-3, 1e-1)
    b_scale = (2 * S5_CH_PER_GROUP) ** -0.5
    s5_b_re = normal((L, S5_GROUPS, S5_STATE, S5_CH_PER_GROUP), b_scale)
    s5_b_im = normal((L, S5_GROUPS, S5_STATE, S5_CH_PER_GROUP), b_scale)
    c_scale = S5_STATE ** -0.5
    s5_c_re = normal((L, S5_GROUPS, S5_CH_PER_GROUP, S5_STATE), c_scale)
    s5_c_im = normal((L, S5_GROUPS, S5_CH_PER_GROUP, S5_STATE), c_scale)
    s5_d = normal((L, S5_GROUPS, S5_CH_PER_GROUP), 1.0)
    s5_w_glu = normal((L, S5_WIDTH, S5_WIDTH), S5_WIDTH ** -0.5)
    s5_b_glu = normal((L, S5_WIDTH), 0.02)
    s5_out_norm = gain((L, S5_WIDTH))
    mla_q_norm = gain((L, MLA_Q_RANK))
    mla_w_uq = normal((L, MLA_Q_RANK, MLA_HEADS * (MLA_NOPE + MLA_ROPE)), MLA_Q_RANK ** -0.5)
    mla_kv_norm = gain((L, MLA_KV_RANK))
    mla_w_ukv = normal((L, MLA_KV_RANK, MLA_HEADS * (MLA_NOPE + MLA_V)), MLA_KV_RANK ** -0.5)
    mla_out_norm = gain((L, MLA_WIDTH))
    gdn_conv = normal((L, GDN_CONV, GDN_QKV), GDN_CONV ** -0.5)
    gdn_a_log = jnp.log(jax.random.uniform(next(keys), (L, GDN_HEADS), f32, 1.0, 16.0))
    dt = jnp.exp(log_uniform((L, GDN_HEADS), 1e-3, 1e-1))
    gdn_dt_bias = dt + jnp.log(-jnp.expm1(-dt))
    gdn_out_norm = gain((L, GDN_DV))
    w_out = normal((L, MIX_WIDTH, D_MODEL), DN_BETA * MIX_WIDTH ** -0.5)
    ln1_g = gain((L, D_MODEL))
    ln1_b = normal((L, D_MODEL), 0.02)
    xa_w_q = normal((L, D_MODEL, XA_WIDTH), D_MODEL ** -0.5)
    xa_w_k = normal((L, D_MODEL, XA_WIDTH), D_MODEL ** -0.5)
    xa_w_v = normal((L, D_MODEL, XA_WIDTH), D_MODEL ** -0.5)
    xa_w_o = normal((L, XA_WIDTH, D_MODEL), DN_BETA * XA_WIDTH ** -0.5)
    ln2_g = gain((L, D_MODEL))
    ln2_b = normal((L, D_MODEL), 0.02)
    moe_w_group = normal((L, D_MODEL, MOE_GROUPS), D_MODEL ** -0.5)
    moe_b_group = normal((L, MOE_GROUPS), 0.01)
    moe_w_expert = normal((L, D_MODEL, MOE_EXPERTS), D_MODEL ** -0.5)
    moe_b_expert = normal((L, MOE_EXPERTS), 0.01)
    moe_w_gate_up = normal((L, MOE_EXPERTS, D_MODEL, 2 * MOE_FF), D_MODEL ** -0.5)
    moe_w_down = normal((L, MOE_EXPERTS, MOE_FF, D_MODEL), DN_BETA * MOE_FF ** -0.5)
    ln3_g = gain((L, D_MODEL))
    ln3_b = normal((L, D_MODEL), 0.02)
    return {'x': x, 'mem': mem, 'positions': positions, 'w_in': w_in,
            's5_lambda_re': s5_lambda_re, 's5_lambda_im': s5_lambda_im, 's5_log_step': s5_log_step,
            's5_b_re': s5_b_re, 's5_b_im': s5_b_im, 's5_c_re': s5_c_re, 's5_c_im': s5_c_im,
            's5_d': s5_d, 's5_w_glu': s5_w_glu, 's5_b_glu': s5_b_glu, 's5_out_norm': s5_out_norm,
            'mla_q_norm': mla_q_norm, 'mla_w_uq': mla_w_uq, 'mla_kv_norm': mla_kv_norm,
            'mla_w_ukv': mla_w_ukv, 'mla_out_norm': mla_out_norm,
            'gdn_conv': gdn_conv, 'gdn_a_log': gdn_a_log, 'gdn_dt_bias': gdn_dt_bias,
            'gdn_out_norm': gdn_out_norm, 'w_out': w_out, 'ln1_g': ln1_g, 'ln1_b': ln1_b,
            'xa_w_q': xa_w_q, 'xa_w_k': xa_w_k, 'xa_w_v': xa_w_v, 'xa_w_o': xa_w_o,
            'ln2_g': ln2_g, 'ln2_b': ln2_b,
            'moe_w_group': moe_w_group, 'moe_b_group': moe_b_group,
            'moe_w_expert': moe_w_expert, 'moe_b_expert': moe_b_expert,
            'moe_w_gate_up': moe_w_gate_up, 'moe_w_down': moe_w_down,
            'ln3_g': ln3_g, 'ln3_b': ln3_b}


def reference(x, mem, positions, w_in, s5_lambda_re, s5_lambda_im, s5_log_step, s5_b_re, s5_b_im,
              s5_c_re, s5_c_im, s5_d, s5_w_glu, s5_b_glu, s5_out_norm, mla_q_norm, mla_w_uq,
              mla_kv_norm, mla_w_ukv, mla_out_norm, gdn_conv, gdn_a_log, gdn_dt_bias, gdn_out_norm,
              w_out, ln1_g, ln1_b, xa_w_q, xa_w_k, xa_w_v, xa_w_o, ln2_g, ln2_b,
              moe_w_group, moe_b_group, moe_w_expert, moe_b_expert, moe_w_gate_up, moe_w_down,
              ln3_g, ln3_b):
    for l in range(DEPTH):
        proj = x @ w_in[l]
        u, cq, ckv, kr, gq, gk, gv, gz, ga, gb = _split_in_proj(proj)
        y_s5 = _s5_group(u, s5_lambda_re[l], s5_lambda_im[l], s5_log_step[l], s5_b_re[l],
                         s5_b_im[l], s5_c_re[l], s5_c_im[l], s5_d[l], s5_w_glu[l], s5_b_glu[l],
                         s5_out_norm[l])
        y_mla = _mla_group(cq, ckv, kr, positions, mla_q_norm[l], mla_w_uq[l], mla_kv_norm[l],
                           mla_w_ukv[l], mla_out_norm[l])
        y_gdn = _gdn_group(gq, gk, gv, gz, ga, gb, gdn_conv[l], gdn_a_log[l], gdn_dt_bias[l],
                           gdn_out_norm[l])
        mixed = jnp.concatenate([y_s5, y_mla, y_gdn], axis=-1) @ w_out[l]
        x = _layernorm(DN_ALPHA * x + mixed, ln1_g[l], ln1_b[l])
        xa = _memory_xattn(x, mem, xa_w_q[l], xa_w_k[l], xa_w_v[l], xa_w_o[l])
        x = _layernorm(DN_ALPHA * x + xa, ln2_g[l], ln2_b[l])
        ff = _hier_moe(x, moe_w_group[l], moe_b_group[l], moe_w_expert[l], moe_b_expert[l],
                       moe_w_gate_up[l], moe_w_down[l])
        x = _layernorm(DN_ALPHA * x + ff, ln3_g[l], ln3_b[l])
    return x
```

```cpp
#include <hip/hip_runtime.h>
#include <cstdio>
#include <cstdint>

#define GAS __attribute__((address_space(1)))
#define LAS __attribute__((address_space(3)))
typedef unsigned short bf16;
typedef short bf16x8 __attribute__((ext_vector_type(8)));
typedef short bf16x4 __attribute__((ext_vector_type(4)));
typedef float f32x2 __attribute__((ext_vector_type(2)));
typedef float f32x4 __attribute__((ext_vector_type(4)));
typedef float f32x16 __attribute__((ext_vector_type(16)));
typedef unsigned u32x2 __attribute__((ext_vector_type(2)));
typedef unsigned u32x4 __attribute__((ext_vector_type(4)));
typedef GAS unsigned gu32;
#define RLX_AGENT __ATOMIC_RELAXED, __HIP_MEMORY_SCOPE_AGENT
#define LDS_WAIT() asm volatile("s_waitcnt lgkmcnt(0)" ::: "memory")
#define VM_WAIT() asm volatile("s_waitcnt vmcnt(0)" ::: "memory")

__device__ __forceinline__ unsigned f2bf(float f) { unsigned u = __builtin_bit_cast(unsigned, f); return (u + 0x7fffu + ((u >> 16) & 1u)) >> 16; }
__device__ __forceinline__ unsigned pk2(float lo, float hi) { return f2bf(lo) | (f2bf(hi) << 16); }
__device__ __forceinline__ float bf2f(unsigned h) { return __builtin_bit_cast(float, h << 16); }
__device__ __forceinline__ float bflo(unsigned w) { return __builtin_bit_cast(float, w << 16); }
__device__ __forceinline__ float bfhi(unsigned w) { return __builtin_bit_cast(float, w & 0xffff0000u); }
__device__ __forceinline__ float wave_sum(float v) {
#pragma unroll
    for (int o = 1; o < 64; o <<= 1) v += __shfl_xor(v, o);
    return v;
}
__device__ __forceinline__ float sigmoidf_(float x) { return 1.0f / (1.0f + __expf(-x)); }
__device__ __forceinline__ float siluf_(float x) { return x / (1.0f + __expf(-x)); }
__device__ __forceinline__ float gelu_tanh(float x) { const float u = 1.5957691216057308f * (x + 0.044715f * x * x * x); return x / (1.0f + __expf(-u)); }

namespace pg8 {
constexpr int BM = 256, BK = 64, HALF = 128, HTB = HALF * BK * 2, STAGE_BYTES = 8 * HTB;
__host__ __device__ __forceinline__ int lds_byte(int r, int c) { const int st = (r >> 4) * 2 + (c >> 5), rr = r & 15, cc = c & 31, ob = rr * 64 + cc * 2; return st * 1024 + (ob ^ (((ob >> 9) & 1) << 5)); }
__host__ __device__ __forceinline__ void stage_rc(int b, int& R, int& C) { const int st = b / 1024, sb = b % 1024, swz = sb ^ (((sb >> 9) & 1) << 5); R = (st >> 1) * 16 + swz / 64; C = (st & 1) * 32 + (swz % 64) / 2; }
__host__ __device__ __forceinline__ int perm32(int rho) { const int n = rho >> 4, i = rho & 15; return 8 * (i >> 2) + 4 * n + (i & 3); }
struct Unit { int pm, pn, z; };

template <class Prob, class Epi, class Sched>
__device__ __forceinline__ void gemm_phase(LAS unsigned char* lds, const Prob& P, const Sched& S, const Epi& E, const int tid) {
    const int wid = __builtin_amdgcn_readfirstlane(tid >> 6), lane = tid & 63, wr = wid >> 2, wc = wid & 3, fr = lane & 15, fq = lane >> 4;
    const int nt = P.nt;
    unsigned voffA[2], voffB[2];
#pragma unroll
    for (int i = 0; i < 2; ++i) { int R, C; stage_rc(tid * 16 + i * 8192, R, C); const int Rb = Epi::PERM ? ((R & ~31) + perm32(R & 31)) : R;
        voffA[i] = P.a_voff(R, C); voffB[i] = P.b_voff(Rb, C); }
    const size_t kstepA = P.a_kstep, kstepB = P.b_kstep, hstepA = P.a_hstep, hstepB = P.b_hstep;
    const unsigned ldsw = (unsigned)wid * 1024u;
    const int aoff = lds_byte(wr * 64 + fr, fq * 8), boff = lds_byte(wc * 32 + fr, fq * 8);
#define PG8_SA(b, h) (((b) * 2 + (h)) * HTB)
#define PG8_SB(b, h) ((4 + (b) * 2 + (h)) * HTB)
#define PG8_STAGE(bufoff, gbase, voff) do { _Pragma("unroll") for (int _i = 0; _i < 2; ++_i) \
        __builtin_amdgcn_global_load_lds((const unsigned*)((const char*)(gbase) + (voff)[_i]), (LAS unsigned*)(lds + (bufoff) + ldsw + _i * 8192), 16, 0, 0); } while (0)
#define PG8_LDA(dst, b, h) do { _Pragma("unroll") for (int m = 0; m < 4; ++m) _Pragma("unroll") for (int k = 0; k < 2; ++k) dst[m][k] = *(const LAS bf16x8*)(lds + PG8_SA(b, h) + aoff + m * 2048 + k * 1024); } while (0)
#define PG8_LDB(dst, b, h) do { _Pragma("unroll") for (int n = 0; n < 2; ++n) _Pragma("unroll") for (int k = 0; k < 2; ++k) dst[n][k] = *(const LAS bf16x8*)(lds + PG8_SB(b, h) + boff + n * 2048 + k * 1024); } while (0)
#define PG8_MMA(ai, bj, At, Bt) do { __builtin_amdgcn_s_setprio(1); _Pragma("unroll") for (int m = 0; m < 4; ++m) _Pragma("unroll") for (int n = 0; n < 2; ++n) _Pragma("unroll") for (int k = 0; k < 2; ++k) \
        acc[ai][bj][m][n] = __builtin_amdgcn_mfma_f32_16x16x32_bf16(Bt[n][k], At[m][k], acc[ai][bj][m][n], 0, 0, 0); __builtin_amdgcn_s_setprio(0); } while (0)
#define PG8_WAIT_V(n) asm volatile("s_waitcnt vmcnt(" #n ")" ::: "memory")
#define PG8_WAIT_L(n) asm volatile("s_waitcnt lgkmcnt(" #n ")" ::: "memory")
#define PG8_BAR __builtin_amdgcn_s_barrier()
#define PG8_SCHED __builtin_amdgcn_sched_barrier(0)
    Unit cur, nxt; int ui = 0;
    if (!S.next(0, cur)) return;
    f32x4 acc[2][2][4][2];
#pragma unroll
    for (int a = 0; a < 2; ++a)
#pragma unroll
        for (int b = 0; b < 2; ++b)
#pragma unroll
            for (int m = 0; m < 4; ++m)
#pragma unroll
                for (int n = 0; n < 2; ++n) acc[a][b][m][n] = (f32x4){0.f, 0.f, 0.f, 0.f};
    bf16x8 At[4][2], B0[2][2], B1[2][2];
    const char* cA = P.a_base(cur); const char* cB = P.b_base(cur);
    PG8_STAGE(PG8_SB(0, 0), cB, voffB); PG8_STAGE(PG8_SB(0, 1), cB + hstepB, voffB); PG8_STAGE(PG8_SA(0, 0), cA, voffA); PG8_STAGE(PG8_SA(0, 1), cA + hstepA, voffA);
    if (wr == 1) PG8_BAR;
    PG8_WAIT_V(2); PG8_BAR;
    PG8_STAGE(PG8_SB(1, 0), cB + kstepB, voffB); PG8_STAGE(PG8_SA(1, 0), cA + kstepA, voffA); PG8_STAGE(PG8_SB(1, 1), cB + hstepB + kstepB, voffB);
    PG8_WAIT_V(6); PG8_BAR;
    for (;;) {
        const bool has_next = S.next(ui + 1, nxt);
        const char* nA = has_next ? P.a_base(nxt) : cA; const char* nB = has_next ? P.b_base(nxt) : cB;
        for (int t = 0; t < nt; t += 2) {
            const bool last = (t == nt - 2);
            const char* a1 = cA + (size_t)(t + 1) * kstepA;
            const char* a2 = last ? nA : cA + (size_t)(t + 2) * kstepA; const char* b2 = last ? nB : cB + (size_t)(t + 2) * kstepB;
            const char* a3 = a2 + kstepA; const char* b3 = b2 + kstepB;
            PG8_LDB(B0, 0, 0); PG8_LDB(B1, 0, 1); PG8_SCHED; PG8_LDA(At, 0, 0); PG8_STAGE(PG8_SA(1, 1), a1 + hstepA, voffA);
            PG8_WAIT_V(8); PG8_WAIT_L(0); PG8_BAR; PG8_MMA(0, 0, At, B0); PG8_MMA(0, 1, At, B1); PG8_BAR; PG8_SCHED;
            PG8_LDA(At, 0, 1); PG8_STAGE(PG8_SB(0, 0), b2, voffB); PG8_STAGE(PG8_SB(0, 1), b2 + hstepB, voffB); PG8_STAGE(PG8_SA(0, 0), a2, voffA);
            PG8_WAIT_V(8); PG8_WAIT_L(0); PG8_BAR; PG8_MMA(1, 0, At, B0); PG8_MMA(1, 1, At, B1); PG8_BAR; PG8_SCHED;
            PG8_LDB(B0, 1, 0); PG8_LDB(B1, 1, 1); PG8_SCHED; PG8_LDA(At, 1, 0); PG8_STAGE(PG8_SA(0, 1), a2 + hstepA, voffA);
            PG8_WAIT_V(8); PG8_WAIT_L(0); PG8_BAR; PG8_MMA(0, 0, At, B0); PG8_MMA(0, 1, At, B1); PG8_BAR; PG8_SCHED;
            PG8_LDA(At, 1, 1); PG8_STAGE(PG8_SB(1, 0), b3, voffB); PG8_STAGE(PG8_SB(1, 1), b3 + hstepB, voffB); PG8_STAGE(PG8_SA(1, 0), a3, voffA);
            PG8_WAIT_V(8); PG8_WAIT_L(0); PG8_BAR; PG8_MMA(1, 0, At, B0); PG8_MMA(1, 1, At, B1); PG8_BAR; PG8_SCHED;
        }
        if (wr == 0) PG8_BAR;
        E(acc, cur, wr, wc, fr, fq);
        if (!has_next) break;
#pragma unroll
        for (int a = 0; a < 2; ++a)
#pragma unroll
            for (int b = 0; b < 2; ++b)
#pragma unroll
                for (int m = 0; m < 4; ++m)
#pragma unroll
                    for (int n = 0; n < 2; ++n) acc[a][b][m][n] = (f32x4){0.f, 0.f, 0.f, 0.f};
        cur = nxt; cA = nA; cB = nB; ++ui;
        if (wr == 1) PG8_BAR;
    }
    PG8_WAIT_V(0);
    PG8_BAR;
#undef PG8_SA
#undef PG8_SB
#undef PG8_STAGE
#undef PG8_LDA
#undef PG8_LDB
#undef PG8_MMA
#undef PG8_WAIT_V
#undef PG8_WAIT_L
#undef PG8_BAR
#undef PG8_SCHED
}
}

#define XB_TMO      128
#define XB_XCNT(j)  (256  + 64 * (j))
#define XB_XSUB(j)  (1280 + 64 * (j))
#define XB_XGEN(j)  (2304 + 64 * (j))
#define XB_TOP      3328
#define XB_TOPGEN   3392
#define XCD_BAR_WORDS 3456
#define XB_SPIN_CAP (1u << 23)
__device__ __forceinline__ unsigned xb_ld(unsigned* p)              { return __hip_atomic_load(p, __ATOMIC_RELAXED, __HIP_MEMORY_SCOPE_AGENT); }
__device__ __forceinline__ unsigned xb_add(unsigned* p, unsigned v) { return __hip_atomic_fetch_add(p, v, __ATOMIC_RELAXED, __HIP_MEMORY_SCOPE_AGENT); }
__device__ __forceinline__ unsigned xb_xcc_id() { return (unsigned)__builtin_amdgcn_s_getreg((3 << 11) | 20) & 0xFu; }
#define XB_SPIN(cond, bar) do { unsigned _sp = 0; while (cond) { __builtin_amdgcn_s_sleep(1); \
    if ((++_sp & 255u) == 0u) { if (xb_ld(&(bar)[XB_TMO])) break; if (_sp > XB_SPIN_CAP) { atomicAdd(&(bar)[XB_TMO], 1u); break; } } } } while (0)
struct XcdBarrier { unsigned* bar; unsigned x; volatile LAS unsigned* st; };
__device__ __forceinline__ XcdBarrier xcd_barrier_post(unsigned* bar, volatile LAS unsigned* st) {
    XcdBarrier b; b.bar = bar; b.x = xb_xcc_id(); b.st = st;
    if (threadIdx.x == 0) (void)xb_add(&bar[XB_XCNT(b.x)], 1u);
    return b;
}
__device__ __forceinline__ void xcd_barrier_complete(unsigned* bar, unsigned x, unsigned& nloc, unsigned& nx) {
    const unsigned G = gridDim.x * gridDim.y * gridDim.z;
    unsigned sum, cnt, mine, sp = 0u;
    for (;;) {
        sum = 0u; cnt = 0u; mine = 0u;
#pragma unroll
        for (unsigned j = 0; j < 16; ++j) { const unsigned c = xb_ld(&bar[XB_XCNT(j)]); sum += c; cnt += (c > 0u) ? 1u : 0u; mine = (j == x) ? c : mine; }
        if (sum == G) break;
        __builtin_amdgcn_s_sleep(1);
        if ((++sp & 255u) == 0u) { if (xb_ld(&bar[XB_TMO])) break; if (sp > XB_SPIN_CAP) { atomicAdd(&bar[XB_TMO], 1u); break; } }
    }
    nloc = mine > 0u ? mine : 1u; nx = cnt > 0u ? cnt : 1u;
}
__device__ __forceinline__ void xcd_barrier(const XcdBarrier& b) {
    asm volatile("s_waitcnt vmcnt(0)" ::: "memory");
    __syncthreads();
    if (threadIdx.x == 0) {
        unsigned* bar = b.bar;
        __builtin_amdgcn_s_waitcnt(0);
        unsigned nloc = b.st[0], nx = b.st[1];
        if (nloc == 0u) { xcd_barrier_complete(bar, b.x, nloc, nx); b.st[0] = nloc; b.st[1] = nx; }
        const unsigned old = xb_add(&bar[XB_XSUB(b.x)], 1u);
        const unsigned gen = old / nloc;
        if (old + 1u == (gen + 1u) * nloc) {
            __builtin_amdgcn_fence(__ATOMIC_RELEASE, "agent");
            asm volatile("s_waitcnt vmcnt(0)" ::: "memory");
            const unsigned og = xb_add(&bar[XB_TOP], 1u);
            const unsigned tg = og / nx;
            if (og + 1u == (tg + 1u) * nx) xb_add(&bar[XB_TOPGEN], 1u);
            else XB_SPIN(xb_ld(&bar[XB_TOPGEN]) == tg, bar);
            __builtin_amdgcn_fence(__ATOMIC_ACQUIRE, "agent");
            xb_add(&bar[XB_XGEN(b.x)], 1u);
            asm volatile("s_waitcnt vmcnt(0)" ::: "memory");
        } else {
            XB_SPIN(xb_ld(&bar[XB_XGEN(b.x)]) == gen, bar);
            __builtin_amdgcn_fence(__ATOMIC_ACQUIRE, "agent");
            asm volatile("s_waitcnt vmcnt(0)" ::: "memory");
        }
    }
    __syncthreads();
}

constexpr int NL = 2, TT = 16384, DM = 2048, NB = 4, SQ = 4096, MEML = 256;
constexpr int NIN = 3840, IN_COLS = 3656;
constexpr int C_U = 0, C_CQ = 512, C_CKV = 1024, C_KR = 1536, C_GQ = 1600, C_GK = 2112, C_GV = 2624, C_GZ = 3136, C_GA = 3648, C_GB = 3652;
constexpr int S5L = 32, S5NCH = TT / S5L;
constexpr int MOE_ROWS = 40960;
constexpr float DN_ALPHA = 1.41421356237f;
constexpr float LOG2E = 1.4426950408889634f;
constexpr int NWAVES = 8;

constexpr size_t MiB = 1u << 20;
constexpr size_t WS_CTL = 0, CTL_ZERO_BYTES = 1 * MiB;
constexpr size_t WS_ROPE = 1 * MiB;
constexpr size_t WS_MISC = 5 * MiB;
constexpr size_t WS_WIN_T = 6 * MiB;
constexpr size_t WS_WUQ_T = 36 * MiB;
constexpr size_t WS_WUKV_T = 39 * MiB;
constexpr size_t WS_GLU_T = 43 * MiB;
constexpr size_t WS_WOUT_T = 44 * MiB;
constexpr size_t WS_XQ_T = 60 * MiB;
constexpr size_t WS_XKV_T = 64 * MiB;
constexpr size_t WS_XO_T = 72 * MiB;
constexpr size_t WS_TOEP_T = 76 * MiB;
constexpr size_t WS_MEND_T = 108 * MiB;
constexpr size_t WS_MST_T = 124 * MiB;
constexpr size_t WS_GU_T = 132 * MiB;
constexpr size_t WS_DN_T = 388 * MiB;
constexpr size_t WS_XF0 = 516 * MiB;
constexpr size_t WS_V = 644 * MiB;
constexpr size_t WS_XB = 772 * MiB;
constexpr size_t WS_PROJ = 836 * MiB;
constexpr size_t WS_MIX = 956 * MiB;
constexpr size_t WS_CQN = 1020 * MiB;
constexpr size_t WS_QB = 1052 * MiB;
constexpr size_t WS_KB = 1100 * MiB;
constexpr size_t WS_VT = 1148 * MiB;
constexpr size_t WS_OB = 1180 * MiB;
constexpr size_t WS_GQ = 1212 * MiB;
constexpr size_t WS_GK = 1228 * MiB;
constexpr size_t WS_GV = 1244 * MiB;
constexpr size_t WS_GDEC = 1260 * MiB;
constexpr size_t WS_GDW = 1261 * MiB;
constexpr size_t WS_GDQ = 1277 * MiB;
constexpr size_t WS_GDK = 1293 * MiB;
constexpr size_t WS_GDA = 1309 * MiB;
constexpr size_t WS_GDU = 1317 * MiB;
constexpr size_t WS_XLOC = 1349 * MiB;
constexpr size_t WS_XSB = 1357 * MiB;
constexpr size_t WS_YTOEP = 1361 * MiB;
constexpr size_t WS_YB = 1393 * MiB;
constexpr size_t WS_ZB = 1409 * MiB;
constexpr size_t WS_MEMB = 1425 * MiB;
constexpr size_t WS_XAQ = 1429 * MiB;
constexpr size_t WS_XAK = 1445 * MiB;
constexpr size_t WS_XAVT = 1446 * MiB;
constexpr size_t WS_XAO = 1447 * MiB;
constexpr size_t WS_ROUTE = 1463 * MiB;
constexpr size_t WS_XG = 1464 * MiB;
constexpr size_t WS_HB = 1624 * MiB;
constexpr size_t WS_END = 1664 * MiB;

constexpr int CW_BAR = 4096;
constexpr int CW_QUEUE = 8192;
constexpr int CW_ECNT = 16384;
constexpr int CW_ECUR = 16384 + 128;

constexpr int RING_OFF = 0, RING_BYTES = 131072;
constexpr int LDSCTL_OFF = RING_BYTES, MISC_OFF = LDSCTL_OFF + 320;
constexpr int LDS_BYTES = 147456;

struct Params { const void* in[41]; float* out; unsigned char* ws; int ph_lo, ph_hi, li, pad; };

__device__ __forceinline__ int rowmap(int mode, int c) {
    if (mode == 1) { const int h = c / 192, d = c - h * 192;
        if (d < 128) return 128 * h + d;
        if (d < 160) return 1024 + 256 * (h >> 2) + 32 * (h & 3) + (d - 128);
        return 1024 + 256 * (h >> 2) + 128 + 32 * (h & 3) + (d - 160); }
    if (mode == 2) { if (c < 512) return 256 * (c >> 7) + (c & 127); c -= 512; return 256 * (c >> 7) + 128 + (c & 127); }
    return c;
}
__device__ __forceinline__ void tr_item(const float* W, int K, int N, bf16* WT, const float* kscale, LAS float* scr, int item, int lane, int mode, int row_off) {
    const int nblk = (N + 31) / 32, kb = item / nblk, nb = item - kb * nblk, k0 = 64 * kb, n0 = 32 * nb;
    const int nn = n0 + (lane & 31);
#pragma unroll 8
    for (int i = 0; i < 32; ++i) { const int kk = 2 * i + (lane >> 5); float v = (nn < N) ? W[(size_t)(k0 + kk) * N + nn] : 0.f; if (kscale) v *= kscale[k0 + kk]; scr[kk * 33 + (lane & 31)] = v; }
    LDS_WAIT(); asm volatile("" ::: "memory");
    const int c = lane & 7;
#pragma unroll
    for (int j = 0; j < 4; ++j) { const int nl = (lane >> 3) + 8 * j; const int n = n0 + nl; const LAS float* s = scr + (8 * c) * 33 + nl;
        u32x4 o; o.x = pk2(s[0 * 33], s[1 * 33]); o.y = pk2(s[2 * 33], s[3 * 33]); o.z = pk2(s[4 * 33], s[5 * 33]); o.w = pk2(s[6 * 33], s[7 * 33]);
        if (n < N) *(u32x4*)(WT + (size_t)(row_off + rowmap(mode, n)) * K + k0 + 8 * c) = o; }
    LDS_WAIT(); asm volatile("" ::: "memory");
}
#define P0_JOB(IN, KK, NN, DSTOFF, DSTELEMS_PER, MODE, SCALE_IN, BATCH, ROWOFF) { \
    constexpr int per = ((KK) / 64) * (((NN) + 31) / 32); constexpr int cnt = NL * (BATCH) * per; \
    if (r < cnt) { const int lb = r / per, it = r - lb * per; \
        const float* W = (const float*)p.in[zz + IN] + (size_t)lb * (KK) * (NN); \
        bf16* WT = (bf16*)(ws + (DSTOFF)) + (size_t)lb * (DSTELEMS_PER); \
        const float* ksc = ((SCALE_IN) >= 0) ? (const float*)p.in[zz + (SCALE_IN) < 0 ? 0 : (SCALE_IN)] + (size_t)(lb / (BATCH)) * (KK) : nullptr; \
        tr_item(W, KK, NN, WT, ksc, scr, it, lane, MODE, ROWOFF); continue; } r -= cnt; }
constexpr int P0_NW_ITEMS = NL * (32 * 115 + 8 * 48 + 8 * 64 + 8 * 16 + 32 * 64 + 4 * 32 * 16 + 32 * (32 * 32) + 32 * (8 * 64)) + NL * 0;
__device__ __forceinline__ void p0_weights(const Params& p, LAS float* scr, int gw, int NGW, int lane) { unsigned char* ws = p.ws; int zz = 0; asm volatile("" : "+s"(ws), "+s"(zz));
    constexpr int per_layer = 32 * 115 + 8 * 48 + 8 * 64 + 8 * 16 + 32 * 64 + 32 * 16 + 32 * 16 + 32 * 16 + 8 * 64 + 32 * 1024 + 32 * 512;
    constexpr int total = NL * per_layer;
    for (int idx = gw; idx < total; idx += NGW) {
        int r = idx;
        P0_JOB(37, 2048, 1024, WS_GU_T, (size_t)1024 * 2048, 2, -1, 32, 0)
        P0_JOB(38, 512, 2048, WS_DN_T, (size_t)2048 * 512, 0, -1, 32, 0)
        P0_JOB(3, 2048, IN_COLS, WS_WIN_T, (size_t)NIN * 2048, 0, -1, 1, 0)
        P0_JOB(24, 2048, 2048, WS_WOUT_T, (size_t)2048 * 2048, 0, -1, 1, 0)
        P0_JOB(16, 512, 1536, WS_WUQ_T, (size_t)1536 * 512, 1, 15, 1, 0)
        P0_JOB(18, 512, 2048, WS_WUKV_T, (size_t)2048 * 512, 0, 17, 1, 0)
        P0_JOB(12, 512, 512, WS_GLU_T, (size_t)512 * 512, 0, -1, 1, 0)
        P0_JOB(27, 2048, 512, WS_XQ_T, (size_t)512 * 2048, 0, -1, 1, 0)
        P0_JOB(28, 2048, 512, WS_XKV_T, (size_t)1024 * 2048, 0, -1, 1, 0)
        P0_JOB(29, 2048, 512, WS_XKV_T, (size_t)1024 * 2048, 0, -1, 1, 512)
        P0_JOB(30, 512, 2048, WS_XO_T, (size_t)2048 * 512, 0, -1, 1, 0)
    }
}
__device__ __forceinline__ void cvt_rows(const float* src, bf16* dst, int nrows, int gw, int NGW, int lane) {
    for (int m = gw; m < nrows; m += NGW) {
        const f32x4* s = (const f32x4*)(src + (size_t)m * DM) + lane; u32x2* d = (u32x2*)(dst + (size_t)m * DM) + lane;
#pragma unroll
        for (int j = 0; j < 8; ++j) { const f32x4 v = s[64 * j]; u32x2 o; o.x = pk2(v.x, v.y); o.y = pk2(v.z, v.w); d[64 * j] = o; }
    }
}
__device__ __forceinline__ void p0_tables(const Params& p, int gw, int NGW, int lane) { unsigned char* ws = p.ws; int zz = 0; asm volatile("" : "+s"(ws), "+s"(zz));
    const int* pos = (const int*)p.in[zz + 2]; float* rt = (float*)(ws + WS_ROPE);
    for (int m = gw; m < TT / 2; m += NGW) { const int t = 2 * m + (lane >> 5), i = lane & 31;
        const float inv = exp2f(-(float)i * (13.287712379549449f / 32.f)); const float ang = (float)pos[t] * inv; float sn, cs; sincosf(ang, &sn, &cs);
        ((f32x2*)rt)[(size_t)t * 32 + i] = (f32x2){cs, sn}; }
    float* wr = (float*)(ws + WS_MISC);
    for (int m = gw; m < NL * 48 * 32; m += NGW) { const int l = m / (48 * 32), rr = m - l * 48 * 32, j = rr / 32, k = (rr & 31) * 64 + lane;
        float v = 0.f; if (j < 4) v = ((const float*)p.in[zz + 33])[((size_t)l * 2048 + k) * 4 + j]; else if (j < 36) v = ((const float*)p.in[zz + 35])[((size_t)l * 2048 + k) * 32 + (j - 4)];
        wr[((size_t)l * 48 + j) * 2048 + k] = v; }
}
__device__ __forceinline__ void s5_lane_consts(const Params& p, int l, int g, int pl, float& lr, float& li, float& dt) { unsigned char* ws = p.ws; int zz = 0; asm volatile("" : "+s"(ws), "+s"(zz));
    lr = fminf(((const float*)p.in[zz + 4])[(l * 32 + g) * 64 + pl], -1e-4f); li = ((const float*)p.in[zz + 5])[(l * 32 + g) * 64 + pl]; dt = __expf(((const float*)p.in[zz + 6])[l * 32 + g]);
}
__device__ __forceinline__ void cpow(float lr, float li, float dt, float n, float& re, float& im) { const float mag = expf(lr * dt * n); float sn, cs; sincosf(li * dt * n, &sn, &cs); re = mag * cs; im = mag * sn; }
__device__ __forceinline__ void s5_f(float lr, float li, float dt, float& fr, float& fi) {
    float ar, ai; cpow(lr, li, dt, 1.f, ar, ai); const float den = lr * lr + li * li, nr = ar - 1.f, ni = ai; fr = (nr * lr + ni * li) / den; fi = (ni * lr - nr * li) / den;
}
__device__ __forceinline__ void p0_s5(const Params& p, LAS float* scr, int gw, int NGW, int lane) { unsigned char* ws = p.ws; int zz = 0; asm volatile("" : "+s"(ws), "+s"(zz));
    constexpr int PER_G = 32 + 32 + 32 + 1, total = NL * 32 * PER_G;
    for (int idx = gw; idx < total; idx += NGW) {
        const int lg = idx / PER_G, kind = idx - lg * PER_G, l = lg >> 5, g = lg & 31;
        float lr, li, dt; s5_lane_consts(p, l, g, lane, lr, li, dt);
        float fr, fi; s5_f(lr, li, dt, fr, fi);
        const float* bre = (const float*)p.in[zz + 7] + (size_t)(l * 32 + g) * 64 * 16; const float* bim = (const float*)p.in[zz + 8] + (size_t)(l * 32 + g) * 64 * 16;
        const float* cre = (const float*)p.in[zz + 9] + (size_t)(l * 32 + g) * 16 * 64; const float* cim = (const float*)p.in[zz + 10] + (size_t)(l * 32 + g) * 16 * 64;
        if (kind < 32) {
            const int tau = kind; float ar, ai; cpow(lr, li, dt, (float)tau, ar, ai);
            const float er = ar * fr - ai * fi, ei = ar * fi + ai * fr;
            scr[lane * 2] = er; scr[lane * 2 + 1] = ei; LDS_WAIT(); asm volatile("" ::: "memory");
            bf16* Tp = (bf16*)(ws + WS_TOEP_T) + (size_t)(l * 32 + g) * 512 * 512;
#pragma unroll
            for (int q = 0; q < 4; ++q) { const int j = lane + 64 * q, ho = j >> 4, hi = j & 15; float acc = 0.f;
                for (int pp = 0; pp < 64; ++pp) { const float e_r = scr[pp * 2], e_i = scr[pp * 2 + 1]; const float br = bre[pp * 16 + hi], bi = bim[pp * 16 + hi];
                    const float xr = e_r * br - e_i * bi, xi = e_r * bi + e_i * br; acc += cre[ho * 64 + pp] * xr - cim[ho * 64 + pp] * xi; }
                if (tau == 0 && ho == hi) acc += ((const float*)p.in[zz + 11])[(l * 32 + g) * 16 + ho];
                const bf16 v = (bf16)f2bf(acc);
                for (int t = tau; t < 32; ++t) Tp[(size_t)(t * 16 + ho) * 512 + (t - tau) * 16 + hi] = v;
                if (tau > 0) for (int t = 0; t + tau < 32; ++t) Tp[(size_t)(t * 16 + ho) * 512 + (t + tau) * 16 + hi] = 0; }
            LDS_WAIT(); asm volatile("" ::: "memory");
        } else if (kind < 64) {
            const int s = kind - 32; float ar, ai; cpow(lr, li, dt, (float)(31 - s), ar, ai);
            const float er = ar * fr - ai * fi, ei = ar * fi + ai * fr;
            bf16* Mp = (bf16*)(ws + WS_MEND_T) + (size_t)(l * 32 + g) * 256 * 512;
            unsigned wre[8], wim[8];
#pragma unroll
            for (int h2 = 0; h2 < 8; ++h2) { float xr[2], xi[2];
#pragma unroll
                for (int u = 0; u < 2; ++u) { const float br = bre[lane * 16 + 2 * h2 + u], bi = bim[lane * 16 + 2 * h2 + u]; xr[u] = er * br - ei * bi; xi[u] = er * bi + ei * br; }
                wre[h2] = pk2(xr[0], xr[1]); wim[h2] = pk2(xi[0], xi[1]); }
            u32x4* dr = (u32x4*)(Mp + (size_t)lane * 512 + s * 16); u32x4* di = (u32x4*)(Mp + (size_t)(64 + lane) * 512 + s * 16);
            dr[0] = (u32x4){wre[0], wre[1], wre[2], wre[3]}; dr[1] = (u32x4){wre[4], wre[5], wre[6], wre[7]};
            di[0] = (u32x4){wim[0], wim[1], wim[2], wim[3]}; di[1] = (u32x4){wim[4], wim[5], wim[6], wim[7]};
        } else if (kind < 96) {
            const int t = kind - 64; float ar, ai; cpow(lr, li, dt, (float)(t + 1), ar, ai);
            bf16* Sp = (bf16*)(ws + WS_MST_T) + (size_t)(l * 32 + g) * 512 * 128;
#pragma unroll 4
            for (int ho = 0; ho < 16; ++ho) { const float cr = cre[ho * 64 + lane], ci = cim[ho * 64 + lane];
                Sp[(size_t)(t * 16 + ho) * 128 + lane] = (bf16)f2bf(cr * ar - ci * ai); Sp[(size_t)(t * 16 + ho) * 128 + 64 + lane] = (bf16)f2bf(-(cr * ai + ci * ar)); }
        } else {
            float ar, ai; cpow(lr, li, dt, (float)S5L, ar, ai);
            float* al = (float*)(ws + WS_MISC + 800 * 1024); al[((l * 32 + g) * 64 + lane) * 2] = ar; al[((l * 32 + g) * 64 + lane) * 2 + 1] = ai;
        }
    }
}

__device__ __forceinline__ void ln_rows(const float* v, const float* g, const float* b, float* xf, bf16* xb, float* vinit, int gw, int NGW, int lane) {
    for (int m = gw; m < TT; m += NGW) {
        const f32x4* vr = (const f32x4*)(v + (size_t)m * DM) + lane; f32x4 x[8]; float s = 0.f;
#pragma unroll
        for (int j = 0; j < 8; ++j) { x[j] = vr[64 * j]; s += (x[j].x + x[j].y) + (x[j].z + x[j].w); }
        const float mean = wave_sum(s) * (1.f / DM); float s2 = 0.f;
#pragma unroll
        for (int j = 0; j < 8; ++j) { x[j] = x[j] - mean; s2 += (x[j].x * x[j].x + x[j].y * x[j].y) + (x[j].z * x[j].z + x[j].w * x[j].w); }
        const float rstd = 1.0f / sqrtf(wave_sum(s2) * (1.f / DM) + 1e-5f);
        f32x4* of = (f32x4*)(xf + (size_t)m * DM) + lane; u32x2* ob = (u32x2*)(xb + (size_t)m * DM) + lane;
#pragma unroll
        for (int j = 0; j < 8; ++j) { const f32x4 gg = ((const f32x4*)g)[lane + 64 * j], bb = ((const f32x4*)b)[lane + 64 * j]; const f32x4 y = x[j] * rstd * gg + bb;
            of[64 * j] = y; u32x2 o; o.x = pk2(y.x, y.y); o.y = pk2(y.z, y.w); ob[64 * j] = o; if (vinit) ((f32x4*)(vinit + (size_t)m * DM) + lane)[64 * j] = y * DN_ALPHA; }
    }
}
__device__ __forceinline__ void scale_rows(const float* x, float* v, int gw, int NGW, int lane) {
    for (int m = gw; m < TT; m += NGW) { const f32x4* s = (const f32x4*)(x + (size_t)m * DM) + lane; f32x4* d = (f32x4*)(v + (size_t)m * DM) + lane;
#pragma unroll
        for (int j = 0; j < 8; ++j) d[64 * j] = s[64 * j] * DN_ALPHA; }
}
__device__ __forceinline__ void unpack8(const u32x4 w, float (&f)[8]) { f[0] = bflo(w.x); f[1] = bfhi(w.x); f[2] = bflo(w.y); f[3] = bfhi(w.y); f[4] = bflo(w.z); f[5] = bfhi(w.z); f[6] = bflo(w.w); f[7] = bfhi(w.w); }
__device__ __forceinline__ u32x4 pack8(const float (&f)[8]) { return (u32x4){pk2(f[0], f[1]), pk2(f[2], f[3]), pk2(f[4], f[5]), pk2(f[6], f[7])}; }

__device__ __forceinline__ void ph2_token(const Params& p, int l, int gw, int NGW, int lane) { unsigned char* ws = p.ws; int zz = 0; asm volatile("" : "+s"(ws), "+s"(zz));
    const bf16* proj = (const bf16*)(ws + WS_PROJ); bf16* cqn = (bf16*)(ws + WS_CQN); bf16* KB = (bf16*)(ws + WS_KB);
    const f32x2* rt = (const f32x2*)(ws + WS_ROPE); float* gdec = (float*)(ws + WS_GDEC); float* gbeta = (float*)(ws + WS_GDEC + 512 * 1024);
    for (int t = gw; t < TT; t += NGW) {
        const bf16* row = proj + (size_t)t * NIN;
#pragma unroll
        for (int part = 0; part < 2; ++part) { float f[8]; unpack8(*(const u32x4*)(row + C_CQ + part * 512 + lane * 8), f); float s = 0.f;
#pragma unroll
            for (int i = 0; i < 8; ++i) s += f[i] * f[i];
            const float sc = 1.0f / sqrtf(wave_sum(s) * (1.f / 512.f) + 1e-6f);
#pragma unroll
            for (int i = 0; i < 8; ++i) f[i] *= sc;
            *(u32x4*)(cqn + (size_t)t * 1024 + part * 512 + lane * 8) = pack8(f); }
        { const int i = lane & 31; const float x1 = bf2f(row[C_KR + i]), x2 = bf2f(row[C_KR + 32 + i]); const f32x2 cs = rt[(size_t)t * 32 + i];
          const float o = (lane < 32) ? (x1 * cs.x - x2 * cs.y) : (x2 * cs.x + x1 * cs.y);
          const int b = t >> 12, s = t & 4095; const bf16 ov = (bf16)f2bf(o);
#pragma unroll
          for (int h = 0; h < 8; ++h) KB[((size_t)(b * 8 + h) * SQ + s) * 192 + 128 + lane] = ov; }
        if (lane < 4) { const float ga = bf2f(row[C_GA + lane]), gb = bf2f(row[C_GB + lane]);
            const float xx = ga + ((const float*)p.in[zz + 22])[l * 4 + lane]; const float sp = fmaxf(xx, 0.f) + __logf(1.0f + __expf(-fabsf(xx)));
            gdec[(size_t)t * 4 + lane] = -__expf(((const float*)p.in[zz + 21])[l * 4 + lane]) * sp; gbeta[(size_t)t * 4 + lane] = 1.0f / (1.0f + __expf(-gb)); }
    }
}
__device__ __forceinline__ void ph2_conv(const Params& p, int l, int gw, int NGW, int lane) { unsigned char* ws = p.ws; int zz = 0; asm volatile("" : "+s"(ws), "+s"(zz));
    const bf16* proj = (const bf16*)(ws + WS_PROJ);
    const float* cw = (const float*)p.in[zz + 20] + (size_t)l * 4 * 1536;
    for (int it = gw; it < (TT / 8) * 3; it += NGW) {
        const int sec = it % 3, t0 = (it / 3) * 8; const int ch = sec * 512 + lane * 8;
        float w[4][8];
#pragma unroll
        for (int tp = 0; tp < 4; ++tp) { const f32x4 a = *(const f32x4*)(cw + tp * 1536 + ch), b = *(const f32x4*)(cw + tp * 1536 + ch + 4);
            w[tp][0] = a.x; w[tp][1] = a.y; w[tp][2] = a.z; w[tp][3] = a.w; w[tp][4] = b.x; w[tp][5] = b.y; w[tp][6] = b.z; w[tp][7] = b.w; }
        bf16* dst = (bf16*)(ws + (sec == 0 ? WS_GQ : (sec == 1 ? WS_GK : WS_GV)));
        float h0[8], h1[8], h2[8];
        const int s0 = t0 & 4095;
#pragma unroll
        for (int i = 0; i < 8; ++i) { h0[i] = 0.f; h1[i] = 0.f; h2[i] = 0.f; }
        if (s0 >= 3) { unpack8(*(const u32x4*)(proj + (size_t)(t0 - 3) * NIN + C_GQ + ch), h0); unpack8(*(const u32x4*)(proj + (size_t)(t0 - 2) * NIN + C_GQ + ch), h1); unpack8(*(const u32x4*)(proj + (size_t)(t0 - 1) * NIN + C_GQ + ch), h2); }
#pragma unroll
        for (int tt = 0; tt < 8; ++tt) { float x[8], y[8]; unpack8(*(const u32x4*)(proj + (size_t)(t0 + tt) * NIN + C_GQ + ch), x); float ss = 0.f;
#pragma unroll
            for (int i = 0; i < 8; ++i) { const float c = w[0][i] * h0[i] + w[1][i] * h1[i] + w[2][i] * h2[i] + w[3][i] * x[i]; y[i] = siluf_(c); ss += y[i] * y[i]; h0[i] = h1[i]; h1[i] = h2[i]; h2[i] = x[i]; }
            if (sec < 2) { ss += __shfl_xor(ss, 1); ss += __shfl_xor(ss, 2); ss += __shfl_xor(ss, 4); ss += __shfl_xor(ss, 8);
                float sc = 1.0f / sqrtf(ss + 1e-6f); if (sec == 0) sc *= 0.08838834764831845f;
#pragma unroll
                for (int i = 0; i < 8; ++i) y[i] *= sc; }
            *(u32x4*)(dst + (size_t)(t0 + tt) * 512 + lane * 8) = pack8(y); }
    }
}
__device__ __forceinline__ void mixnorm_rows(const Params& p, int l, bool do_s5, bool do_mla, int gw, int NGW, int lane) { unsigned char* ws = p.ws; int zz = 0; asm volatile("" : "+s"(ws), "+s"(zz));
    const bf16* zb = (const bf16*)(ws + WS_ZB); const bf16* ob = (const bf16*)(ws + WS_OB); bf16* mix = (bf16*)(ws + WS_MIX);
    const float* g5 = (const float*)p.in[zz + 14] + l * 512; const float* gm = (const float*)p.in[zz + 19] + l * 1024;
    for (int t = gw; t < TT; t += NGW) {
        if (do_s5) { float f[8]; unpack8(*(const u32x4*)(zb + (size_t)t * 512 + lane * 8), f); float s = 0.f;
#pragma unroll
            for (int i = 0; i < 8; ++i) s += f[i] * f[i];
            const float sc = 1.0f / sqrtf(wave_sum(s) * (1.f / 512.f) + 1e-6f);
#pragma unroll
            for (int i = 0; i < 8; ++i) f[i] *= sc * g5[lane * 8 + i];
            *(u32x4*)(mix + (size_t)t * DM + lane * 8) = pack8(f); }
        if (do_mla) { float f[2][8]; unpack8(*(const u32x4*)(ob + (size_t)t * 1024 + lane * 8), f[0]); unpack8(*(const u32x4*)(ob + (size_t)t * 1024 + 512 + lane * 8), f[1]); float s = 0.f;
#pragma unroll
            for (int i = 0; i < 8; ++i) s += f[0][i] * f[0][i] + f[1][i] * f[1][i];
            const float sc = 1.0f / sqrtf(wave_sum(s) * (1.f / 1024.f) + 1e-6f);
#pragma unroll
            for (int i = 0; i < 8; ++i) { f[0][i] *= sc * gm[lane * 8 + i]; f[1][i] *= sc * gm[512 + lane * 8 + i]; }
            *(u32x4*)(mix + (size_t)t * DM + 512 + lane * 8) = pack8(f[0]); *(u32x4*)(mix + (size_t)t * DM + 1024 + lane * 8) = pack8(f[1]); }
    }
}
__device__ __forceinline__ void zero_mix_cols(const Params& p, int c0, int ncols, int gw, int NGW, int lane) { unsigned char* ws = p.ws; int zz = 0; asm volatile("" : "+s"(ws), "+s"(zz));
    bf16* mix = (bf16*)(ws + WS_MIX); const int per = ncols / 8;
    for (int t = gw; t < TT; t += NGW) for (int i = lane; i < per; i += 64) *(u32x4*)(mix + (size_t)t * DM + c0 + i * 8) = (u32x4){0u, 0u, 0u, 0u};
}

#define MFMA32(a, b, c) __builtin_amdgcn_mfma_f32_32x32x16_bf16((a), (b), (c), 0, 0, 0)
#define MFMA16(a, b, c) __builtin_amdgcn_mfma_f32_16x16x32_bf16((a), (b), (c), 0, 0, 0)
__device__ __forceinline__ bf16x8 mk8(u32x2 lo, u32x2 hi) { const u32x4 w = {lo.x, lo.y, hi.x, hi.y}; return __builtin_bit_cast(bf16x8, w); }
template <int DK, bool CAUSAL>
__device__ __forceinline__ void attn_unit(LAS unsigned char* lds, const bf16* Qp, const bf16* Kp, const bf16* VTp, int SK, int q0, int ntiles, bf16* Op, int opitch, const int tid) {
    asm volatile("" : "+v"(lds));
    constexpr int KP = DK * 2 + 16, VP = 136, KVB = 64 * KP + 128 * VP, NKL = DK / 64;
    const int w = __builtin_amdgcn_readfirstlane(tid >> 6), lane = tid & 63, l31 = lane & 31, hl = lane >> 5;
    const int qrow = q0 + 32 * w + l31;
    bf16x8 qf[DK / 16];
#pragma unroll
    for (int s = 0; s < DK / 16; ++s) qf[s] = *(const bf16x8*)(Qp + (size_t)qrow * DK + 16 * s + 8 * hl);
    f32x16 ot[4];
#pragma unroll
    for (int d = 0; d < 4; ++d)
#pragma unroll
        for (int r = 0; r < 16; ++r) ot[d][r] = 0.f;
    float m_run = -INFINITY, l_run = 0.f;
    u32x4 kreg[NKL], vreg[2];
    int krow[NKL], kpc[NKL];
#pragma unroll
    for (int i = 0; i < NKL; ++i) { const int idx = tid + 512 * i; krow[i] = idx / (DK / 8); kpc[i] = idx - krow[i] * (DK / 8); }
#define ATT_LOAD(j) do { _Pragma("unroll") for (int i = 0; i < NKL; ++i) kreg[i] = *(const u32x4*)(Kp + (size_t)((j) * 64 + krow[i]) * DK + kpc[i] * 8); \
        _Pragma("unroll") for (int i = 0; i < 2; ++i) { const int idx = tid + 512 * i; vreg[i] = *(const u32x4*)(VTp + (size_t)(idx >> 3) * SK + (j) * 64 + (idx & 7) * 8); } } while (0)
#define ATT_STORE(buf) do { LAS unsigned char* kb_ = lds + (buf) * KVB; _Pragma("unroll") for (int i = 0; i < NKL; ++i) *(LAS u32x4*)(kb_ + krow[i] * KP + kpc[i] * 16) = kreg[i]; \
        _Pragma("unroll") for (int i = 0; i < 2; ++i) { const int idx = tid + 512 * i; LAS unsigned char* vp_ = kb_ + 64 * KP + (idx >> 3) * VP + (idx & 7) * 16; \
            *(LAS u32x2*)vp_ = (u32x2){vreg[i].x, vreg[i].y}; *(LAS u32x2*)(vp_ + 8) = (u32x2){vreg[i].z, vreg[i].w}; } } while (0)
    __syncthreads();
    ATT_LOAD(0); ATT_STORE(0);
    const int jmax = CAUSAL ? ((q0 + 32 * w + 31) >> 6) : (ntiles - 1);
#pragma unroll 1
    for (int j = 0; j < ntiles; ++j) {
        __syncthreads();
        if (j + 1 < ntiles) ATT_LOAD(j + 1);
        if (j <= jmax) {
            const LAS unsigned char* Kt = lds + (j & 1) * KVB; const LAS unsigned char* Vt = Kt + 64 * KP;
            f32x16 s0, s1;
#pragma unroll
            for (int r = 0; r < 16; ++r) { s0[r] = 0.f; s1[r] = 0.f; }
#pragma unroll
            for (int s = 0; s < DK / 16; ++s) { const bf16x8 a0 = *(const LAS bf16x8*)(Kt + l31 * KP + (16 * s + 8 * hl) * 2); const bf16x8 a1 = *(const LAS bf16x8*)(Kt + (32 + l31) * KP + (16 * s + 8 * hl) * 2);
                s0 = MFMA32(a0, qf[s], s0); s1 = MFMA32(a1, qf[s], s1); }
            if (CAUSAL && (j * 64 + 63 > q0 + 32 * w)) {
#pragma unroll
                for (int r = 0; r < 16; ++r) { const int key = j * 64 + (r & 3) + 8 * (r >> 2) + 4 * hl; if (key > qrow) s0[r] = -INFINITY; if (key + 32 > qrow) s1[r] = -INFINITY; }
            }
            float mx = s0[0];
#pragma unroll
            for (int r = 1; r < 16; ++r) mx = fmaxf(mx, s0[r]);
#pragma unroll
            for (int r = 0; r < 16; ++r) mx = fmaxf(mx, s1[r]);
            mx = fmaxf(mx, __shfl_xor(mx, 32));
            const float m_new = fmaxf(m_run, mx); const float alpha = __builtin_amdgcn_exp2f(m_run - m_new); m_run = m_new;
            float ps = 0.f;
#pragma unroll
            for (int r = 0; r < 16; ++r) { s0[r] = __builtin_amdgcn_exp2f(s0[r] - m_new); s1[r] = __builtin_amdgcn_exp2f(s1[r] - m_new); ps += s0[r] + s1[r]; }
            l_run = l_run * alpha + ps;
#pragma unroll
            for (int d = 0; d < 4; ++d)
#pragma unroll
                for (int r = 0; r < 16; ++r) ot[d][r] *= alpha;
            bf16x8 pf[4];
#pragma unroll
            for (int s = 0; s < 2; ++s) { pf[s] = __builtin_bit_cast(bf16x8, (u32x4){pk2(s0[8 * s + 0], s0[8 * s + 1]), pk2(s0[8 * s + 2], s0[8 * s + 3]), pk2(s0[8 * s + 4], s0[8 * s + 5]), pk2(s0[8 * s + 6], s0[8 * s + 7])});
                pf[2 + s] = __builtin_bit_cast(bf16x8, (u32x4){pk2(s1[8 * s + 0], s1[8 * s + 1]), pk2(s1[8 * s + 2], s1[8 * s + 3]), pk2(s1[8 * s + 4], s1[8 * s + 5]), pk2(s1[8 * s + 6], s1[8 * s + 7])}); }
#pragma unroll
            for (int sp = 0; sp < 4; ++sp)
#pragma unroll
                for (int d = 0; d < 4; ++d) { const LAS unsigned char* vp = Vt + (32 * d + l31) * VP + (16 * sp + 4 * hl) * 2;
                    const bf16x8 va = mk8(*(const LAS u32x2*)vp, *(const LAS u32x2*)(vp + 16)); ot[d] = MFMA32(va, pf[sp], ot[d]); }
        }
        if (j + 1 < ntiles) ATT_STORE((j + 1) & 1);
    }
    l_run += __shfl_xor(l_run, 32);
    const float inv = 1.0f / l_run;
    bf16* orow = Op + (size_t)qrow * opitch;
#pragma unroll
    for (int d = 0; d < 4; ++d)
#pragma unroll
        for (int r4 = 0; r4 < 4; ++r4) { u32x2 o; o.x = pk2(ot[d][4 * r4] * inv, ot[d][4 * r4 + 1] * inv); o.y = pk2(ot[d][4 * r4 + 2] * inv, ot[d][4 * r4 + 3] * inv);
            *(u32x2*)(orow + 32 * d + 8 * r4 + 4 * hl) = o; }
#undef ATT_LOAD
#undef ATT_STORE
}

constexpr int GP_K = 0, GP_Q = 17408, GP_KT = 34816, GP_VT = 53248, GP_L = 71680, GP_TB = 89088, GP_TBG = 98304, GP_GC = 107520, GP_BETA = 107776, GP_END = 108032;
__device__ __forceinline__ void gdn_pre_item(const Params& p, LAS unsigned char* lds, int item, const int tid) { asm volatile("" : "+v"(lds)); unsigned char* ws = p.ws; int zz = 0; asm volatile("" : "+s"(ws), "+s"(zz));
    const int w = __builtin_amdgcn_readfirstlane(tid >> 6), lane = tid & 63, fr = lane & 15, fq = lane >> 4;
    const int bh = item >> 6, n = item & 63, b = bh >> 2, h = bh & 3; const int t0 = b * SQ + n * 64;
    const bf16* gq = (const bf16*)(ws + WS_GQ); const bf16* gk = (const bf16*)(ws + WS_GK); const bf16* gv = (const bf16*)(ws + WS_GV);
    const float* gdec = (const float*)(ws + WS_GDEC); const float* gbeta = (const float*)(ws + WS_GDEC + 512 * 1024); float* glp = (float*)(ws + WS_GDEC + 768 * 1024);
    LAS float* gc = (LAS float*)(lds + GP_GC); LAS float* beta = (LAS float*)(lds + GP_BETA); LAS float* Lm = (LAS float*)(lds + GP_L);
    __syncthreads();
#pragma unroll
    for (int i = 0; i < 2; ++i) { const int idx = tid + 512 * i, c = idx >> 4, pc = idx & 15; const size_t go = (size_t)(t0 + c) * 512 + h * 128 + pc * 8;
        const u32x4 kq = *(const u32x4*)(gk + go), qq = *(const u32x4*)(gq + go), vq = *(const u32x4*)(gv + go);
        *(LAS u32x4*)(lds + GP_K + c * 272 + pc * 16) = kq; *(LAS u32x4*)(lds + GP_Q + c * 272 + pc * 16) = qq;
        const unsigned kk[4] = {kq.x, kq.y, kq.z, kq.w}, vv[4] = {vq.x, vq.y, vq.z, vq.w};
#pragma unroll
        for (int e = 0; e < 4; ++e) { *(LAS bf16*)(lds + GP_KT + (pc * 8 + 2 * e) * 144 + c * 2) = (bf16)(kk[e] & 0xffffu); *(LAS bf16*)(lds + GP_KT + (pc * 8 + 2 * e + 1) * 144 + c * 2) = (bf16)(kk[e] >> 16);
            *(LAS bf16*)(lds + GP_VT + (pc * 8 + 2 * e) * 144 + c * 2) = (bf16)(vv[e] & 0xffffu); *(LAS bf16*)(lds + GP_VT + (pc * 8 + 2 * e + 1) * 144 + c * 2) = (bf16)(vv[e] >> 16); } }
    if (tid < 64) { float g = gdec[(size_t)(t0 + tid) * 4 + h];
#pragma unroll
        for (int o = 1; o < 64; o <<= 1) { const float y = __shfl_up(g, o); if (tid >= o) g += y; }
        gc[tid] = g; beta[tid] = gbeta[(size_t)(t0 + tid) * 4 + h]; if (tid == 63) glp[item] = __expf(g); }
    __syncthreads();
    {
        const int tc = w >> 1; bf16* ga = (bf16*)(ws + WS_GDA) + (size_t)item * 4096;
#pragma unroll
        for (int u = 0; u < 2; ++u) { const int tj = 2 * (w & 1) + u; f32x4 kk = {0.f, 0.f, 0.f, 0.f}, qk = {0.f, 0.f, 0.f, 0.f};
            if (tj <= tc) {
#pragma unroll
                for (int s = 0; s < 4; ++s) { const bf16x8 bk = *(const LAS bf16x8*)(lds + GP_K + (16 * tj + fr) * 272 + (32 * s + 8 * fq) * 2);
                    const bf16x8 ak = *(const LAS bf16x8*)(lds + GP_K + (16 * tc + fr) * 272 + (32 * s + 8 * fq) * 2); const bf16x8 aq = *(const LAS bf16x8*)(lds + GP_Q + (16 * tc + fr) * 272 + (32 * s + 8 * fq) * 2);
                    kk = MFMA16(ak, bk, kk); qk = MFMA16(aq, bk, qk); } }
            const int j = 16 * tj + fr; const float gj = gc[j];
#pragma unroll
            for (int r = 0; r < 4; ++r) { const int c = 16 * tc + 4 * fq + r; const float dec = (j <= c) ? __expf(gc[c] - gj) : 0.f;
                Lm[c * 68 + j] = (j < c) ? kk[r] * dec * beta[c] : 0.f; ga[c * 64 + j] = (bf16)f2bf((j <= c) ? qk[r] * dec : 0.f); } }
    }
    __syncthreads();
    if (w == 0) {
        float tcol[64]; const float bj = beta[lane], bgj = bj * __expf(gc[lane]);
#pragma unroll
        for (int i = 0; i < 64; ++i) { float acc = (i == lane) ? 1.f : 0.f;
#pragma unroll
            for (int m4 = 0; m4 < (i + 3) / 4; ++m4) { const f32x4 lv = *(const LAS f32x4*)(Lm + i * 68 + 4 * m4);
                if (4 * m4 + 0 < i) acc -= lv.x * tcol[4 * m4 + 0]; if (4 * m4 + 1 < i) acc -= lv.y * tcol[4 * m4 + 1]; if (4 * m4 + 2 < i) acc -= lv.z * tcol[4 * m4 + 2]; if (4 * m4 + 3 < i) acc -= lv.w * tcol[4 * m4 + 3]; }
            tcol[i] = acc;
            *(LAS bf16*)(lds + GP_TB + i * 144 + lane * 2) = (bf16)f2bf(acc * bj); *(LAS bf16*)(lds + GP_TBG + i * 144 + lane * 2) = (bf16)f2bf(acc * bgj); }
    } else {
        bf16* gqd = (bf16*)(ws + WS_GDQ) + (size_t)item * 8192; bf16* gke = (bf16*)(ws + WS_GDK) + (size_t)item * 8192; const float glast = gc[63];
        for (int idx = tid - 64; idx < 1024; idx += 448) { const int c = idx >> 4, pc = idx & 15; float f[8]; unpack8(*(const LAS u32x4*)(lds + GP_Q + c * 272 + pc * 16), f); const float e = __expf(gc[c]);
#pragma unroll
            for (int i = 0; i < 8; ++i) f[i] *= e;
            *(u32x4*)(gqd + c * 128 + pc * 8) = pack8(f); }
        for (int idx = tid - 64; idx < 1024; idx += 448) { const int d = idx >> 3, pc = idx & 7; float f[8]; const LAS unsigned char* src = lds + GP_KT + d * 144 + pc * 16;
            unpack8((u32x4){*(const LAS unsigned*)src, *(const LAS unsigned*)(src + 4), *(const LAS unsigned*)(src + 8), *(const LAS unsigned*)(src + 12)}, f);
#pragma unroll
            for (int i = 0; i < 8; ++i) f[i] *= __expf(glast - gc[pc * 8 + i]);
            *(u32x4*)(gke + d * 64 + pc * 8) = pack8(f); }
    }
    __syncthreads();
    {
        float* gu = (float*)(ws + WS_GDU) + (size_t)item * 8192; bf16* gw_ = (bf16*)(ws + WS_GDW) + (size_t)item * 8192;
        bf16x8 bv[2], bk[2];
#pragma unroll
        for (int s = 0; s < 2; ++s) { const LAS unsigned char* pv = lds + GP_VT + (16 * w + fr) * 144 + (32 * s + 8 * fq) * 2; const LAS unsigned char* pk = lds + GP_KT + (16 * w + fr) * 144 + (32 * s + 8 * fq) * 2;
            bv[s] = __builtin_bit_cast(bf16x8, *(const LAS u32x4*)pv); bk[s] = __builtin_bit_cast(bf16x8, *(const LAS u32x4*)pk); }
#pragma unroll
        for (int tc = 0; tc < 4; ++tc) { f32x4 uu = {0.f, 0.f, 0.f, 0.f}, ww = {0.f, 0.f, 0.f, 0.f};
#pragma unroll
            for (int s = 0; s < 2; ++s) { const bf16x8 a1 = __builtin_bit_cast(bf16x8, *(const LAS u32x4*)(lds + GP_TB + (16 * tc + fr) * 144 + (32 * s + 8 * fq) * 2));
                const bf16x8 a2 = __builtin_bit_cast(bf16x8, *(const LAS u32x4*)(lds + GP_TBG + (16 * tc + fr) * 144 + (32 * s + 8 * fq) * 2));
                uu = MFMA16(a1, bv[s], uu); ww = MFMA16(a2, bk[s], ww); }
            *(f32x4*)(gu + ((w * 4 + tc) * 64 + lane) * 4) = uu;
#pragma unroll
            for (int r = 0; r < 4; ++r) gw_[(16 * tc + 4 * fq + r) * 128 + 16 * w + fr] = (bf16)f2bf(-ww[r]); }
    }
}

constexpr int GC_W = 0, GC_Q = 17408, GC_A = 34816, GC_KE = 44032, GC_BUF = 62464, GC_SSQ = 2 * GC_BUF;
__device__ __forceinline__ void gdn_chain(const Params& p, LAS unsigned char* lds, int bh, int l, const int tid) { asm volatile("" : "+v"(lds)); unsigned char* ws = p.ws; int zz = 0; asm volatile("" : "+s"(ws), "+s"(zz));
    const int w = __builtin_amdgcn_readfirstlane(tid >> 6), lane = tid & 63, fr = lane & 15, fq = lane >> 4;
    const int b = bh >> 2, h = bh & 3;
    const bf16* gW = (const bf16*)(ws + WS_GDW) + (size_t)bh * 64 * 8192; const bf16* gQ = (const bf16*)(ws + WS_GDQ) + (size_t)bh * 64 * 8192;
    const bf16* gA = (const bf16*)(ws + WS_GDA) + (size_t)bh * 64 * 4096; const bf16* gK = (const bf16*)(ws + WS_GDK) + (size_t)bh * 64 * 8192;
    const float* gU = (const float*)(ws + WS_GDU) + (size_t)bh * 64 * 8192; const float* glp = (const float*)(ws + WS_GDEC + 768 * 1024) + bh * 64;
    const bf16* proj = (const bf16*)(ws + WS_PROJ); bf16* mix = (bf16*)(ws + WS_MIX);
    const float gout = ((const float*)p.in[zz + 23])[l * 128 + 16 * w + fr];
    LAS float* ssq = (LAS float*)(lds + GC_SSQ);
    f32x4 S[8];
#pragma unroll
    for (int t = 0; t < 8; ++t) S[t] = (f32x4){0.f, 0.f, 0.f, 0.f};
    u32x4 rg[7];
#define GC_LOAD(n) do { const bf16* w_ = gW + (size_t)(n) * 8192; const bf16* q_ = gQ + (size_t)(n) * 8192; const bf16* a_ = gA + (size_t)(n) * 4096; const bf16* k_ = gK + (size_t)(n) * 8192; \
        rg[0] = *(const u32x4*)(w_ + tid * 8); rg[1] = *(const u32x4*)(w_ + 4096 + tid * 8); rg[2] = *(const u32x4*)(q_ + tid * 8); rg[3] = *(const u32x4*)(q_ + 4096 + tid * 8); \
        rg[4] = *(const u32x4*)(a_ + tid * 8); rg[5] = *(const u32x4*)(k_ + tid * 8); rg[6] = *(const u32x4*)(k_ + 4096 + tid * 8); } while (0)
#define GC_STORE(buf) do { LAS unsigned char* b_ = lds + (buf) * GC_BUF; \
        { const int c = tid >> 4, pc = tid & 15; *(LAS u32x4*)(b_ + GC_W + c * 272 + pc * 16) = rg[0]; *(LAS u32x4*)(b_ + GC_W + (32 + c) * 272 + pc * 16) = rg[1]; \
          *(LAS u32x4*)(b_ + GC_Q + c * 272 + pc * 16) = rg[2]; *(LAS u32x4*)(b_ + GC_Q + (32 + c) * 272 + pc * 16) = rg[3]; } \
        { const int c = tid >> 3, pc = tid & 7; *(LAS u32x4*)(b_ + GC_A + c * 144 + pc * 16) = rg[4]; *(LAS u32x4*)(b_ + GC_KE + c * 144 + pc * 16) = rg[5]; *(LAS u32x4*)(b_ + GC_KE + (64 + c) * 144 + pc * 16) = rg[6]; } } while (0)
    __syncthreads();
    GC_LOAD(0); GC_STORE(0);
#pragma unroll 1
    for (int n = 0; n < 64; ++n) {
        __syncthreads();
        if (n + 1 < 64) GC_LOAD(n + 1);
        const LAS unsigned char* B_ = lds + (n & 1) * GC_BUF;
        f32x4 vn[4], o[4];
#pragma unroll
        for (int t = 0; t < 4; ++t) { vn[t] = *(const f32x4*)(gU + (size_t)n * 8192 + ((w * 4 + t) * 64 + lane) * 4); o[t] = (f32x4){0.f, 0.f, 0.f, 0.f}; }
        bf16x8 sb[4];
#pragma unroll
        for (int s = 0; s < 4; ++s) sb[s] = __builtin_bit_cast(bf16x8, (u32x4){pk2(S[2 * s][0], S[2 * s][1]), pk2(S[2 * s][2], S[2 * s][3]), pk2(S[2 * s + 1][0], S[2 * s + 1][1]), pk2(S[2 * s + 1][2], S[2 * s + 1][3])});
#pragma unroll
        for (int t = 0; t < 4; ++t)
#pragma unroll
            for (int s = 0; s < 4; ++s) { const LAS unsigned char* pw = B_ + GC_W + (16 * t + fr) * 272 + (32 * s + 4 * fq) * 2; const LAS unsigned char* pq = B_ + GC_Q + (16 * t + fr) * 272 + (32 * s + 4 * fq) * 2;
                const bf16x8 aw = mk8(*(const LAS u32x2*)pw, *(const LAS u32x2*)(pw + 32)); const bf16x8 aq = mk8(*(const LAS u32x2*)pq, *(const LAS u32x2*)(pq + 32));
                vn[t] = MFMA16(aw, sb[s], vn[t]); o[t] = MFMA16(aq, sb[s], o[t]); }
        bf16x8 vb[2];
#pragma unroll
        for (int s = 0; s < 2; ++s) vb[s] = __builtin_bit_cast(bf16x8, (u32x4){pk2(vn[2 * s][0], vn[2 * s][1]), pk2(vn[2 * s][2], vn[2 * s][3]), pk2(vn[2 * s + 1][0], vn[2 * s + 1][1]), pk2(vn[2 * s + 1][2], vn[2 * s + 1][3])});
#pragma unroll
        for (int t = 0; t < 4; ++t)
#pragma unroll
            for (int s = 0; s < 2; ++s) { const LAS unsigned char* pa = B_ + GC_A + (16 * t + fr) * 144 + (32 * s + 4 * fq) * 2; const bf16x8 aa = mk8(*(const LAS u32x2*)pa, *(const LAS u32x2*)(pa + 32)); o[t] = MFMA16(aa, vb[s], o[t]); }
        const float gl = glp[n];
#pragma unroll
        for (int t = 0; t < 8; ++t) { S[t] = S[t] * gl;
#pragma unroll
            for (int s = 0; s < 2; ++s) { const LAS unsigned char* pk = B_ + GC_KE + (16 * t + fr) * 144 + (32 * s + 4 * fq) * 2; const bf16x8 ak = mk8(*(const LAS u32x2*)pk, *(const LAS u32x2*)(pk + 32)); S[t] = MFMA16(ak, vb[s], S[t]); } }
#pragma unroll
        for (int t = 0; t < 4; ++t)
#pragma unroll
            for (int r = 0; r < 4; ++r) { float q2 = o[t][r] * o[t][r]; q2 += __shfl_xor(q2, 1); q2 += __shfl_xor(q2, 2); q2 += __shfl_xor(q2, 4); q2 += __shfl_xor(q2, 8);
                if (fr == 0) ssq[w * 64 + 16 * t + 4 * fq + r] = q2; }
        __syncthreads();
#pragma unroll
        for (int t = 0; t < 4; ++t)
#pragma unroll
            for (int r = 0; r < 4; ++r) { const int c = 16 * t + 4 * fq + r; float tot = 0.f;
#pragma unroll
                for (int ww = 0; ww < 8; ++ww) tot += ssq[ww * 64 + c];
                const int tok = b * SQ + n * 64 + c; const float z = bf2f(proj[(size_t)tok * NIN + C_GZ + h * 128 + 16 * w + fr]);
                const float y = o[t][r] * (1.0f / sqrtf(tot * (1.f / 128.f) + 1e-6f)) * gout * siluf_(z);
                mix[(size_t)tok * DM + 1536 + h * 128 + 16 * w + fr] = (bf16)f2bf(y); }
        if (n + 1 < 64) GC_STORE((n + 1) & 1);
    }
#undef GC_LOAD
#undef GC_STORE
}

__device__ __forceinline__ void router_rows(const Params& p, int l, LAS float* scr  , const float* x2, int gw, int NGW, int lane) { unsigned char* ws = p.ws; int zz = 0; asm volatile("" : "+s"(ws), "+s"(zz));
    const float* wr = (const float*)(ws + WS_MISC) + (size_t)l * 48 * 2048; const int fr = lane & 15, fq = lane >> 4;
    int* tok_e = (int*)(ws + WS_ROUTE); float* tok_g = (float*)(ws + WS_ROUTE + 256 * 1024); unsigned* ecnt = (unsigned*)(ws + WS_CTL) + CW_ECNT + l * 32;
    const float* bg = (const float*)p.in[zz + 34] + l * 4; const float* be = (const float*)p.in[zz + 36] + l * 32;
    for (int blk = gw; blk < TT / 16; blk += NGW) {
        f32x4 acc[3] = {{0.f, 0.f, 0.f, 0.f}, {0.f, 0.f, 0.f, 0.f}, {0.f, 0.f, 0.f, 0.f}};
        const float* xa = x2 + (size_t)(blk * 16 + fr) * DM + 4 * fq;
        for (int i = 0; i < 128; ++i) { const f32x4 a = *(const f32x4*)(xa + 16 * i);
            const f32x4 b0 = *(const f32x4*)(wr + (size_t)fr * 2048 + 16 * i + 4 * fq), b1 = *(const f32x4*)(wr + (size_t)(16 + fr) * 2048 + 16 * i + 4 * fq), b2 = *(const f32x4*)(wr + (size_t)(32 + fr) * 2048 + 16 * i + 4 * fq);
#pragma unroll
            for (int j = 0; j < 4; ++j) { acc[0] = __builtin_amdgcn_mfma_f32_16x16x4f32(a[j], b0[j], acc[0], 0, 0, 0); acc[1] = __builtin_amdgcn_mfma_f32_16x16x4f32(a[j], b1[j], acc[1], 0, 0, 0); acc[2] = __builtin_amdgcn_mfma_f32_16x16x4f32(a[j], b2[j], acc[2], 0, 0, 0); } }
#pragma unroll
        for (int nt = 0; nt < 3; ++nt)
#pragma unroll
            for (int r = 0; r < 4; ++r) scr[(4 * fq + r) * 52 + 16 * nt + fr] = acc[nt][r];
        LDS_WAIT(); asm volatile("" ::: "memory");
        if (lane < 16) { const LAS float* lg = scr + lane * 52; const int t = blk * 16 + lane;
            float gbest = lg[0] + bg[0]; int gi = 0; float gl[4]; gl[0] = gbest;
#pragma unroll
            for (int j = 1; j < 4; ++j) { gl[j] = lg[j] + bg[j]; if (gl[j] > gbest) { gbest = gl[j]; gi = j; } }
            float gs = 0.f;
#pragma unroll
            for (int j = 0; j < 4; ++j) gs += expf(gl[j] - gbest);
            const float pg = 1.0f / gs;
            float e1 = -INFINITY, e2 = -INFINITY; int i1 = 0, i2 = 0;
#pragma unroll
            for (int j = 0; j < 8; ++j) { const float v = lg[4 + gi * 8 + j] + be[gi * 8 + j]; if (v > e1) { e2 = e1; i2 = i1; e1 = v; i1 = j; } else if (v > e2) { e2 = v; i2 = j; } }
            const float w2 = expf(e2 - e1), den = 1.0f + w2;
            const int ea = gi * 8 + i1, eb = gi * 8 + i2;
            tok_e[2 * t] = ea; tok_e[2 * t + 1] = eb; tok_g[2 * t] = pg / den; tok_g[2 * t + 1] = pg * w2 / den;
            atomicAdd(ecnt + ea, 1u); atomicAdd(ecnt + eb, 1u); }
        LDS_WAIT(); asm volatile("" ::: "memory");
    }
}

using pg8::Unit;
struct ProbG {
    const char* A; const char* Bt; unsigned a_rs, b_rs; size_t a_zs, b_zs; int nt;
    size_t a_kstep, b_kstep, a_hstep, b_hstep;
    __device__ __forceinline__ ProbG(const void* A_, unsigned a_rs_, size_t a_zs_, const void* B_, unsigned b_rs_, size_t b_zs_, int K)
        : A((const char*)A_), Bt((const char*)B_), a_rs(a_rs_), b_rs(b_rs_), a_zs(a_zs_), b_zs(b_zs_), nt(K / 64), a_kstep(128), b_kstep(128), a_hstep((size_t)128 * a_rs_), b_hstep((size_t)128 * b_rs_) {}
    __device__ __forceinline__ const char* a_base(const Unit& u) const { return A + (size_t)u.z * a_zs + (size_t)u.pm * 256 * a_rs; }
    __device__ __forceinline__ const char* b_base(const Unit& u) const { return Bt + (size_t)u.z * b_zs + (size_t)u.pn * 256 * b_rs; }
    __device__ __forceinline__ unsigned a_voff(int R, int C) const { return (unsigned)R * a_rs + (unsigned)C * 2u; }
    __device__ __forceinline__ unsigned b_voff(int R, int C) const { return (unsigned)R * b_rs + (unsigned)C * 2u; }
};
struct ProbS5 {
    const char* A; const char* Bt; unsigned b_rs; size_t b_zs; int nt; size_t a_kstep, b_kstep, a_hstep, b_hstep;
    __device__ __forceinline__ ProbS5(const void* proj, const void* B_, int nrowsB) : A((const char*)proj), Bt((const char*)B_), b_rs(1024), b_zs((size_t)nrowsB * 1024), nt(8),
        a_kstep((size_t)4 * NIN * 2), b_kstep(128), a_hstep((size_t)128 * 32 * NIN * 2), b_hstep((size_t)128 * 1024) {}
    __device__ __forceinline__ const char* a_base(const Unit& u) const { return A + ((size_t)u.pm * 256 * 32 * NIN + (size_t)u.z * 16) * 2; }
    __device__ __forceinline__ const char* b_base(const Unit& u) const { return Bt + (size_t)u.z * b_zs + (size_t)u.pn * 256 * b_rs; }
    __device__ __forceinline__ unsigned a_voff(int R, int C) const { return ((unsigned)(R * 32 + (C >> 4)) * NIN + (unsigned)(C & 15)) * 2u; }
    __device__ __forceinline__ unsigned b_voff(int R, int C) const { return (unsigned)R * b_rs + (unsigned)C * 2u; }
};
struct StaticOrder {
    int nM, nN, nwg, G, c;
    __device__ __forceinline__ StaticOrder(int M, int N, int G_, int c_) : nM(M / 256), nN(N / 256), nwg((M / 256) * (N / 256)), G(G_), c(c_) {}
    __device__ __forceinline__ bool next(int i, Unit& u) const {
        const long L = (long)i * G + c; if (L >= nwg) return false;
        int wgid = (int)L; { const int q = nwg / 8, r = nwg % 8, xcd = wgid % 8, off = wgid / 8; wgid = (xcd < r ? xcd * (q + 1) : r * (q + 1) + (xcd - r) * q) + off; }
        const int nig = 8 * nN, gid = wgid / nig, fm = gid * 8, gsz = (nM - fm) < 8 ? (nM - fm) : 8;
        u.pm = fm + ((wgid % nig) % gsz); u.pn = (wgid % nig) / gsz; u.z = 0; return true;
    }
};
struct BatchOrder {
    int nM, nN, total, G, c;
    __device__ __forceinline__ BatchOrder(int nz, int nM_, int nN_, int G_, int c_) : nM(nM_), nN(nN_), total(nz * nM_ * nN_), G(G_), c(c_) {}
    __device__ __forceinline__ bool next(int i, Unit& u) const { const int L = i * G + c; if (c < 0 || L >= total) return false; u.pn = L % nN; const int r = L / nN; u.pm = r % nM; u.z = r / nM; return true; }
};
constexpr int MOE_TAB_OFF = RING_BYTES + 1024;
struct MoeOrder {
    const volatile LAS int* tab; int nN, G, c;
    __device__ __forceinline__ bool next(int i, Unit& u) const { const int L = i * G + c; const int np = tab[0]; if (L >= np * nN) return false; const int pi = L / nN; u.pn = L - pi * nN; const int e = tab[1 + pi]; u.z = e & 255; u.pm = e >> 8; return true; }
};
__device__ __forceinline__ void moe_build_table(const Params& p, int l, LAS unsigned char* lds, const int tid) { unsigned char* ws = p.ws; int zz = 0; asm volatile("" : "+s"(ws), "+s"(zz));
    volatile LAS int* tab = (volatile LAS int*)(lds + MOE_TAB_OFF);
    __syncthreads();
    if (tid == 0) { const unsigned* ecnt = (const unsigned*)(ws + WS_CTL) + CW_ECNT + l * 32; int np = 0, row = 0;
        for (int e = 0; e < 32; ++e) { const int cnt = (int)__hip_atomic_load(ecnt + e, RLX_AGENT); tab[192 + e] = row; tab[224 + e] = cnt; const int k = (cnt + 255) >> 8;
            for (int j = 0; j < k; ++j) { if (np < 160) tab[1 + np] = e | (((row >> 8) + j) << 8); ++np; } row += k * 256; }
        tab[0] = np < 160 ? np : 160; }
    __syncthreads();
}

#define EPI_ROWS const int row0 = u.pm * 256 + wr * 64 + fr
typedef f32x4 AccT[2][2][4][2];
struct EpiBf16 { static constexpr bool PERM = true; bf16* O; int ldc;
    __device__ __forceinline__ void operator()(const AccT& acc, const Unit& u, int wr, int wc, int fr, int fq) const { EPI_ROWS; const int col0 = u.pn * 256 + wc * 32 + 8 * fq;
#pragma unroll
        for (int ai = 0; ai < 2; ++ai)
#pragma unroll
            for (int m = 0; m < 4; ++m) { bf16* rp = O + (size_t)(row0 + ai * 128 + m * 16) * ldc + col0;
#pragma unroll
                for (int bj = 0; bj < 2; ++bj) { const f32x4 v0 = acc[ai][bj][m][0], v1 = acc[ai][bj][m][1]; *(u32x4*)(rp + bj * 128) = (u32x4){pk2(v0[0], v0[1]), pk2(v0[2], v0[3]), pk2(v1[0], v1[1]), pk2(v1[2], v1[3])}; } } } };
struct EpiMlaQ { static constexpr bool PERM = true; bf16* Q; const float* rt; float sc;
    __device__ __forceinline__ void operator()(const AccT& acc, const Unit& u, int wr, int wc, int fr, int fq) const { EPI_ROWS;
#pragma unroll
        for (int ai = 0; ai < 2; ++ai)
#pragma unroll
            for (int m = 0; m < 4; ++m) { const int row = row0 + ai * 128 + m * 16, b = row >> 12, s = row & 4095;
                if (u.pn < 4) {
#pragma unroll
                    for (int bj = 0; bj < 2; ++bj) { const int h = 2 * u.pn + bj; const f32x4 v0 = acc[ai][bj][m][0] * sc, v1 = acc[ai][bj][m][1] * sc;
                        *(u32x4*)(Q + ((size_t)(b * 8 + h) * SQ + s) * 192 + wc * 32 + 8 * fq) = (u32x4){pk2(v0[0], v0[1]), pk2(v0[2], v0[3]), pk2(v1[0], v1[1]), pk2(v1[2], v1[3])}; }
                } else { const int h = 4 * (u.pn - 4) + wc; const f32x4* cs = (const f32x4*)(rt + ((size_t)row * 32 + 8 * fq) * 2); float o1[8], o2[8];
#pragma unroll
                    for (int n = 0; n < 2; ++n) { const f32x4 c01 = cs[2 * n], c23 = cs[2 * n + 1]; const f32x4 x1 = acc[ai][0][m][n], x2 = acc[ai][1][m][n];
                        const float cc[4] = {c01[0], c01[2], c23[0], c23[2]}, ss[4] = {c01[1], c01[3], c23[1], c23[3]};
#pragma unroll
                        for (int r = 0; r < 4; ++r) { o1[4 * n + r] = (x1[r] * cc[r] - x2[r] * ss[r]) * sc; o2[4 * n + r] = (x2[r] * cc[r] + x1[r] * ss[r]) * sc; } }
                    bf16* qp = Q + ((size_t)(b * 8 + h) * SQ + s) * 192 + 128 + 8 * fq; *(u32x4*)qp = pack8(o1); *(u32x4*)(qp + 32) = pack8(o2); } } } };
struct EpiMlaKV { static constexpr bool PERM = true; bf16* K; bf16* VT;
    __device__ __forceinline__ void operator()(const AccT& acc, const Unit& u, int wr, int wc, int fr, int fq) const { EPI_ROWS; const int h = u.pn;
#pragma unroll
        for (int ai = 0; ai < 2; ++ai)
#pragma unroll
            for (int m = 0; m < 4; ++m) { const int row = row0 + ai * 128 + m * 16, b = row >> 12, s = row & 4095;
                { const f32x4 v0 = acc[ai][0][m][0], v1 = acc[ai][0][m][1]; *(u32x4*)(K + ((size_t)(b * 8 + h) * SQ + s) * 192 + wc * 32 + 8 * fq) = (u32x4){pk2(v0[0], v0[1]), pk2(v0[2], v0[3]), pk2(v1[0], v1[1]), pk2(v1[2], v1[3])}; }
#pragma unroll
                for (int n = 0; n < 2; ++n)
#pragma unroll
                    for (int r = 0; r < 4; ++r) VT[((size_t)(b * 8 + h) * 128 + wc * 32 + 8 * fq + 4 * n + r) * SQ + s] = (bf16)f2bf(acc[ai][1][m][n][r]); } } };
struct EpiXloc { static constexpr bool PERM = false; float* X;
    __device__ __forceinline__ void operator()(const AccT& acc, const Unit& u, int wr, int wc, int fr, int fq) const { EPI_ROWS;
#pragma unroll
        for (int ai = 0; ai < 2; ++ai)
#pragma unroll
            for (int m = 0; m < 4; ++m) { float* rp = X + ((size_t)u.z * 512 + row0 + ai * 128 + m * 16) * 128 + wc * 32 + 4 * fq;
#pragma unroll
                for (int n = 0; n < 2; ++n) *(f32x4*)(rp + 16 * n) = acc[ai][0][m][n]; } } };
struct EpiYtoep { static constexpr bool PERM = false; float* Y;
    __device__ __forceinline__ void operator()(const AccT& acc, const Unit& u, int wr, int wc, int fr, int fq) const { EPI_ROWS;
#pragma unroll
        for (int ai = 0; ai < 2; ++ai)
#pragma unroll
            for (int m = 0; m < 4; ++m) { const int cr = row0 + ai * 128 + m * 16;
#pragma unroll
                for (int bj = 0; bj < 2; ++bj)
#pragma unroll
                    for (int n = 0; n < 2; ++n) { const int t = 16 * u.pn + 8 * bj + 2 * wc + n; *(f32x4*)(Y + ((size_t)cr * 32 + t) * 512 + u.z * 16 + 4 * fq) = acc[ai][bj][m][n]; } } } };
struct EpiYfin { static constexpr bool PERM = false; const float* Y; bf16* YB;
    __device__ __forceinline__ void operator()(const AccT& acc, const Unit& u, int wr, int wc, int fr, int fq) const { EPI_ROWS;
#pragma unroll
        for (int ai = 0; ai < 2; ++ai)
#pragma unroll
            for (int m = 0; m < 4; ++m) { const int cr = row0 + ai * 128 + m * 16;
#pragma unroll
                for (int bj = 0; bj < 2; ++bj)
#pragma unroll
                    for (int n = 0; n < 2; ++n) { const int t = 16 * u.pn + 8 * bj + 2 * wc + n; const size_t o = ((size_t)cr * 32 + t) * 512 + u.z * 16 + 4 * fq; const f32x4 v = acc[ai][bj][m][n] + *(const f32x4*)(Y + o);
                        *(u32x2*)(YB + o) = (u32x2){pk2(gelu_tanh(v[0]), gelu_tanh(v[1])), pk2(gelu_tanh(v[2]), gelu_tanh(v[3]))}; } } } };
struct EpiGlu { static constexpr bool PERM = true; const bf16* YB; bf16* ZB; const float* bias;
    __device__ __forceinline__ void operator()(const AccT& acc, const Unit& u, int wr, int wc, int fr, int fq) const { EPI_ROWS; const int col0 = u.pn * 256 + wc * 32 + 8 * fq;
#pragma unroll
        for (int ai = 0; ai < 2; ++ai)
#pragma unroll
            for (int m = 0; m < 4; ++m) { const size_t ro = (size_t)(row0 + ai * 128 + m * 16) * 512;
#pragma unroll
                for (int bj = 0; bj < 2; ++bj) { const int col = col0 + bj * 128; float y[8]; unpack8(*(const u32x4*)(YB + ro + col), y); const f32x4 b0 = *(const f32x4*)(bias + col), b1 = *(const f32x4*)(bias + col + 4);
                    const f32x4 v0 = acc[ai][bj][m][0] + b0, v1 = acc[ai][bj][m][1] + b1;
#pragma unroll
                    for (int r = 0; r < 4; ++r) { y[r] *= sigmoidf_(v0[r]); y[4 + r] *= sigmoidf_(v1[r]); }
                    *(u32x4*)(ZB + ro + col) = pack8(y); } } } };
struct EpiResid { static constexpr bool PERM = false; const float* X; float* V;
    __device__ __forceinline__ void operator()(const AccT& acc, const Unit& u, int wr, int wc, int fr, int fq) const { EPI_ROWS; const int col0 = u.pn * 256 + wc * 32 + 4 * fq;
#pragma unroll
        for (int ai = 0; ai < 2; ++ai)
#pragma unroll
            for (int m = 0; m < 4; ++m) { const size_t ro = (size_t)(row0 + ai * 128 + m * 16) * DM + col0;
#pragma unroll
                for (int bj = 0; bj < 2; ++bj)
#pragma unroll
                    for (int n = 0; n < 2; ++n) { const size_t o = ro + bj * 128 + n * 16; *(f32x4*)(V + o) = *(const f32x4*)(X + o) * DN_ALPHA + acc[ai][bj][m][n]; } } } };
struct EpiXaKV { static constexpr bool PERM = true; bf16* K; bf16* VT;
    __device__ __forceinline__ void operator()(const AccT& acc, const Unit& u, int wr, int wc, int fr, int fq) const { EPI_ROWS;
#pragma unroll
        for (int ai = 0; ai < 2; ++ai)
#pragma unroll
            for (int m = 0; m < 4; ++m) { const int row = row0 + ai * 128 + m * 16, b = row >> 8, mm = row & 255;
#pragma unroll
                for (int bj = 0; bj < 2; ++bj) { const int h = 2 * (u.pn & 1) + bj;
                    if (u.pn < 2) { const f32x4 v0 = acc[ai][bj][m][0], v1 = acc[ai][bj][m][1]; *(u32x4*)(K + ((size_t)(b * 4 + h) * 256 + mm) * 128 + wc * 32 + 8 * fq) = (u32x4){pk2(v0[0], v0[1]), pk2(v0[2], v0[3]), pk2(v1[0], v1[1]), pk2(v1[2], v1[3])}; }
                    else {
#pragma unroll
                        for (int n = 0; n < 2; ++n)
#pragma unroll
                            for (int r = 0; r < 4; ++r) VT[((size_t)(b * 4 + h) * 128 + wc * 32 + 8 * fq + 4 * n + r) * 256 + mm] = (bf16)f2bf(acc[ai][bj][m][n][r]); } } } } };
struct EpiXaQ { static constexpr bool PERM = true; bf16* Q; float sc;
    __device__ __forceinline__ void operator()(const AccT& acc, const Unit& u, int wr, int wc, int fr, int fq) const { EPI_ROWS;
#pragma unroll
        for (int ai = 0; ai < 2; ++ai)
#pragma unroll
            for (int m = 0; m < 4; ++m) { const int row = row0 + ai * 128 + m * 16, b = row >> 12, s = row & 4095;
#pragma unroll
                for (int bj = 0; bj < 2; ++bj) { const int h = 2 * u.pn + bj; const f32x4 v0 = acc[ai][bj][m][0] * sc, v1 = acc[ai][bj][m][1] * sc;
                    *(u32x4*)(Q + ((size_t)(b * 4 + h) * SQ + s) * 128 + wc * 32 + 8 * fq) = (u32x4){pk2(v0[0], v0[1]), pk2(v0[2], v0[3]), pk2(v1[0], v1[1]), pk2(v1[2], v1[3])}; } } } };
struct EpiMoeGU { static constexpr bool PERM = true; bf16* H;
    __device__ __forceinline__ void operator()(const AccT& acc, const Unit& u, int wr, int wc, int fr, int fq) const { EPI_ROWS;
#pragma unroll
        for (int ai = 0; ai < 2; ++ai)
#pragma unroll
            for (int m = 0; m < 4; ++m) { float o[8];
#pragma unroll
                for (int n = 0; n < 2; ++n)
#pragma unroll
                    for (int r = 0; r < 4; ++r) o[4 * n + r] = siluf_(acc[ai][0][m][n][r]) * acc[ai][1][m][n][r];
                *(u32x4*)(H + (size_t)(row0 + ai * 128 + m * 16) * 512 + u.pn * 128 + wc * 32 + 8 * fq) = pack8(o); } } };
struct EpiMoeDown { static constexpr bool PERM = false; float* V; const int* row_tok; const float* row_gate;
    __device__ __forceinline__ void operator()(const AccT& acc, const Unit& u, int wr, int wc, int fr, int fq) const { EPI_ROWS; const int col0 = u.pn * 256 + wc * 32 + 4 * fq;
#pragma unroll
        for (int ai = 0; ai < 2; ++ai)
#pragma unroll
            for (int m = 0; m < 4; ++m) { const int row = row0 + ai * 128 + m * 16; const int tok = row_tok[row]; if (tok < 0) continue; const float g = row_gate[row]; float* vp = V + (size_t)tok * DM + col0;
#pragma unroll
                for (int bj = 0; bj < 2; ++bj)
#pragma unroll
                    for (int n = 0; n < 2; ++n)
#pragma unroll
                        for (int r = 0; r < 4; ++r) __hip_atomic_fetch_add(vp + bj * 128 + n * 16 + r, g * acc[ai][bj][m][n][r], RLX_AGENT); } } };

#ifndef EN_S5
#define EN_S5 1
#endif
#ifndef EN_MLA
#define EN_MLA 1
#endif
#ifndef EN_GDN
#define EN_GDN 1
#endif
#ifndef EN_XA
#define EN_XA 1
#endif
#ifndef EN_MOE
#define EN_MOE 1
#endif
#ifndef EN_MIX
#define EN_MIX 1
#endif
constexpr int NPH = 17, NPHASES = 1 + NL * NPH;

__global__ void __launch_bounds__(NWAVES * 64, 2) hybrid_fwd(Params p) {
    extern __shared__ __attribute__((aligned(16))) unsigned char lds_raw[];
    LAS unsigned char* lds0 = (LAS unsigned char*)lds_raw;
    const int tid0 = threadIdx.x; const int wave0 = __builtin_amdgcn_readfirstlane(tid0 >> 6);
    const int G = gridDim.x, bid = blockIdx.x; const int NGW = G * NWAVES;
    unsigned* ctl0 = (unsigned*)(p.ws + WS_CTL);
    for (int u = tid0; u < (LDS_BYTES - LDSCTL_OFF) / 4; u += NWAVES * 64) ((LAS unsigned*)(lds0 + LDSCTL_OFF))[u] = 0u;
    __syncthreads();
    volatile LAS unsigned* MISC = (volatile LAS unsigned*)(lds0 + MISC_OFF);
    const bool use_bar = (p.ph_hi - p.ph_lo) > 1;
    XcdBarrier bar; bar.bar = ctl0 + CW_BAR; bar.x = 0; bar.st = MISC + 8;
    if (use_bar) bar = xcd_barrier_post(ctl0 + CW_BAR, MISC + 8);
    const int lo = p.ph_lo, hi = p.ph_hi;
#define IN(k) (lo <= (k) && (k) < hi)
#define PH_VARS int wv_ = wave0; unsigned m1_ = ~0u; asm volatile("" : "+s"(wv_), "+s"(m1_)); int tid = wv_ * 64 + (int)__builtin_amdgcn_mbcnt_hi(m1_, __builtin_amdgcn_mbcnt_lo(m1_, 0u)); LAS unsigned char* lds = lds0; asm volatile("" : "+v"(tid), "+v"(lds)); const int lane = tid & 63, wave = __builtin_amdgcn_readfirstlane(tid >> 6); const int gw = bid * NWAVES + wave; LAS float* wscr = (LAS float*)(lds + RING_OFF + wave * 16384); unsigned char* ws = p.ws; int zz = 0; asm volatile("" : "+s"(ws), "+s"(zz)); unsigned* ctl = (unsigned*)(ws + WS_CTL); float* XF0 = (float*)(ws + WS_XF0); float* XF1 = p.out; float* V = (float*)(ws + WS_V); bf16* XB = (bf16*)(ws + WS_XB); bf16* PROJ = (bf16*)(ws + WS_PROJ); bf16* MIX = (bf16*)(ws + WS_MIX); \
    const float* xin = (l == 0) ? (const float*)p.in[zz] : XF0; float* x1 = (l == 0) ? XF0 : XF1; float* x2 = (l == 0) ? XF1 : XF0; float* x3 = (l == 0) ? XF0 : XF1; \
    (void)lane; (void)gw; (void)wscr; (void)ctl; (void)V; (void)XB; (void)PROJ; (void)MIX; (void)xin; (void)x1; (void)x2; (void)x3
#define SEAM(k) do { if (IN(k) && IN((k) + 1)) xcd_barrier(bar); } while (0)

    if (IN(0)) { const int l = 0; PH_VARS;
        p0_weights(p, wscr, gw, NGW, lane);
        p0_tables(p, gw, NGW, lane);
        p0_s5(p, wscr, gw, NGW, lane);
        cvt_rows((const float*)p.in[zz + 0], XB, TT, gw, NGW, lane);
        cvt_rows((const float*)p.in[zz + 1], (bf16*)(ws + WS_MEMB), NB * MEML, gw, NGW, lane);
    }
    SEAM(0);

    { constexpr int l = 0; constexpr int P0 = 1;
        if (IN(P0 + 0)) { PH_VARS;
#if EN_MIX
            ProbG P(XB, DM * 2, 0, ws + WS_WIN_T + (size_t)l * NIN * 2048 * 2, DM * 2, 0, DM); StaticOrder S(TT, NIN, G, bid); EpiBf16 E{PROJ, NIN};
            pg8::gemm_phase(lds0 + RING_OFF, P, S, E, tid);
#endif
        }
        SEAM(P0 + 0);
        if (IN(P0 + 1)) { PH_VARS;
#if EN_MLA || EN_GDN
            ph2_token(p, l, gw, NGW, lane);
#endif
#if EN_GDN
            ph2_conv(p, l, gw, NGW, lane);
#endif
#if EN_S5
            { ProbS5 P(PROJ, ws + WS_MEND_T + (size_t)l * 32 * 256 * 512 * 2, 256); BatchOrder S(32, 2, 1, G, bid); EpiXloc E{(float*)(ws + WS_XLOC)}; pg8::gemm_phase(lds0 + RING_OFF, P, S, E, tid); }
            { ProbS5 P(PROJ, ws + WS_TOEP_T + (size_t)l * 32 * 512 * 512 * 2, 512); BatchOrder S(32, 2, 2, G, (bid + 192) % G); EpiYtoep E{(float*)(ws + WS_YTOEP)}; pg8::gemm_phase(lds0 + RING_OFF, P, S, E, tid); }
#endif
#if EN_XA
            { ProbG P(ws + WS_MEMB, DM * 2, 0, ws + WS_XKV_T + (size_t)l * 1024 * 2048 * 2, DM * 2, 0, DM); StaticOrder S(NB * MEML, 1024, G, (bid + 64) % G); EpiXaKV E{(bf16*)(ws + WS_XAK), (bf16*)(ws + WS_XAVT)};
              pg8::gemm_phase(lds0 + RING_OFF, P, S, E, tid); }
#endif
        }
        SEAM(P0 + 1);
        if (IN(P0 + 2)) { PH_VARS;
#if EN_S5
            if (bid >= G - 32) { const int q = (bid - (G - 32)) * 512 + tid;
                if (q < 8192) { const int b = q >> 11, g = (q >> 6) & 31, pp = q & 63; const float* al = (const float*)(ws + WS_MISC + 800 * 1024) + ((l * 32 + g) * 64 + pp) * 2; const float ar = al[0], ai = al[1];
                    const float* xl = (const float*)(ws + WS_XLOC) + ((size_t)g * 512 + b * 128) * 128; bf16* xs = (bf16*)(ws + WS_XSB) + ((size_t)g * 512 + b * 128) * 128; float sr = 0.f, si = 0.f;
                    for (int c = 0; c < 128; ++c) { xs[c * 128 + pp] = (bf16)f2bf(sr); xs[c * 128 + 64 + pp] = (bf16)f2bf(si); const float lr_ = xl[c * 128 + pp], li_ = xl[c * 128 + 64 + pp];
                        const float nr = ar * sr - ai * si + lr_, ni = ar * si + ai * sr + li_; sr = nr; si = ni; } } }
#endif
#if EN_MLA
            { ProbG P(ws + WS_CQN, 2048, 0, ws + WS_WUQ_T + (size_t)l * 1536 * 512 * 2, 1024, 0, 512); StaticOrder S(TT, 1536, G, bid); EpiMlaQ E{(bf16*)(ws + WS_QB), (const float*)(ws + WS_ROPE), 0.07216878364870323f * LOG2E};
              pg8::gemm_phase(lds0 + RING_OFF, P, S, E, tid); }
            { ProbG P(ws + WS_CQN + 1024, 2048, 0, ws + WS_WUKV_T + (size_t)l * 2048 * 512 * 2, 1024, 0, 512); StaticOrder S(TT, 2048, G, (bid + 128) % G); EpiMlaKV E{(bf16*)(ws + WS_KB), (bf16*)(ws + WS_VT)};
              pg8::gemm_phase(lds0 + RING_OFF, P, S, E, tid); }
#endif
#if EN_GDN
            for (int it = bid; it < 1024; it += G) gdn_pre_item(p, lds + RING_OFF, it, tid);
#endif
        }
        SEAM(P0 + 2);
        if (IN(P0 + 3)) { PH_VARS;
#if EN_GDN
            if (bid < 16) gdn_chain(p, lds + RING_OFF, bid, l, tid);
#else
            zero_mix_cols(p, 1536, 512, gw, NGW, lane);
#endif
#if EN_S5
            { ProbG P(ws + WS_XSB, 256, (size_t)512 * 256, ws + WS_MST_T + (size_t)l * 32 * 512 * 128 * 2, 256, (size_t)512 * 256, 128); BatchOrder S(32, 2, 2, G - 16, bid - 16); EpiYfin E{(const float*)(ws + WS_YTOEP), (bf16*)(ws + WS_YB)};
              pg8::gemm_phase(lds0 + RING_OFF, P, S, E, tid); }
#endif
#if EN_MLA
            { unsigned* head = ctl + CW_QUEUE + l * 64; volatile LAS int* qslot = (volatile LAS int*)(lds + MISC_OFF);
              for (;;) { __syncthreads(); if (tid == 0) qslot[0] = (int)__hip_atomic_fetch_add(head, 1u, RLX_AGENT); __syncthreads(); const int q = qslot[0]; if (q >= 512) break;
                  const int qb = 15 - (q >> 5), bh = q & 31, b = bh >> 3, h = bh & 7;
                  attn_unit<192, true>(lds + RING_OFF, (const bf16*)(ws + WS_QB) + (size_t)bh * SQ * 192, (const bf16*)(ws + WS_KB) + (size_t)bh * SQ * 192, (const bf16*)(ws + WS_VT) + (size_t)bh * 128 * SQ, SQ, qb * 256, 4 * qb + 4,
                                       (bf16*)(ws + WS_OB) + (size_t)b * SQ * 1024 + h * 128, 1024, tid); } }
#endif
        }
        SEAM(P0 + 3);
        if (IN(P0 + 4)) { PH_VARS;
#if EN_S5
            { ProbG P(ws + WS_YB, 1024, 0, ws + WS_GLU_T + (size_t)l * 512 * 512 * 2, 1024, 0, 512); StaticOrder S(TT, 512, G, bid); EpiGlu E{(const bf16*)(ws + WS_YB), (bf16*)(ws + WS_ZB), (const float*)p.in[zz + 13] + l * 512};
              pg8::gemm_phase(lds0 + RING_OFF, P, S, E, tid); }
#endif
#if EN_MLA
            mixnorm_rows(p, l, false, true, gw, NGW, lane);
#else
            zero_mix_cols(p, 512, 1024, gw, NGW, lane);
#endif
        }
        SEAM(P0 + 4);
        if (IN(P0 + 5)) { PH_VARS;
#if EN_S5
            mixnorm_rows(p, l, true, false, gw, NGW, lane);
#else
            zero_mix_cols(p, 0, 512, gw, NGW, lane);
#endif
        }
        SEAM(P0 + 5);
        if (IN(P0 + 6)) { PH_VARS;
#if EN_MIX
            ProbG P(MIX, DM * 2, 0, ws + WS_WOUT_T + (size_t)l * 2048 * 2048 * 2, DM * 2, 0, DM); StaticOrder S(TT, DM, G, bid); EpiResid E{xin, V};
            pg8::gemm_phase(lds0 + RING_OFF, P, S, E, tid);
#else
            scale_rows(xin, V, gw, NGW, lane);
#endif
        }
        SEAM(P0 + 6);
        if (IN(P0 + 7)) { PH_VARS; ln_rows(V, (const float*)p.in[zz + 25] + l * DM, (const float*)p.in[zz + 26] + l * DM, x1, XB, nullptr, gw, NGW, lane); }
        SEAM(P0 + 7);
        if (IN(P0 + 8)) { PH_VARS;
#if EN_XA
            ProbG P(XB, DM * 2, 0, ws + WS_XQ_T + (size_t)l * 512 * 2048 * 2, DM * 2, 0, DM); StaticOrder S(TT, 512, G, bid); EpiXaQ E{(bf16*)(ws + WS_XAQ), 0.08838834764831845f * LOG2E};
            pg8::gemm_phase(lds0 + RING_OFF, P, S, E, tid);
#endif
        }
        SEAM(P0 + 8);
        if (IN(P0 + 9)) { PH_VARS;
#if EN_XA
            for (int q = bid; q < 256; q += G) { const int bh = q >> 4, qb = q & 15, b = bh >> 2, h = bh & 3;
                attn_unit<128, false>(lds + RING_OFF, (const bf16*)(ws + WS_XAQ) + (size_t)bh * SQ * 128, (const bf16*)(ws + WS_XAK) + (size_t)bh * 256 * 128, (const bf16*)(ws + WS_XAVT) + (size_t)bh * 128 * 256, 256, qb * 256, 4,
                                      (bf16*)(ws + WS_XAO) + (size_t)b * SQ * 512 + h * 128, 512, tid); }
#endif
        }
        SEAM(P0 + 9);
        if (IN(P0 + 10)) { PH_VARS;
#if EN_XA
            ProbG P(ws + WS_XAO, 1024, 0, ws + WS_XO_T + (size_t)l * 2048 * 512 * 2, 1024, 0, 512); StaticOrder S(TT, DM, G, bid); EpiResid E{x1, V};
            pg8::gemm_phase(lds0 + RING_OFF, P, S, E, tid);
#else
            scale_rows(x1, V, gw, NGW, lane);
#endif
        }
        SEAM(P0 + 10);
        if (IN(P0 + 11)) { PH_VARS; ln_rows(V, (const float*)p.in[zz + 31] + l * DM, (const float*)p.in[zz + 32] + l * DM, x2, XB, V, gw, NGW, lane); }
        SEAM(P0 + 11);
        if (IN(P0 + 12)) { PH_VARS;
#if EN_MOE
            router_rows(p, l, wscr, x2, gw, NGW, lane);
#endif
        }
        SEAM(P0 + 12);
        if (IN(P0 + 13)) { PH_VARS;
#if EN_MOE
            moe_build_table(p, l, lds, tid);
            { volatile LAS int* tab = (volatile LAS int*)(lds + MOE_TAB_OFF); const int* tok_e = (const int*)(ws + WS_ROUTE); const float* tok_g = (const float*)(ws + WS_ROUTE + 256 * 1024);
              int* row_tok = (int*)(ws + WS_ROUTE + 512 * 1024); float* row_gate = (float*)(ws + WS_ROUTE + 768 * 1024); unsigned* ecur = ctl + CW_ECUR + l * 32; bf16* XG = (bf16*)(ws + WS_XG);
              for (int e = gw; e < 32; e += NGW) { const int cnt = tab[224 + e], st = tab[192 + e]; const int pe = ((cnt + 255) >> 8) << 8; for (int r = cnt + lane; r < pe; r += 64) row_tok[st + r] = -1; }
              for (int t = gw; t < TT; t += NGW) {
#pragma unroll
                  for (int k = 0; k < 2; ++k) { const int e = tok_e[2 * t + k]; unsigned pos = 0; if (lane == 0) pos = __hip_atomic_fetch_add(ecur + e, 1u, RLX_AGENT); pos = __builtin_amdgcn_readfirstlane(pos);
                      const int dest = tab[192 + e] + (int)pos; if (lane == 0) { row_tok[dest] = t; row_gate[dest] = tok_g[2 * t + k]; }
                      const u32x4* s = (const u32x4*)(XB + (size_t)t * DM) + lane; u32x4* d = (u32x4*)(XG + (size_t)dest * DM) + lane;
#pragma unroll
                      for (int j = 0; j < 4; ++j) d[64 * j] = s[64 * j]; } } }
#endif
        }
        SEAM(P0 + 13);
        if (IN(P0 + 14)) { PH_VARS;
#if EN_MOE
            moe_build_table(p, l, lds, tid);
            ProbG P(ws + WS_XG, DM * 2, 0, ws + WS_GU_T + (size_t)l * 32 * 1024 * 2048 * 2, DM * 2, (size_t)1024 * 2048 * 2, DM); MoeOrder S{(const volatile LAS int*)(lds + MOE_TAB_OFF), 4, G, bid}; EpiMoeGU E{(bf16*)(ws + WS_HB)};
            pg8::gemm_phase(lds0 + RING_OFF, P, S, E, tid);
#endif
        }
        SEAM(P0 + 14);
        if (IN(P0 + 15)) { PH_VARS;
#if EN_MOE
            moe_build_table(p, l, lds, tid);
            ProbG P(ws + WS_HB, 1024, 0, ws + WS_DN_T + (size_t)l * 32 * 2048 * 512 * 2, 1024, (size_t)2048 * 512 * 2, 512); MoeOrder S{(const volatile LAS int*)(lds + MOE_TAB_OFF), 8, G, bid};
            EpiMoeDown E{V, (const int*)(ws + WS_ROUTE + 512 * 1024), (const float*)(ws + WS_ROUTE + 768 * 1024)};
            pg8::gemm_phase(lds0 + RING_OFF, P, S, E, tid);
#endif
        }
        SEAM(P0 + 15);
        if (IN(P0 + 16)) { PH_VARS; ln_rows(V, (const float*)p.in[zz + 39] + l * DM, (const float*)p.in[zz + 40] + l * DM, x3, XB, nullptr, gw, NGW, lane); }
        SEAM(P0 + 16);
    }
    { constexpr int l = 1; constexpr int P0 = 1 + NPH;
        if (IN(P0 + 0)) { PH_VARS;
#if EN_MIX
            ProbG P(XB, DM * 2, 0, ws + WS_WIN_T + (size_t)l * NIN * 2048 * 2, DM * 2, 0, DM); StaticOrder S(TT, NIN, G, bid); EpiBf16 E{PROJ, NIN};
            pg8::gemm_phase(lds0 + RING_OFF, P, S, E, tid);
#endif
        }
        SEAM(P0 + 0);
        if (IN(P0 + 1)) { PH_VARS;
#if EN_MLA || EN_GDN
            ph2_token(p, l, gw, NGW, lane);
#endif
#if EN_GDN
            ph2_conv(p, l, gw, NGW, lane);
#endif
#if EN_S5
            { ProbS5 P(PROJ, ws + WS_MEND_T + (size_t)l * 32 * 256 * 512 * 2, 256); BatchOrder S(32, 2, 1, G, bid); EpiXloc E{(float*)(ws + WS_XLOC)}; pg8::gemm_phase(lds0 + RING_OFF, P, S, E, tid); }
            { ProbS5 P(PROJ, ws + WS_TOEP_T + (size_t)l * 32 * 512 * 512 * 2, 512); BatchOrder S(32, 2, 2, G, (bid + 192) % G); EpiYtoep E{(float*)(ws + WS_YTOEP)}; pg8::gemm_phase(lds0 + RING_OFF, P, S, E, tid); }
#endif
#if EN_XA
            { ProbG P(ws + WS_MEMB, DM * 2, 0, ws + WS_XKV_T + (size_t)l * 1024 * 2048 * 2, DM * 2, 0, DM); StaticOrder S(NB * MEML, 1024, G, (bid + 64) % G); EpiXaKV E{(bf16*)(ws + WS_XAK), (bf16*)(ws + WS_XAVT)};
              pg8::gemm_phase(lds0 + RING_OFF, P, S, E, tid); }
#endif
        }
        SEAM(P0 + 1);
        if (IN(P0 + 2)) { PH_VARS;
#if EN_S5
            if (bid >= G - 32) { const int q = (bid - (G - 32)) * 512 + tid;
                if (q < 8192) { const int b = q >> 11, g = (q >> 6) & 31, pp = q & 63; const float* al = (const float*)(ws + WS_MISC + 800 * 1024) + ((l * 32 + g) * 64 + pp) * 2; const float ar = al[0], ai = al[1];
                    const float* xl = (const float*)(ws + WS_XLOC) + ((size_t)g * 512 + b * 128) * 128; bf16* xs = (bf16*)(ws + WS_XSB) + ((size_t)g * 512 + b * 128) * 128; float sr = 0.f, si = 0.f;
                    for (int c = 0; c < 128; ++c) { xs[c * 128 + pp] = (bf16)f2bf(sr); xs[c * 128 + 64 + pp] = (bf16)f2bf(si); const float lr_ = xl[c * 128 + pp], li_ = xl[c * 128 + 64 + pp];
                        const float nr = ar * sr - ai * si + lr_, ni = ar * si + ai * sr + li_; sr = nr; si = ni; } } }
#endif
#if EN_MLA
            { ProbG P(ws + WS_CQN, 2048, 0, ws + WS_WUQ_T + (size_t)l * 1536 * 512 * 2, 1024, 0, 512); StaticOrder S(TT, 1536, G, bid); EpiMlaQ E{(bf16*)(ws + WS_QB), (const float*)(ws + WS_ROPE), 0.07216878364870323f * LOG2E};
              pg8::gemm_phase(lds0 + RING_OFF, P, S, E, tid); }
            { ProbG P(ws + WS_CQN + 1024, 2048, 0, ws + WS_WUKV_T + (size_t)l * 2048 * 512 * 2, 1024, 0, 512); StaticOrder S(TT, 2048, G, (bid + 128) % G); EpiMlaKV E{(bf16*)(ws + WS_KB), (bf16*)(ws + WS_VT)};
              pg8::gemm_phase(lds0 + RING_OFF, P, S, E, tid); }
#endif
#if EN_GDN
            for (int it = bid; it < 1024; it += G) gdn_pre_item(p, lds + RING_OFF, it, tid);
#endif
        }
        SEAM(P0 + 2);
        if (IN(P0 + 3)) { PH_VARS;
#if EN_GDN
            if (bid < 16) gdn_chain(p, lds + RING_OFF, bid, l, tid);
#else
            zero_mix_cols(p, 1536, 512, gw, NGW, lane);
#endif
#if EN_S5
            { ProbG P(ws + WS_XSB, 256, (size_t)512 * 256, ws + WS_MST_T + (size_t)l * 32 * 512 * 128 * 2, 256, (size_t)512 * 256, 128); BatchOrder S(32, 2, 2, G - 16, bid - 16); EpiYfin E{(const float*)(ws + WS_YTOEP), (bf16*)(ws + WS_YB)};
              pg8::gemm_phase(lds0 + RING_OFF, P, S, E, tid); }
#endif
#if EN_MLA
            { unsigned* head = ctl + CW_QUEUE + l * 64; volatile LAS int* qslot = (volatile LAS int*)(lds + MISC_OFF);
              for (;;) { __syncthreads(); if (tid == 0) qslot[0] = (int)__hip_atomic_fetch_add(head, 1u, RLX_AGENT); __syncthreads(); const int q = qslot[0]; if (q >= 512) break;
                  const int qb = 15 - (q >> 5), bh = q & 31, b = bh >> 3, h = bh & 7;
                  attn_unit<192, true>(lds + RING_OFF, (const bf16*)(ws + WS_QB) + (size_t)bh * SQ * 192, (const bf16*)(ws + WS_KB) + (size_t)bh * SQ * 192, (const bf16*)(ws + WS_VT) + (size_t)bh * 128 * SQ, SQ, qb * 256, 4 * qb + 4,
                                       (bf16*)(ws + WS_OB) + (size_t)b * SQ * 1024 + h * 128, 1024, tid); } }
#endif
        }
        SEAM(P0 + 3);
        if (IN(P0 + 4)) { PH_VARS;
#if EN_S5
            { ProbG P(ws + WS_YB, 1024, 0, ws + WS_GLU_T + (size_t)l * 512 * 512 * 2, 1024, 0, 512); StaticOrder S(TT, 512, G, bid); EpiGlu E{(const bf16*)(ws + WS_YB), (bf16*)(ws + WS_ZB), (const float*)p.in[zz + 13] + l * 512};
              pg8::gemm_phase(lds0 + RING_OFF, P, S, E, tid); }
#endif
#if EN_MLA
            mixnorm_rows(p, l, false, true, gw, NGW, lane);
#else
            zero_mix_cols(p, 512, 1024, gw, NGW, lane);
#endif
        }
        SEAM(P0 + 4);
        if (IN(P0 + 5)) { PH_VARS;
#if EN_S5
            mixnorm_rows(p, l, true, false, gw, NGW, lane);
#else
            zero_mix_cols(p, 0, 512, gw, NGW, lane);
#endif
        }
        SEAM(P0 + 5);
        if (IN(P0 + 6)) { PH_VARS;
#if EN_MIX
            ProbG P(MIX, DM * 2, 0, ws + WS_WOUT_T + (size_t)l * 2048 * 2048 * 2, DM * 2, 0, DM); StaticOrder S(TT, DM, G, bid); EpiResid E{xin, V};
            pg8::gemm_phase(lds0 + RING_OFF, P, S, E, tid);
#else
            scale_rows(xin, V, gw, NGW, lane);
#endif
        }
        SEAM(P0 + 6);
        if (IN(P0 + 7)) { PH_VARS; ln_rows(V, (const float*)p.in[zz + 25] + l * DM, (const float*)p.in[zz + 26] + l * DM, x1, XB, nullptr, gw, NGW, lane); }
        SEAM(P0 + 7);
        if (IN(P0 + 8)) { PH_VARS;
#if EN_XA
            ProbG P(XB, DM * 2, 0, ws + WS_XQ_T + (size_t)l * 512 * 2048 * 2, DM * 2, 0, DM); StaticOrder S(TT, 512, G, bid); EpiXaQ E{(bf16*)(ws + WS_XAQ), 0.08838834764831845f * LOG2E};
            pg8::gemm_phase(lds0 + RING_OFF, P, S, E, tid);
#endif
        }
        SEAM(P0 + 8);
        if (IN(P0 + 9)) { PH_VARS;
#if EN_XA
            for (int q = bid; q < 256; q += G) { const int bh = q >> 4, qb = q & 15, b = bh >> 2, h = bh & 3;
                attn_unit<128, false>(lds + RING_OFF, (const bf16*)(ws + WS_XAQ) + (size_t)bh * SQ * 128, (const bf16*)(ws + WS_XAK) + (size_t)bh * 256 * 128, (const bf16*)(ws + WS_XAVT) + (size_t)bh * 128 * 256, 256, qb * 256, 4,
                                      (bf16*)(ws + WS_XAO) + (size_t)b * SQ * 512 + h * 128, 512, tid); }
#endif
        }
        SEAM(P0 + 9);
        if (IN(P0 + 10)) { PH_VARS;
#if EN_XA
            ProbG P(ws + WS_XAO, 1024, 0, ws + WS_XO_T + (size_t)l * 2048 * 512 * 2, 1024, 0, 512); StaticOrder S(TT, DM, G, bid); EpiResid E{x1, V};
            pg8::gemm_phase(lds0 + RING_OFF, P, S, E, tid);
#else
            scale_rows(x1, V, gw, NGW, lane);
#endif
        }
        SEAM(P0 + 10);
        if (IN(P0 + 11)) { PH_VARS; ln_rows(V, (const float*)p.in[zz + 31] + l * DM, (const float*)p.in[zz + 32] + l * DM, x2, XB, V, gw, NGW, lane); }
        SEAM(P0 + 11);
        if (IN(P0 + 12)) { PH_VARS;
#if EN_MOE
            router_rows(p, l, wscr, x2, gw, NGW, lane);
#endif
        }
        SEAM(P0 + 12);
        if (IN(P0 + 13)) { PH_VARS;
#if EN_MOE
            moe_build_table(p, l, lds, tid);
            { volatile LAS int* tab = (volatile LAS int*)(lds + MOE_TAB_OFF); const int* tok_e = (const int*)(ws + WS_ROUTE); const float* tok_g = (const float*)(ws + WS_ROUTE + 256 * 1024);
              int* row_tok = (int*)(ws + WS_ROUTE + 512 * 1024); float* row_gate = (float*)(ws + WS_ROUTE + 768 * 1024); unsigned* ecur = ctl + CW_ECUR + l * 32; bf16* XG = (bf16*)(ws + WS_XG);
              for (int e = gw; e < 32; e += NGW) { const int cnt = tab[224 + e], st = tab[192 + e]; const int pe = ((cnt + 255) >> 8) << 8; for (int r = cnt + lane; r < pe; r += 64) row_tok[st + r] = -1; }
              for (int t = gw; t < TT; t += NGW) {
#pragma unroll
                  for (int k = 0; k < 2; ++k) { const int e = tok_e[2 * t + k]; unsigned pos = 0; if (lane == 0) pos = __hip_atomic_fetch_add(ecur + e, 1u, RLX_AGENT); pos = __builtin_amdgcn_readfirstlane(pos);
                      const int dest = tab[192 + e] + (int)pos; if (lane == 0) { row_tok[dest] = t; row_gate[dest] = tok_g[2 * t + k]; }
                      const u32x4* s = (const u32x4*)(XB + (size_t)t * DM) + lane; u32x4* d = (u32x4*)(XG + (size_t)dest * DM) + lane;
#pragma unroll
                      for (int j = 0; j < 4; ++j) d[64 * j] = s[64 * j]; } } }
#endif
        }
        SEAM(P0 + 13);
        if (IN(P0 + 14)) { PH_VARS;
#if EN_MOE
            moe_build_table(p, l, lds, tid);
            ProbG P(ws + WS_XG, DM * 2, 0, ws + WS_GU_T + (size_t)l * 32 * 1024 * 2048 * 2, DM * 2, (size_t)1024 * 2048 * 2, DM); MoeOrder S{(const volatile LAS int*)(lds + MOE_TAB_OFF), 4, G, bid}; EpiMoeGU E{(bf16*)(ws + WS_HB)};
            pg8::gemm_phase(lds0 + RING_OFF, P, S, E, tid);
#endif
        }
        SEAM(P0 + 14);
        if (IN(P0 + 15)) { PH_VARS;
#if EN_MOE
            moe_build_table(p, l, lds, tid);
            ProbG P(ws + WS_HB, 1024, 0, ws + WS_DN_T + (size_t)l * 32 * 2048 * 512 * 2, 1024, (size_t)2048 * 512 * 2, 512); MoeOrder S{(const volatile LAS int*)(lds + MOE_TAB_OFF), 8, G, bid};
            EpiMoeDown E{V, (const int*)(ws + WS_ROUTE + 512 * 1024), (const float*)(ws + WS_ROUTE + 768 * 1024)};
            pg8::gemm_phase(lds0 + RING_OFF, P, S, E, tid);
#endif
        }
        SEAM(P0 + 15);
        if (IN(P0 + 16)) { PH_VARS; ln_rows(V, (const float*)p.in[zz + 39] + l * DM, (const float*)p.in[zz + 40] + l * DM, x3, XB, nullptr, gw, NGW, lane); }
        SEAM(P0 + 16);
    }
#undef IN
#undef SEAM
}

#ifndef MK_PER_PHASE
#define MK_PER_PHASE 0
#endif
extern "C" void kernel_launch(void* const* d_in, const int* in_sizes, int n_in, void* d_out, int out_size, void* d_ws, size_t ws_size, hipStream_t stream) {
    static int grid = 0;
    if (grid == 0) {
        if (n_in != 41 || out_size != TT * DM || ws_size < WS_END) { fprintf(stderr, "kernel_launch: unexpected shapes (n_in %d out %d ws %zu need %zu)\n", n_in, out_size, ws_size, (size_t)WS_END); grid = -1; return; }
        int dev = 0, cus = 0, per_cu = 0;
        if (hipGetDevice(&dev) != hipSuccess || hipDeviceGetAttribute(&cus, hipDeviceAttributeMultiprocessorCount, dev) != hipSuccess) { grid = -1; return; }
        if (hipFuncSetAttribute((const void*)hybrid_fwd, hipFuncAttributeMaxDynamicSharedMemorySize, LDS_BYTES) != hipSuccess) { fprintf(stderr, "kernel_launch: hipFuncSetAttribute failed\n"); grid = -1; return; }
        if (hipOccupancyMaxActiveBlocksPerMultiprocessor(&per_cu, (const void*)hybrid_fwd, NWAVES * 64, LDS_BYTES) != hipSuccess || per_cu < 1) { fprintf(stderr, "kernel_launch: occupancy query says %d\n", per_cu); }
        (void)hipGetLastError();
        grid = cus;
    }
    if (grid < 0) return;
    (void)hipMemsetAsync((char*)d_ws + WS_CTL, 0, CTL_ZERO_BYTES, stream);
    Params p{};
    for (int i = 0; i < 41; ++i) p.in[i] = d_in[i];
    p.out = (float*)d_out; p.ws = (unsigned char*)d_ws; p.li = 0; p.pad = 0;
#if MK_PER_PHASE
    for (int ph = 0; ph < NPHASES; ++ph) { p.ph_lo = ph; p.ph_hi = ph + 1; hipLaunchKernelGGL(hybrid_fwd, dim3(grid), dim3(NWAVES * 64), LDS_BYTES, stream, p); }
#else
    p.ph_lo = 0; p.ph_hi = NPHASES;
    hipLaunchKernelGGL(hybrid_fwd, dim3(grid), dim3(NWAVES * 64), LDS_BYTES, stream, p);
#endif
    const hipError_t le = hipPeekAtLastError();
    if (le != hipSuccess) fprintf(stderr, "kernel_launch: launch failed: %s\n", hipGetErrorName(le));
}
```

```cpp
#include <hip/hip_runtime.h>
#include <cstdio>
#include <cstdint>

#define GAS __attribute__((address_space(1)))
#define LAS __attribute__((address_space(3)))
typedef unsigned short bf16;
typedef short bf16x8 __attribute__((ext_vector_type(8)));
typedef short bf16x4 __attribute__((ext_vector_type(4)));
typedef float f32x2 __attribute__((ext_vector_type(2)));
typedef float f32x4 __attribute__((ext_vector_type(4)));
typedef float f32x16 __attribute__((ext_vector_type(16)));
typedef unsigned u32x2 __attribute__((ext_vector_type(2)));
typedef unsigned u32x4 __attribute__((ext_vector_type(4)));
typedef GAS unsigned gu32;
#define RLX_AGENT __ATOMIC_RELAXED, __HIP_MEMORY_SCOPE_AGENT
#define LDS_WAIT() asm volatile("s_waitcnt lgkmcnt(0)" ::: "memory")
#define VM_WAIT() asm volatile("s_waitcnt vmcnt(0)" ::: "memory")

__device__ __forceinline__ unsigned f2bf(float f) { unsigned u = __builtin_bit_cast(unsigned, f); return (u + 0x7fffu + ((u >> 16) & 1u)) >> 16; }
typedef __bf16 bf16x2_t __attribute__((ext_vector_type(2)));
__device__ __forceinline__ unsigned pk2(float lo, float hi) { const f32x2 v = {lo, hi}; const bf16x2_t b = __builtin_convertvector(v, bf16x2_t); return __builtin_bit_cast(unsigned, b); }
__device__ __forceinline__ float bf2f(unsigned h) { return __builtin_bit_cast(float, h << 16); }
__device__ __forceinline__ float bflo(unsigned w) { return __builtin_bit_cast(float, w << 16); }
__device__ __forceinline__ float bfhi(unsigned w) { return __builtin_bit_cast(float, w & 0xffff0000u); }
__device__ __forceinline__ float wave_sum(float v) {
#pragma unroll
    for (int o = 1; o < 64; o <<= 1) v += __shfl_xor(v, o);
    return v;
}
__device__ __forceinline__ float sigmoidf_(float x) { return 1.0f / (1.0f + __expf(-x)); }
__device__ __forceinline__ float siluf_(float x) { return x / (1.0f + __expf(-x)); }
__device__ __forceinline__ float gelu_tanh(float x) { const float u = 1.5957691216057308f * (x + 0.044715f * x * x * x); return x / (1.0f + __expf(-u)); }

namespace pg8 {
constexpr int BM = 256, BK = 64, HALF = 128, HTB = HALF * BK * 2, STAGE_BYTES = 8 * HTB;
__host__ __device__ __forceinline__ int lds_byte(int r, int c) { const int st = (r >> 4) * 2 + (c >> 5), rr = r & 15, cc = c & 31, ob = rr * 64 + cc * 2; return st * 1024 + (ob ^ (((ob >> 9) & 1) << 5)); }
__host__ __device__ __forceinline__ void stage_rc(int b, int& R, int& C) { const int st = b / 1024, sb = b % 1024, swz = sb ^ (((sb >> 9) & 1) << 5); R = (st >> 1) * 16 + swz / 64; C = (st & 1) * 32 + (swz % 64) / 2; }
__host__ __device__ __forceinline__ int perm32(int rho) { const int n = rho >> 4, i = rho & 15; return 8 * (i >> 2) + 4 * n + (i & 3); }
struct Unit { int pm, pn, z; };

template <class Prob, class Epi, class Sched, bool ALIGN_EPI = true, bool GATHER = false>
__device__ __forceinline__ void gemm_phase(LAS unsigned char* lds, const Prob& P, const Sched& S, const Epi& E, const int tid, const int* row_tok = nullptr) {
    const int wid = __builtin_amdgcn_readfirstlane(tid >> 6), lane = tid & 63, wr = wid >> 2, wc = wid & 3, fr = lane & 15, fq = lane >> 4;
    const int nt = P.nt;
    unsigned voffA[2], voffB[2];
#pragma unroll
    for (int i = 0; i < 2; ++i) { int R, C; stage_rc(tid * 16 + i * 8192, R, C); const int Rb = Epi::PERM ? ((R & ~31) + perm32(R & 31)) : R;
        voffA[i] = P.a_voff(R, C); voffB[i] = P.b_voff(Rb, C); }
    const size_t kstepA = P.a_kstep, kstepB = P.b_kstep, hstepA = GATHER ? (size_t)0 : P.a_hstep, hstepB = P.b_hstep;
    unsigned gA_c[2][2], gA_n[2][2]; int gR[2], gC[2];
#pragma unroll
    for (int i = 0; i < 2; ++i) stage_rc(tid * 16 + i * 8192, gR[i], gC[i]);
#define PG8_GATHER(g, u) do { _Pragma("unroll") for (int _h = 0; _h < 2; ++_h) _Pragma("unroll") for (int _i = 0; _i < 2; ++_i) { const int ts_ = row_tok[(u).pm * 256 + _h * 128 + gR[_i]]; \
        g[_h][_i] = (unsigned)(ts_ < 0 ? 0 : (ts_ >> 1)) * P.a_rs + (unsigned)gC[_i] * 2u; } } while (0)
#define PG8_VA(h, nx) (*(GATHER ? ((nx) ? &gA_n[h] : &gA_c[h]) : &voffA))
    const unsigned ldsw = (unsigned)wid * 1024u;
    const int aoff = lds_byte(wr * 64 + fr, fq * 8), boff = lds_byte(wc * 32 + fr, fq * 8);
#define PG8_SA(b, h) (((b) * 2 + (h)) * HTB)
#define PG8_SB(b, h) ((4 + (b) * 2 + (h)) * HTB)
#define PG8_STAGE(bufoff, gbase, voff) do { _Pragma("unroll") for (int _i = 0; _i < 2; ++_i) \
        __builtin_amdgcn_global_load_lds((const unsigned*)((const char*)(gbase) + (voff)[_i]), (LAS unsigned*)(lds + (bufoff) + ldsw + _i * 8192), 16, 0, 0); } while (0)
#define PG8_LDA(dst, b, h) do { _Pragma("unroll") for (int m = 0; m < 4; ++m) _Pragma("unroll") for (int k = 0; k < 2; ++k) dst[m][k] = *(const LAS bf16x8*)(lds + PG8_SA(b, h) + aoff + m * 2048 + k * 1024); } while (0)
#define PG8_LDB(dst, b, h) do { _Pragma("unroll") for (int n = 0; n < 2; ++n) _Pragma("unroll") for (int k = 0; k < 2; ++k) dst[n][k] = *(const LAS bf16x8*)(lds + PG8_SB(b, h) + boff + n * 2048 + k * 1024); } while (0)
#define PG8_MMA(ai, bj, At, Bt) do { __builtin_amdgcn_s_setprio(1); _Pragma("unroll") for (int m = 0; m < 4; ++m) _Pragma("unroll") for (int n = 0; n < 2; ++n) _Pragma("unroll") for (int k = 0; k < 2; ++k) \
        acc[ai][bj][m][n] = __builtin_amdgcn_mfma_f32_16x16x32_bf16(Bt[n][k], At[m][k], acc[ai][bj][m][n], 0, 0, 0); __builtin_amdgcn_s_setprio(0); } while (0)
#define PG8_WAIT_V(n) asm volatile("s_waitcnt vmcnt(" #n ")" ::: "memory")
#define PG8_WAIT_L(n) asm volatile("s_waitcnt lgkmcnt(" #n ")" ::: "memory")
#define PG8_BAR __builtin_amdgcn_s_barrier()
#define PG8_SCHED __builtin_amdgcn_sched_barrier(0)
    Unit cur, nxt; int ui = 0;
    if (!S.next(0, cur)) return;
    f32x4 acc[2][2][4][2];
#pragma unroll
    for (int a = 0; a < 2; ++a)
#pragma unroll
        for (int b = 0; b < 2; ++b)
#pragma unroll
            for (int m = 0; m < 4; ++m)
#pragma unroll
                for (int n = 0; n < 2; ++n) acc[a][b][m][n] = (f32x4){0.f, 0.f, 0.f, 0.f};
    bf16x8 At[4][2], B0[2][2], B1[2][2];
    const char* cA = GATHER ? P.A : P.a_base(cur); const char* cB = P.b_base(cur);
    if constexpr (GATHER) PG8_GATHER(gA_c, cur);
    PG8_STAGE(PG8_SB(0, 0), cB, voffB); PG8_STAGE(PG8_SB(0, 1), cB + hstepB, voffB); PG8_STAGE(PG8_SA(0, 0), cA, PG8_VA(0, false)); PG8_STAGE(PG8_SA(0, 1), cA + hstepA, PG8_VA(1, false));
    if (wr == 1) PG8_BAR;
    PG8_WAIT_V(2); PG8_BAR;
    PG8_STAGE(PG8_SB(1, 0), cB + kstepB, voffB); PG8_STAGE(PG8_SA(1, 0), cA + kstepA, PG8_VA(0, false)); PG8_STAGE(PG8_SB(1, 1), cB + hstepB + kstepB, voffB);
    PG8_WAIT_V(6); PG8_BAR;
    for (;;) {
        const bool has_next = S.next(ui + 1, nxt);
        const char* nA = GATHER ? cA : (has_next ? P.a_base(nxt) : cA); const char* nB = has_next ? P.b_base(nxt) : cB;
        if constexpr (GATHER) { if (has_next) PG8_GATHER(gA_n, nxt); else { _Pragma("unroll") for (int _h = 0; _h < 2; ++_h) _Pragma("unroll") for (int _i = 0; _i < 2; ++_i) gA_n[_h][_i] = gA_c[_h][_i]; } }
        for (int t = 0; t < nt; t += 2) {
            const bool last = (t == nt - 2);
            const char* a1 = cA + (size_t)(t + 1) * kstepA;
            const char* a2 = last ? nA : cA + (size_t)(t + 2) * kstepA; const char* b2 = last ? nB : cB + (size_t)(t + 2) * kstepB;
            const char* a3 = a2 + kstepA; const char* b3 = b2 + kstepB;
            PG8_LDB(B0, 0, 0); PG8_LDB(B1, 0, 1); PG8_SCHED; PG8_LDA(At, 0, 0); PG8_STAGE(PG8_SA(1, 1), a1 + hstepA, PG8_VA(1, false));
            PG8_WAIT_V(8); PG8_WAIT_L(0); PG8_BAR; PG8_MMA(0, 0, At, B0); PG8_MMA(0, 1, At, B1); PG8_BAR; PG8_SCHED;
            PG8_LDA(At, 0, 1); PG8_STAGE(PG8_SB(0, 0), b2, voffB); PG8_STAGE(PG8_SB(0, 1), b2 + hstepB, voffB); PG8_STAGE(PG8_SA(0, 0), a2, PG8_VA(0, last));
            PG8_WAIT_V(8); PG8_WAIT_L(0); PG8_BAR; PG8_MMA(1, 0, At, B0); PG8_MMA(1, 1, At, B1); PG8_BAR; PG8_SCHED;
            PG8_LDB(B0, 1, 0); PG8_LDB(B1, 1, 1); PG8_SCHED; PG8_LDA(At, 1, 0); PG8_STAGE(PG8_SA(0, 1), a2 + hstepA, PG8_VA(1, last));
            PG8_WAIT_V(8); PG8_WAIT_L(0); PG8_BAR; PG8_MMA(0, 0, At, B0); PG8_MMA(0, 1, At, B1); PG8_BAR; PG8_SCHED;
            PG8_LDA(At, 1, 1); PG8_STAGE(PG8_SB(1, 0), b3, voffB); PG8_STAGE(PG8_SB(1, 1), b3 + hstepB, voffB); PG8_STAGE(PG8_SA(1, 0), a3, PG8_VA(0, last));
            PG8_WAIT_V(8); PG8_WAIT_L(0); PG8_BAR; PG8_MMA(1, 0, At, B0); PG8_MMA(1, 1, At, B1); PG8_BAR; PG8_SCHED;
        }
        if constexpr (ALIGN_EPI) { if (wr == 0) PG8_BAR; }
        E(acc, cur, wr, wc, fr, fq);
        if (!has_next) break;
#pragma unroll
        for (int a = 0; a < 2; ++a)
#pragma unroll
            for (int b = 0; b < 2; ++b)
#pragma unroll
                for (int m = 0; m < 4; ++m)
#pragma unroll
                    for (int n = 0; n < 2; ++n) acc[a][b][m][n] = (f32x4){0.f, 0.f, 0.f, 0.f};
        cur = nxt; cA = nA; cB = nB; ++ui;
        if constexpr (GATHER) { _Pragma("unroll") for (int _h = 0; _h < 2; ++_h) _Pragma("unroll") for (int _i = 0; _i < 2; ++_i) gA_c[_h][_i] = gA_n[_h][_i]; }
        if constexpr (ALIGN_EPI) { if (wr == 1) PG8_BAR; }
    }
    PG8_WAIT_V(0);
    if constexpr (!ALIGN_EPI) { if (wr == 0) PG8_BAR; }
    PG8_BAR;
#undef PG8_GATHER
#undef PG8_VA
#undef PG8_SA
#undef PG8_SB
#undef PG8_STAGE
#undef PG8_LDA
#undef PG8_LDB
#undef PG8_MMA
#undef PG8_WAIT_V
#undef PG8_WAIT_L
#undef PG8_BAR
#undef PG8_SCHED
}
}

#define XB_TMO      128
#define XB_XCNT(j)  (256  + 64 * (j))
#define XB_XSUB(j)  (1280 + 64 * (j))
#define XB_XGEN(j)  (2304 + 64 * (j))
#define XB_TOP      3328
#define XB_TOPGEN   3392
#define XCD_BAR_WORDS 3456
#define XB_SPIN_CAP (1u << 23)
__device__ __forceinline__ unsigned xb_ld(unsigned* p)              { return __hip_atomic_load(p, __ATOMIC_RELAXED, __HIP_MEMORY_SCOPE_AGENT); }
__device__ __forceinline__ unsigned xb_add(unsigned* p, unsigned v) { return __hip_atomic_fetch_add(p, v, __ATOMIC_RELAXED, __HIP_MEMORY_SCOPE_AGENT); }
__device__ __forceinline__ unsigned xb_xcc_id() { return (unsigned)__builtin_amdgcn_s_getreg((3 << 11) | 20) & 0xFu; }
#define XB_SPIN(cond, bar) do { unsigned _sp = 0; while (cond) { __builtin_amdgcn_s_sleep(1); \
    if ((++_sp & 255u) == 0u) { if (xb_ld(&(bar)[XB_TMO])) break; if (_sp > XB_SPIN_CAP) { atomicAdd(&(bar)[XB_TMO], 1u); break; } } } } while (0)
struct XcdBarrier { unsigned* bar; unsigned x; volatile LAS unsigned* st; };
__device__ __forceinline__ XcdBarrier xcd_barrier_post(unsigned* bar, volatile LAS unsigned* st) {
    XcdBarrier b; b.bar = bar; b.x = xb_xcc_id(); b.st = st;
    if (threadIdx.x == 0) (void)xb_add(&bar[XB_XCNT(b.x)], 1u);
    return b;
}
__device__ __forceinline__ void xcd_barrier_complete(unsigned* bar, unsigned x, unsigned& nloc, unsigned& nx) {
    const unsigned G = gridDim.x * gridDim.y * gridDim.z;
    unsigned sum, cnt, mine, sp = 0u;
    for (;;) {
        sum = 0u; cnt = 0u; mine = 0u;
#pragma unroll
        for (unsigned j = 0; j < 16; ++j) { const unsigned c = xb_ld(&bar[XB_XCNT(j)]); sum += c; cnt += (c > 0u) ? 1u : 0u; mine = (j == x) ? c : mine; }
        if (sum == G) break;
        __builtin_amdgcn_s_sleep(1);
        if ((++sp & 255u) == 0u) { if (xb_ld(&bar[XB_TMO])) break; if (sp > XB_SPIN_CAP) { atomicAdd(&bar[XB_TMO], 1u); break; } }
    }
    nloc = mine > 0u ? mine : 1u; nx = cnt > 0u ? cnt : 1u;
}
__device__ __forceinline__ void xcd_barrier(const XcdBarrier& b) {
    asm volatile("s_waitcnt vmcnt(0)" ::: "memory");
    __syncthreads();
    if (threadIdx.x == 0) {
        unsigned* bar = b.bar;
        __builtin_amdgcn_s_waitcnt(0);
        unsigned nloc = b.st[0], nx = b.st[1];
        if (nloc == 0u) { xcd_barrier_complete(bar, b.x, nloc, nx); b.st[0] = nloc; b.st[1] = nx; }
        const unsigned old = xb_add(&bar[XB_XSUB(b.x)], 1u);
        const unsigned gen = old / nloc;
        if (old + 1u == (gen + 1u) * nloc) {
            __builtin_amdgcn_fence(__ATOMIC_RELEASE, "agent");
            asm volatile("s_waitcnt vmcnt(0)" ::: "memory");
            const unsigned og = xb_add(&bar[XB_TOP], 1u);
            const unsigned tg = og / nx;
            if (og + 1u == (tg + 1u) * nx) xb_add(&bar[XB_TOPGEN], 1u);
            else XB_SPIN(xb_ld(&bar[XB_TOPGEN]) == tg, bar);
            __builtin_amdgcn_fence(__ATOMIC_ACQUIRE, "agent");
            xb_add(&bar[XB_XGEN(b.x)], 1u);
            asm volatile("s_waitcnt vmcnt(0)" ::: "memory");
        } else {
            XB_SPIN(xb_ld(&bar[XB_XGEN(b.x)]) == gen, bar);
            __builtin_amdgcn_fence(__ATOMIC_ACQUIRE, "agent");
            asm volatile("s_waitcnt vmcnt(0)" ::: "memory");
        }
    }
    __syncthreads();
}

constexpr int NL = 2, TT = 16384, DM = 2048, NB = 4, SQ = 4096, MEML = 256;
constexpr int NIN = 3840, IN_COLS = 3656;
constexpr int C_U = 0, C_CQ = 512, C_CKV = 1024, C_KR = 1536, C_GQ = 1600, C_GK = 2112, C_GV = 2624, C_GZ = 3136, C_GA = 3648, C_GB = 3652;
constexpr int S5L = 32, S5NCH = TT / S5L;
constexpr int MOE_ROWS = 40960;
constexpr float DN_ALPHA = 1.41421356237f;
constexpr float LOG2E = 1.4426950408889634f;
constexpr int NWAVES = 8;

constexpr size_t MiB = 1u << 20;
constexpr size_t WS_CTL = 0, CTL_ZERO_BYTES = 1 * MiB;
constexpr size_t WS_ROPE = 1 * MiB;
constexpr size_t WS_MISC = 5 * MiB;
constexpr size_t WS_WIN_T = 6 * MiB;
constexpr size_t WS_WUQ_T = 36 * MiB;
constexpr size_t WS_WUKV_T = 39 * MiB;
constexpr size_t WS_GLU_T = 43 * MiB;
constexpr size_t WS_WOUT_T = 44 * MiB;
constexpr size_t WS_XQ_T = 60 * MiB;
constexpr size_t WS_XKV_T = 64 * MiB;
constexpr size_t WS_XO_T = 72 * MiB;
constexpr size_t WS_TOEP_T = 76 * MiB;
constexpr size_t WS_MEND_T = 108 * MiB;
constexpr size_t WS_MST_T = 124 * MiB;
constexpr size_t WS_GU_T = 132 * MiB;
constexpr size_t WS_DN_T = 388 * MiB;
constexpr size_t WS_XF0 = 516 * MiB;
constexpr size_t WS_V = 644 * MiB;
constexpr size_t WS_XB = 772 * MiB;
constexpr size_t WS_PROJ = 836 * MiB;
constexpr size_t WS_MIX = 956 * MiB;
constexpr size_t WS_CQN = 1020 * MiB;
constexpr size_t WS_QB = 1052 * MiB;
constexpr size_t WS_KB = 1100 * MiB;
constexpr size_t WS_VT = 1148 * MiB;
constexpr size_t WS_OB = 1180 * MiB;
constexpr size_t WS_GQ = 1212 * MiB;
constexpr size_t WS_GK = 1228 * MiB;
constexpr size_t WS_GV = 1244 * MiB;
constexpr size_t WS_GDEC = 1260 * MiB;
constexpr size_t WS_GDW = 1261 * MiB;
constexpr size_t WS_GDQ = 1277 * MiB;
constexpr size_t WS_GDK = 1293 * MiB;
constexpr size_t WS_GDA = 1309 * MiB;
constexpr size_t WS_GDU = 1317 * MiB;
constexpr size_t WS_XLOC = 1349 * MiB;
constexpr size_t WS_XSB = 1357 * MiB;
constexpr size_t WS_YTOEP = 1361 * MiB;
constexpr size_t WS_YB = 1393 * MiB;
constexpr size_t WS_ZB = 1409 * MiB;
constexpr size_t WS_MEMB = 1425 * MiB;
constexpr size_t WS_XAQ = 548 * MiB;
constexpr size_t WS_XAK = 1445 * MiB;
constexpr size_t WS_XAVT = 1446 * MiB;
constexpr size_t WS_XAO = 1447 * MiB;
constexpr size_t WS_ROUTE = 1463 * MiB;
constexpr size_t WS_XG = 1464 * MiB;
constexpr size_t WS_HB = 1624 * MiB;
constexpr size_t WS_END = 1664 * MiB;

constexpr int CW_BAR = 4096;
constexpr int CW_QUEUE = 8192;
constexpr int CW_ECNT = 16384;
constexpr int CW_ECUR = 16384 + 128;

constexpr int RING_OFF = 0, RING_BYTES = 139264;
constexpr int LDSCTL_OFF = RING_BYTES, MISC_OFF = LDSCTL_OFF + 320;
constexpr int LDS_BYTES = 155648;

struct Params { const void* in[41]; float* out; unsigned char* ws; int ph_lo, ph_hi, li, pad; };

__device__ __forceinline__ int rowmap(int mode, int c) {
    if (mode == 1) { const int h = c / 192, d = c - h * 192;
        if (d < 128) return 128 * h + d;
        if (d < 160) return 1024 + 256 * (h >> 2) + 32 * (h & 3) + (d - 128);
        return 1024 + 256 * (h >> 2) + 128 + 32 * (h & 3) + (d - 160); }
    if (mode == 2) { if (c < 512) return 256 * (c >> 7) + (c & 127); c -= 512; return 256 * (c >> 7) + 128 + (c & 127); }
    return c;
}
__device__ __forceinline__ void tr_item(const float* W, int K, int N, bf16* WT, const float* kscale, int item, int lane, int mode, int row_off) {
    const int nblk = (N + 63) / 64, kb = item / nblk, nb = item - kb * nblk, k0 = 128 * kb, nq = lane & 15, kq = lane >> 4, n = 64 * nb + 4 * nq;
    if (n >= N) return;
    const float* src = W + (size_t)(k0 + 8 * kq) * N + n; f32x4 v[4][8];
#pragma unroll
    for (int b = 0; b < 4; ++b)
#pragma unroll
        for (int j = 0; j < 8; ++j) v[b][j] = *(const f32x4*)(src + (size_t)(32 * b + j) * N);
#pragma unroll
    for (int b = 0; b < 4; ++b) {
        if (kscale) {
#pragma unroll
            for (int j = 0; j < 8; ++j) v[b][j] = v[b][j] * kscale[k0 + 32 * b + 8 * kq + j]; }
#pragma unroll
        for (int i = 0; i < 4; ++i) *(u32x4*)(WT + (size_t)(row_off + rowmap(mode, n + i)) * K + k0 + 32 * b + 8 * kq) =
            (u32x4){pk2(v[b][0][i], v[b][1][i]), pk2(v[b][2][i], v[b][3][i]), pk2(v[b][4][i], v[b][5][i]), pk2(v[b][6][i], v[b][7][i])}; }
}
#define P0_JOB(IN, KK, NN, DSTOFF, DSTELEMS_PER, MODE, SCALE_IN, BATCH, ROWOFF) { \
    constexpr int per = ((KK) / 128) * (((NN) + 63) / 64); constexpr int cnt = NL * (BATCH) * per; \
    if (r < cnt) { const int lb = r / per, it = r - lb * per; \
        const float* W = (const float*)p.in[zz + IN] + (size_t)lb * (KK) * (NN); \
        bf16* WT = (bf16*)(ws + (DSTOFF)) + (size_t)lb * (DSTELEMS_PER); \
        const float* ksc = ((SCALE_IN) >= 0) ? (const float*)p.in[zz + ((SCALE_IN) < 0 ? 0 : (SCALE_IN))] + (size_t)(lb / (BATCH)) * (KK) : nullptr; \
        tr_item(W, KK, NN, WT, ksc, it, lane, MODE, ROWOFF); continue; } r -= cnt; }
__device__ __forceinline__ void p0_weights(const Params& p, int gw, int NGW, int lane) { GAS unsigned char* wsg_ = (GAS unsigned char*)p.ws; int zz = 0; asm volatile("" : "+s"(wsg_), "+s"(zz)); unsigned char* ws = (unsigned char*)wsg_;
    constexpr int per_layer = 16 * 58 + 4 * 24 + 4 * 32 + 4 * 8 + 16 * 32 + 16 * 8 + 16 * 8 + 16 * 8 + 4 * 32;
    constexpr int total = NL * per_layer;
    for (int idx = gw; idx < total; idx += NGW) {
        int r = idx;
        P0_JOB(3, 2048, IN_COLS, WS_WIN_T, (size_t)NIN * 2048, 0, -1, 1, 0)
        P0_JOB(24, 2048, 2048, WS_WOUT_T, (size_t)2048 * 2048, 0, -1, 1, 0)
        P0_JOB(16, 512, 1536, WS_WUQ_T, (size_t)1536 * 512, 1, 15, 1, 0)
        P0_JOB(18, 512, 2048, WS_WUKV_T, (size_t)2048 * 512, 0, 17, 1, 0)
        P0_JOB(12, 512, 512, WS_GLU_T, (size_t)512 * 512, 0, -1, 1, 0)
        P0_JOB(27, 2048, 512, WS_XQ_T, (size_t)512 * 2048, 0, -1, 1, 0)
        P0_JOB(28, 2048, 512, WS_XKV_T, (size_t)1024 * 2048, 0, -1, 1, 0)
        P0_JOB(29, 2048, 512, WS_XKV_T, (size_t)1024 * 2048, 0, -1, 1, 512)
        P0_JOB(30, 512, 2048, WS_XO_T, (size_t)2048 * 512, 0, -1, 1, 0)
    }
}
constexpr int MOE_CVT_ITEMS = 32 * 256 + 32 * 128;
__device__ __forceinline__ void moe_convert_item(const Params& p, int l, int idx, int lane) { GAS unsigned char* wsg_ = (GAS unsigned char*)p.ws; int zz = 0; asm volatile("" : "+s"(wsg_), "+s"(zz)); unsigned char* ws = (unsigned char*)wsg_;
    if (idx < 32 * 256) { const int e = idx >> 8, it = idx & 255; const int le = l * 32 + e;
        tr_item((const float*)p.in[zz + 37] + (size_t)le * 2048 * 1024, 2048, 1024, (bf16*)(ws + WS_GU_T) + (size_t)le * 1024 * 2048, nullptr, it, lane, 2, 0); }
    else { idx -= 32 * 256; const int e = idx >> 7, it = idx & 127; const int le = l * 32 + e;
        tr_item((const float*)p.in[zz + 38] + (size_t)le * 512 * 2048, 512, 2048, (bf16*)(ws + WS_DN_T) + (size_t)le * 2048 * 512, nullptr, it, lane, 0, 0); }
}
__device__ __forceinline__ void cvt_rows(const float* src, bf16* dst, int nrows, int gw, int NGW, int lane) {
    for (int m0 = gw; m0 < nrows; m0 += 2 * NGW) { f32x4 v[2][8];
#pragma unroll
        for (int q = 0; q < 2; ++q) { const int m = (m0 + q * NGW < nrows) ? m0 + q * NGW : m0; const f32x4* s = (const f32x4*)(src + (size_t)m * DM) + lane;
#pragma unroll
            for (int j = 0; j < 8; ++j) v[q][j] = s[64 * j]; }
#pragma unroll
        for (int q = 0; q < 2; ++q) { const int m = m0 + q * NGW; if (m >= nrows) break; u32x2* d = (u32x2*)(dst + (size_t)m * DM) + lane;
#pragma unroll
            for (int j = 0; j < 8; ++j) { u32x2 o; o.x = pk2(v[q][j].x, v[q][j].y); o.y = pk2(v[q][j].z, v[q][j].w); d[64 * j] = o; } } }
}
__device__ __forceinline__ void p0_tables(const Params& p, int gw, int NGW, int lane) { GAS unsigned char* wsg_ = (GAS unsigned char*)p.ws; int zz = 0; asm volatile("" : "+s"(wsg_), "+s"(zz)); unsigned char* ws = (unsigned char*)wsg_;
    const int* pos = (const int*)p.in[zz + 2]; float* rt = (float*)(ws + WS_ROPE);
    for (int m = gw; m < TT / 2; m += NGW) { const int t = 2 * m + (lane >> 5), i = lane & 31;
        const float inv = exp2f(-(float)i * (13.287712379549449f / 32.f)); const float ang = (float)pos[t] * inv; float sn, cs; sincosf(ang, &sn, &cs);
        ((f32x2*)rt)[(size_t)t * 32 + i] = (f32x2){cs, sn}; }
    float* wr = (float*)(ws + WS_MISC);
    for (int m = gw; m < NL * 48 * 32; m += NGW) { const int l = m / (48 * 32), rr = m - l * 48 * 32, j = rr / 32, k = (rr & 31) * 64 + lane;
        float v = 0.f; if (j < 4) v = ((const float*)p.in[zz + 33])[((size_t)l * 2048 + k) * 4 + j]; else if (j < 36) v = ((const float*)p.in[zz + 35])[((size_t)l * 2048 + k) * 32 + (j - 4)];
        wr[((size_t)l * 48 + j) * 2048 + k] = v; }
}
__device__ __forceinline__ void s5_lane_consts(const Params& p, int l, int g, int pl, float& lr, float& li, float& dt) { GAS unsigned char* wsg_ = (GAS unsigned char*)p.ws; int zz = 0; asm volatile("" : "+s"(wsg_), "+s"(zz)); unsigned char* ws = (unsigned char*)wsg_;
    lr = fminf(((const float*)p.in[zz + 4])[(l * 32 + g) * 64 + pl], -1e-4f); li = ((const float*)p.in[zz + 5])[(l * 32 + g) * 64 + pl]; dt = __expf(((const float*)p.in[zz + 6])[l * 32 + g]);
}
__device__ __forceinline__ void cpow(float lr, float li, float dt, float n, float& re, float& im) { const float mag = expf(lr * dt * n); float sn, cs; sincosf(li * dt * n, &sn, &cs); re = mag * cs; im = mag * sn; }
__device__ __forceinline__ void s5_f(float lr, float li, float dt, float& fr, float& fi) {
    float ar, ai; cpow(lr, li, dt, 1.f, ar, ai); const float den = lr * lr + li * li, nr = ar - 1.f, ni = ai; fr = (nr * lr + ni * li) / den; fi = (ni * lr - nr * li) / den;
}
__device__ __forceinline__ void p0_s5(const Params& p, LAS float* scr, int gw, int NGW, int lane) { GAS unsigned char* wsg_ = (GAS unsigned char*)p.ws; int zz = 0; asm volatile("" : "+s"(wsg_), "+s"(zz)); unsigned char* ws = (unsigned char*)wsg_;
    constexpr int PER_G = 32 + 32 + 32 + 1, total = NL * 32 * PER_G;
    for (int idx = gw; idx < total; idx += NGW) {
        const int kind = idx >> 6, lg = idx & 63, l = lg >> 5, g = lg & 31;
        float lr, li, dt; s5_lane_consts(p, l, g, lane, lr, li, dt);
        float fr, fi; s5_f(lr, li, dt, fr, fi);
        const float* bre = (const float*)p.in[zz + 7] + (size_t)(l * 32 + g) * 64 * 16; const float* bim = (const float*)p.in[zz + 8] + (size_t)(l * 32 + g) * 64 * 16;
        const float* cre = (const float*)p.in[zz + 9] + (size_t)(l * 32 + g) * 16 * 64; const float* cim = (const float*)p.in[zz + 10] + (size_t)(l * 32 + g) * 16 * 64;
        if (kind < 32) {
            const int tau = kind; float ar, ai; cpow(lr, li, dt, (float)tau, ar, ai);
            const float er = ar * fr - ai * fi, ei = ar * fi + ai * fr;
            scr[lane * 2] = er; scr[lane * 2 + 1] = ei; LDS_WAIT(); asm volatile("" ::: "memory");
            bf16* Tp = (bf16*)(ws + WS_TOEP_T) + (size_t)(l * 32 + g) * 512 * 512;
            const int hi = lane & 15, hob = lane >> 4; float acc4[4] = {0.f, 0.f, 0.f, 0.f};
#pragma unroll 1
            for (int p0 = 0; p0 < 64; p0 += 8) { float br[8], bi[8]; f32x4 cr[4][2], ci[4][2];
#pragma unroll
                for (int u = 0; u < 8; ++u) { br[u] = bre[(p0 + u) * 16 + hi]; bi[u] = bim[(p0 + u) * 16 + hi]; }
#pragma unroll
                for (int q = 0; q < 4; ++q) {
#pragma unroll
                    for (int v = 0; v < 2; ++v) { cr[q][v] = *(const f32x4*)(cre + (hob + 4 * q) * 64 + p0 + 4 * v); ci[q][v] = *(const f32x4*)(cim + (hob + 4 * q) * 64 + p0 + 4 * v); } }
#pragma unroll
                for (int u = 0; u < 8; ++u) { const float e_r = scr[(p0 + u) * 2], e_i = scr[(p0 + u) * 2 + 1];
                    const float xr = e_r * br[u] - e_i * bi[u], xi = e_r * bi[u] + e_i * br[u];
#pragma unroll
                    for (int q = 0; q < 4; ++q) acc4[q] += cr[q][u >> 2][u & 3] * xr - ci[q][u >> 2][u & 3] * xi; } }
#pragma unroll
            for (int q = 0; q < 4; ++q) { const int ho = hob + 4 * q; float acc = acc4[q];
                if (tau == 0 && ho == hi) acc += ((const float*)p.in[zz + 11])[(l * 32 + g) * 16 + ho];
                const bf16 v = (bf16)f2bf(acc);
                for (int t = tau; t < 32; ++t) Tp[(size_t)(t * 16 + ho) * 512 + (t - tau) * 16 + hi] = v;
                if (tau > 0) for (int t = 0; t + tau < 32; ++t) Tp[(size_t)(t * 16 + ho) * 512 + (t + tau) * 16 + hi] = 0; }
            LDS_WAIT(); asm volatile("" ::: "memory");
        } else if (kind < 64) {
            const int s = kind - 32; float ar, ai; cpow(lr, li, dt, (float)(31 - s), ar, ai);
            const float er = ar * fr - ai * fi, ei = ar * fi + ai * fr;
            bf16* Mp = (bf16*)(ws + WS_MEND_T) + (size_t)(l * 32 + g) * 256 * 512;
            unsigned wre[8], wim[8];
#pragma unroll
            for (int h2 = 0; h2 < 8; ++h2) { float xr[2], xi[2];
#pragma unroll
                for (int u = 0; u < 2; ++u) { const float br = bre[lane * 16 + 2 * h2 + u], bi = bim[lane * 16 + 2 * h2 + u]; xr[u] = er * br - ei * bi; xi[u] = er * bi + ei * br; }
                wre[h2] = pk2(xr[0], xr[1]); wim[h2] = pk2(xi[0], xi[1]); }
            u32x4* dr = (u32x4*)(Mp + (size_t)lane * 512 + s * 16); u32x4* di = (u32x4*)(Mp + (size_t)(64 + lane) * 512 + s * 16);
            dr[0] = (u32x4){wre[0], wre[1], wre[2], wre[3]}; dr[1] = (u32x4){wre[4], wre[5], wre[6], wre[7]};
            di[0] = (u32x4){wim[0], wim[1], wim[2], wim[3]}; di[1] = (u32x4){wim[4], wim[5], wim[6], wim[7]};
        } else if (kind < 96) {
            const int t = kind - 64; float ar, ai; cpow(lr, li, dt, (float)(t + 1), ar, ai);
            bf16* Sp = (bf16*)(ws + WS_MST_T) + (size_t)(l * 32 + g) * 512 * 128;
#pragma unroll 4
            for (int ho = 0; ho < 16; ++ho) { const float cr = cre[ho * 64 + lane], ci = cim[ho * 64 + lane];
                Sp[(size_t)(t * 16 + ho) * 128 + lane] = (bf16)f2bf(cr * ar - ci * ai); Sp[(size_t)(t * 16 + ho) * 128 + 64 + lane] = (bf16)f2bf(-(cr * ai + ci * ar)); }
        } else {
            float ar, ai; cpow(lr, li, dt, (float)S5L, ar, ai);
            float* al = (float*)(ws + WS_MISC + 800 * 1024); al[((l * 32 + g) * 64 + lane) * 2] = ar; al[((l * 32 + g) * 64 + lane) * 2 + 1] = ai;
        }
    }
}

__device__ __forceinline__ void unpack8(const u32x4 w, float (&f)[8]) { f[0] = bflo(w.x); f[1] = bfhi(w.x); f[2] = bflo(w.y); f[3] = bfhi(w.y); f[4] = bflo(w.z); f[5] = bfhi(w.z); f[6] = bflo(w.w); f[7] = bfhi(w.w); }
__device__ __forceinline__ u32x4 pack8(const float (&f)[8]) { return (u32x4){pk2(f[0], f[1]), pk2(f[2], f[3]), pk2(f[4], f[5]), pk2(f[6], f[7])}; }
template <int NR = 2> __device__ __forceinline__ void ln_rows(const bf16* V, const bf16* xres, const bf16* Y, bool has_y, const float* g, const float* b, bf16* xb, float* of, int gw, int NGW, int lane, int limit = TT) {
    for (int m0 = gw; m0 < limit; m0 += NR * NGW) {
        u32x4 ra[NR][4], ry0[NR][4], ry1[NR][4];
#pragma unroll
        for (int q = 0; q < NR; ++q) { const int m = (m0 + q * NGW < limit) ? m0 + q * NGW : m0;
#pragma unroll
            for (int j = 0; j < 4; ++j) { const size_t o = (size_t)m * DM + lane * 8 + 512 * j;
                ra[q][j] = *(const u32x4*)((xres ? xres : V) + o);
                if (xres && has_y) { ry0[q][j] = *(const u32x4*)(Y + o); ry1[q][j] = *(const u32x4*)(Y + (size_t)TT * DM + o); } } }
#pragma unroll
        for (int q = 0; q < NR; ++q) { const int m = m0 + q * NGW; if (m >= limit) break;
            float x[4][8]; float s = 0.f;
#pragma unroll
            for (int j = 0; j < 4; ++j) { unpack8(ra[q][j], x[j]);
                if (xres) {
#pragma unroll
                    for (int i = 0; i < 8; ++i) x[j][i] *= DN_ALPHA;
                    if (has_y) { float y0[8], y1[8]; unpack8(ry0[q][j], y0); unpack8(ry1[q][j], y1);
#pragma unroll
                        for (int i = 0; i < 8; ++i) x[j][i] += y0[i] + y1[i]; } }
#pragma unroll
                for (int i = 0; i < 8; ++i) s += x[j][i]; }
            const float mean = wave_sum(s) * (1.f / DM); float s2 = 0.f;
#pragma unroll
            for (int j = 0; j < 4; ++j)
#pragma unroll
                for (int i = 0; i < 8; ++i) { x[j][i] -= mean; s2 += x[j][i] * x[j][i]; }
            const float rstd = 1.0f / sqrtf(wave_sum(s2) * (1.f / DM) + 1e-5f);
#pragma unroll
            for (int j = 0; j < 4; ++j) { const int c = lane * 8 + 512 * j; const f32x4 g0 = *(const f32x4*)(g + c), g1 = *(const f32x4*)(g + c + 4), b0 = *(const f32x4*)(b + c), b1 = *(const f32x4*)(b + c + 4);
                float y[8];
#pragma unroll
                for (int i = 0; i < 4; ++i) { y[i] = x[j][i] * rstd * g0[i] + b0[i]; y[4 + i] = x[j][4 + i] * rstd * g1[i] + b1[i]; }
                if (xb) *(u32x4*)(xb + (size_t)m * DM + c) = pack8(y);
                if (of) { *(f32x4*)(of + (size_t)m * DM + c) = (f32x4){y[0], y[1], y[2], y[3]}; *(f32x4*)(of + (size_t)m * DM + c + 4) = (f32x4){y[4], y[5], y[6], y[7]}; } } }
    }
}
__device__ __forceinline__ void scale_rows(const bf16* x, bf16* v, int gw, int NGW, int lane) {
    for (int m = gw; m < TT; m += NGW) {
#pragma unroll
        for (int j = 0; j < 4; ++j) { float f[8]; unpack8(*(const u32x4*)(x + (size_t)m * DM + lane * 8 + 512 * j), f);
#pragma unroll
            for (int i = 0; i < 8; ++i) f[i] *= DN_ALPHA;
            *(u32x4*)(v + (size_t)m * DM + lane * 8 + 512 * j) = pack8(f); } }
}

__device__ __forceinline__ void ph2_token(const Params& p, int l, int gw, int NGW, int lane) { GAS unsigned char* wsg_ = (GAS unsigned char*)p.ws; int zz = 0; asm volatile("" : "+s"(wsg_), "+s"(zz)); unsigned char* ws = (unsigned char*)wsg_;
    const bf16* proj = (const bf16*)(ws + WS_PROJ); bf16* cqn = (bf16*)(ws + WS_CQN); bf16* KB = (bf16*)(ws + WS_KB);
    const f32x2* rt = (const f32x2*)(ws + WS_ROPE); float* gdec = (float*)(ws + WS_GDEC); float* gbeta = (float*)(ws + WS_GDEC + 512 * 1024);
    for (int t0 = gw; t0 < TT; t0 += 4 * NGW) {
        u32x4 rq[4][2]; unsigned short rk[4][2], rg[4][2]; f32x2 rcs[4];
#pragma unroll
        for (int q = 0; q < 4; ++q) { const int t = (t0 + q * NGW < TT) ? t0 + q * NGW : t0; const bf16* row = proj + (size_t)t * NIN;
            rq[q][0] = *(const u32x4*)(row + C_CQ + lane * 8); rq[q][1] = *(const u32x4*)(row + C_CQ + 512 + lane * 8);
            rk[q][0] = row[C_KR + (lane & 31)]; rk[q][1] = row[C_KR + 32 + (lane & 31)]; rcs[q] = rt[(size_t)t * 32 + (lane & 31)];
            rg[q][0] = row[C_GA + (lane & 3)]; rg[q][1] = row[C_GB + (lane & 3)]; }
#pragma unroll
        for (int q = 0; q < 4; ++q) { const int t = t0 + q * NGW; if (t >= TT) break;
#pragma unroll
            for (int part = 0; part < 2; ++part) { float f[8]; unpack8(rq[q][part], f); float s = 0.f;
#pragma unroll
                for (int i = 0; i < 8; ++i) s += f[i] * f[i];
                const float sc = 1.0f / sqrtf(wave_sum(s) * (1.f / 512.f) + 1e-6f);
#pragma unroll
                for (int i = 0; i < 8; ++i) f[i] *= sc;
                *(u32x4*)(cqn + (size_t)t * 1024 + part * 512 + lane * 8) = pack8(f); }
            { const float x1 = bf2f(rk[q][0]), x2 = bf2f(rk[q][1]); const f32x2 cs = rcs[q];
              const float o = (lane < 32) ? (x1 * cs.x - x2 * cs.y) : (x2 * cs.x + x1 * cs.y);
              const int b = t >> 12, s = t & 4095; const bf16 ov = (bf16)f2bf(o);
#pragma unroll
              for (int h = 0; h < 8; ++h) KB[((size_t)(b * 8 + h) * SQ + s) * 192 + 128 + lane] = ov; }
            if (lane < 4) { const float ga = bf2f(rg[q][0]), gb = bf2f(rg[q][1]);
                const float xx = ga + ((const float*)p.in[zz + 22])[l * 4 + lane]; const float sp = fmaxf(xx, 0.f) + __logf(1.0f + __expf(-fabsf(xx)));
                gdec[(size_t)t * 4 + lane] = -__expf(((const float*)p.in[zz + 21])[l * 4 + lane]) * sp; gbeta[(size_t)t * 4 + lane] = 1.0f / (1.0f + __expf(-gb)); } }
    }
}
__device__ __forceinline__ void ph2_conv(const Params& p, int l, int gw, int NGW, int lane) { GAS unsigned char* wsg_ = (GAS unsigned char*)p.ws; int zz = 0; asm volatile("" : "+s"(wsg_), "+s"(zz)); unsigned char* ws = (unsigned char*)wsg_;
    const bf16* proj = (const bf16*)(ws + WS_PROJ);
    const float* cw = (const float*)p.in[zz + 20] + (size_t)l * 4 * 1536;
    for (int it = gw; it < (TT / 8) * 3; it += NGW) {
        const int sec = it % 3, t0 = (it / 3) * 8; const int ch = sec * 512 + lane * 8;
        float w[4][8];
#pragma unroll
        for (int tp = 0; tp < 4; ++tp) { const f32x4 a = *(const f32x4*)(cw + tp * 1536 + ch), b = *(const f32x4*)(cw + tp * 1536 + ch + 4);
            w[tp][0] = a.x; w[tp][1] = a.y; w[tp][2] = a.z; w[tp][3] = a.w; w[tp][4] = b.x; w[tp][5] = b.y; w[tp][6] = b.z; w[tp][7] = b.w; }
        bf16* dst = (bf16*)(ws + (sec == 0 ? WS_GQ : (sec == 1 ? WS_GK : WS_GV)));
        float h0[8], h1[8], h2[8];
        const int s0 = t0 & 4095;
        u32x4 rr[11];
#pragma unroll
        for (int i = 0; i < 11; ++i) { const int tt = (s0 >= 3 || i >= 3) ? t0 - 3 + i : t0; rr[i] = *(const u32x4*)(proj + (size_t)tt * NIN + C_GQ + ch); }
#pragma unroll
        for (int i = 0; i < 8; ++i) { h0[i] = 0.f; h1[i] = 0.f; h2[i] = 0.f; }
        if (s0 >= 3) { unpack8(rr[0], h0); unpack8(rr[1], h1); unpack8(rr[2], h2); }
#pragma unroll
        for (int tt = 0; tt < 8; ++tt) { float x[8], y[8]; unpack8(rr[3 + tt], x); float ss = 0.f;
#pragma unroll
            for (int i = 0; i < 8; ++i) { const float c = w[0][i] * h0[i] + w[1][i] * h1[i] + w[2][i] * h2[i] + w[3][i] * x[i]; y[i] = siluf_(c); ss += y[i] * y[i]; h0[i] = h1[i]; h1[i] = h2[i]; h2[i] = x[i]; }
            if (sec < 2) { ss += __shfl_xor(ss, 1); ss += __shfl_xor(ss, 2); ss += __shfl_xor(ss, 4); ss += __shfl_xor(ss, 8);
                float sc = 1.0f / sqrtf(ss + 1e-6f); if (sec == 0) sc *= 0.08838834764831845f;
#pragma unroll
                for (int i = 0; i < 8; ++i) y[i] *= sc; }
            *(u32x4*)(dst + (size_t)(t0 + tt) * 512 + lane * 8) = pack8(y); }
    }
}
__device__ __forceinline__ void mixnorm_rows(const Params& p, int l, bool do_s5, bool do_mla, bool do_gdn, int gw, int NGW, int lane, int limit = TT) { GAS unsigned char* wsg_ = (GAS unsigned char*)p.ws; int zz = 0; asm volatile("" : "+s"(wsg_), "+s"(zz)); unsigned char* ws = (unsigned char*)wsg_;
    const bf16* zb = (const bf16*)(ws + WS_ZB); const bf16* ob = (const bf16*)(ws + WS_OB); bf16* mix = (bf16*)(ws + WS_MIX); const bf16* proj = (const bf16*)(ws + WS_PROJ);
    const float* g5 = (const float*)p.in[zz + 14] + l * 512; const float* gm = (const float*)p.in[zz + 19] + l * 1024; const float* gg = (const float*)p.in[zz + 23] + l * 128 + (lane & 15) * 8;
    for (int t0 = gw; t0 < limit; t0 += 4 * NGW) {
        u32x4 rz[4], ro[4][2], ry[4], rgz[4];
#pragma unroll
        for (int q = 0; q < 4; ++q) { const int t = (t0 + q * NGW < limit) ? t0 + q * NGW : t0;
            if (do_s5) rz[q] = *(const u32x4*)(zb + (size_t)t * 512 + lane * 8);
            if (do_mla) { ro[q][0] = *(const u32x4*)(ob + (size_t)t * 1024 + lane * 8); ro[q][1] = *(const u32x4*)(ob + (size_t)t * 1024 + 512 + lane * 8); }
            if (do_gdn) { ry[q] = *(const u32x4*)(mix + (size_t)t * DM + 1536 + lane * 8); rgz[q] = *(const u32x4*)(proj + (size_t)t * NIN + C_GZ + lane * 8); } }
#pragma unroll
        for (int q = 0; q < 4; ++q) { const int t = t0 + q * NGW; if (t >= limit) break;
            if (do_s5) { float f[8]; unpack8(rz[q], f); float s = 0.f;
#pragma unroll
                for (int i = 0; i < 8; ++i) s += f[i] * f[i];
                const float sc = 1.0f / sqrtf(wave_sum(s) * (1.f / 512.f) + 1e-6f);
#pragma unroll
                for (int i = 0; i < 8; ++i) f[i] *= sc * g5[lane * 8 + i];
                *(u32x4*)(mix + (size_t)t * DM + lane * 8) = pack8(f); }
            if (do_mla) { float f[2][8]; unpack8(ro[q][0], f[0]); unpack8(ro[q][1], f[1]); float s = 0.f;
#pragma unroll
                for (int i = 0; i < 8; ++i) s += f[0][i] * f[0][i] + f[1][i] * f[1][i];
                const float sc = 1.0f / sqrtf(wave_sum(s) * (1.f / 1024.f) + 1e-6f);
#pragma unroll
                for (int i = 0; i < 8; ++i) { f[0][i] *= sc * gm[lane * 8 + i]; f[1][i] *= sc * gm[512 + lane * 8 + i]; }
                *(u32x4*)(mix + (size_t)t * DM + 512 + lane * 8) = pack8(f[0]); *(u32x4*)(mix + (size_t)t * DM + 1024 + lane * 8) = pack8(f[1]); }
            if (do_gdn) { float y[8], z[8]; unpack8(ry[q], y); unpack8(rgz[q], z); float ss = 0.f;
#pragma unroll
                for (int i = 0; i < 8; ++i) ss += y[i] * y[i];
                ss += __shfl_xor(ss, 1); ss += __shfl_xor(ss, 2); ss += __shfl_xor(ss, 4); ss += __shfl_xor(ss, 8);
                const float rs = 1.0f / sqrtf(ss * (1.f / 128.f) + 1e-6f);
#pragma unroll
                for (int i = 0; i < 8; ++i) y[i] *= rs * gg[i] * siluf_(z[i]);
                *(u32x4*)(mix + (size_t)t * DM + 1536 + lane * 8) = pack8(y); } }
    }
}
__device__ __forceinline__ void zero_mix_cols(const Params& p, int c0, int ncols, int gw, int NGW, int lane) { GAS unsigned char* wsg_ = (GAS unsigned char*)p.ws; int zz = 0; asm volatile("" : "+s"(wsg_), "+s"(zz)); unsigned char* ws = (unsigned char*)wsg_;
    bf16* mix = (bf16*)(ws + WS_MIX); const int per = ncols / 8;
    for (int t = gw; t < TT; t += NGW) for (int i = lane; i < per; i += 64) *(u32x4*)(mix + (size_t)t * DM + c0 + i * 8) = (u32x4){0u, 0u, 0u, 0u};
}

#define MFMA32(a, b, c) __builtin_amdgcn_mfma_f32_32x32x16_bf16((a), (b), (c), 0, 0, 0)
#define MFMA16(a, b, c) __builtin_amdgcn_mfma_f32_16x16x32_bf16((a), (b), (c), 0, 0, 0)
__device__ __forceinline__ bf16x8 mk8(u32x2 lo, u32x2 hi) { const u32x4 w = {lo.x, lo.y, hi.x, hi.y}; return __builtin_bit_cast(bf16x8, w); }
template <int DK, bool CAUSAL>
__device__ __forceinline__ void attn_unit(LAS unsigned char* lds, const bf16* Qp, const bf16* Kp, const bf16* VTp, int SK, int q0, int ntiles, bf16* Op, int opitch, const int tid) {
    asm volatile("" : "+v"(lds));
    constexpr int KP = DK * 2 + 16, VP = 144, KVB = 64 * KP + 128 * VP, NKL = DK / 64;
    const int w = __builtin_amdgcn_readfirstlane(tid >> 6), lane = tid & 63, l31 = lane & 31, hl = lane >> 5;
    const int qrow = q0 + 32 * w + l31;
    bf16x8 qf[DK / 16];
#pragma unroll
    for (int s = 0; s < DK / 16; ++s) qf[s] = *(const bf16x8*)(Qp + (size_t)qrow * DK + 16 * s + 8 * hl);
    f32x16 ot[4];
#pragma unroll
    for (int d = 0; d < 4; ++d)
#pragma unroll
        for (int r = 0; r < 16; ++r) ot[d][r] = 0.f;
    float m_run = -INFINITY, l_run = 0.f;
    u32x4 kreg[NKL], vreg[2];
    int krow[NKL], kpc[NKL];
#pragma unroll
    for (int i = 0; i < NKL; ++i) { const int idx = tid + 512 * i; krow[i] = idx / (DK / 8); kpc[i] = idx - krow[i] * (DK / 8); }
#define ATT_LOAD(j) do { _Pragma("unroll") for (int i = 0; i < NKL; ++i) kreg[i] = *(const u32x4*)(Kp + (size_t)((j) * 64 + krow[i]) * DK + kpc[i] * 8); \
        _Pragma("unroll") for (int i = 0; i < 2; ++i) { const int idx = tid + 512 * i; vreg[i] = *(const u32x4*)(VTp + (size_t)(idx >> 3) * SK + (j) * 64 + (idx & 7) * 8); } } while (0)
#define ATT_STORE(buf) do { LAS unsigned char* kb_ = lds + (buf) * KVB; _Pragma("unroll") for (int i = 0; i < NKL; ++i) *(LAS u32x4*)(kb_ + krow[i] * KP + kpc[i] * 16) = kreg[i]; \
        _Pragma("unroll") for (int i = 0; i < 2; ++i) { const int idx = tid + 512 * i; *(LAS u32x4*)(kb_ + 64 * KP + (idx >> 3) * VP + (idx & 7) * 16) = vreg[i]; } } while (0)
    __syncthreads();
    ATT_LOAD(0); ATT_STORE(0);
    const int jmax = CAUSAL ? ((q0 + 32 * w + 31) >> 6) : (ntiles - 1);
#pragma unroll 1
    for (int j = 0; j < ntiles; ++j) {
        __syncthreads();
        if (j + 1 < ntiles) ATT_LOAD(j + 1);
        __builtin_amdgcn_sched_barrier(0);
        if (j <= jmax) {
            const LAS unsigned char* Kt = lds + (j & 1) * KVB; const LAS unsigned char* Vt = Kt + 64 * KP;
            f32x16 s0, s1;
#pragma unroll
            for (int r = 0; r < 16; ++r) { s0[r] = 0.f; s1[r] = 0.f; }
#pragma unroll
            for (int s = 0; s < DK / 16; ++s) { const bf16x8 a0 = *(const LAS bf16x8*)(Kt + l31 * KP + (16 * s + 8 * hl) * 2); const bf16x8 a1 = *(const LAS bf16x8*)(Kt + (32 + l31) * KP + (16 * s + 8 * hl) * 2);
                s0 = MFMA32(a0, qf[s], s0); s1 = MFMA32(a1, qf[s], s1); }
            if (CAUSAL && (j * 64 + 63 > q0 + 32 * w)) {
#pragma unroll
                for (int r = 0; r < 16; ++r) { const int key = j * 64 + (r & 3) + 8 * (r >> 2) + 4 * hl; if (key > qrow) s0[r] = -INFINITY; if (key + 32 > qrow) s1[r] = -INFINITY; }
            }
            float mx = s0[0];
#pragma unroll
            for (int r = 1; r < 16; ++r) mx = fmaxf(mx, s0[r]);
#pragma unroll
            for (int r = 0; r < 16; ++r) mx = fmaxf(mx, s1[r]);
            mx = fmaxf(mx, __shfl_xor(mx, 32));
            const float m_new = fmaxf(m_run, mx); const float alpha = __builtin_amdgcn_exp2f(m_run - m_new); m_run = m_new;
            float ps = 0.f;
#pragma unroll
            for (int r = 0; r < 16; ++r) { s0[r] = __builtin_amdgcn_exp2f(s0[r] - m_new); s1[r] = __builtin_amdgcn_exp2f(s1[r] - m_new); ps += s0[r] + s1[r]; }
            l_run = l_run * alpha + ps;
            if (__builtin_amdgcn_ballot_w64(alpha != 1.0f) != 0ull) {
#pragma unroll
                for (int d = 0; d < 4; ++d)
#pragma unroll
                    for (int r = 0; r < 16; ++r) ot[d][r] *= alpha; }
            bf16x8 pf[4];
#pragma unroll
            for (int s = 0; s < 2; ++s) { pf[s] = __builtin_bit_cast(bf16x8, (u32x4){pk2(s0[8 * s + 0], s0[8 * s + 1]), pk2(s0[8 * s + 2], s0[8 * s + 3]), pk2(s0[8 * s + 4], s0[8 * s + 5]), pk2(s0[8 * s + 6], s0[8 * s + 7])});
                pf[2 + s] = __builtin_bit_cast(bf16x8, (u32x4){pk2(s1[8 * s + 0], s1[8 * s + 1]), pk2(s1[8 * s + 2], s1[8 * s + 3]), pk2(s1[8 * s + 4], s1[8 * s + 5]), pk2(s1[8 * s + 6], s1[8 * s + 7])}); }
#pragma unroll
            for (int sp = 0; sp < 4; ++sp)
#pragma unroll
                for (int d = 0; d < 4; ++d) { const bf16x8 va = *(const LAS bf16x8*)(Vt + (32 * d + l31) * VP + 32 * sp + 16 * hl); ot[d] = MFMA32(va, pf[sp], ot[d]); }
        }
        if (j + 1 < ntiles) ATT_STORE((j + 1) & 1);
    }
    l_run += __shfl_xor(l_run, 32);
    const float inv = 1.0f / l_run;
    bf16* orow = Op + (size_t)qrow * opitch;
#pragma unroll
    for (int d = 0; d < 4; ++d)
#pragma unroll
        for (int r4 = 0; r4 < 4; ++r4) { u32x2 o; o.x = pk2(ot[d][4 * r4] * inv, ot[d][4 * r4 + 1] * inv); o.y = pk2(ot[d][4 * r4 + 2] * inv, ot[d][4 * r4 + 3] * inv);
            *(u32x2*)(orow + 32 * d + 8 * r4 + 4 * hl) = o; }
#undef ATT_LOAD
#undef ATT_STORE
}

__device__ __forceinline__ void xattn_unit(LAS unsigned char* lds, const bf16* Qp, const bf16* Kp, const bf16* VTp, int q0, bf16* Op, int opitch, const int tid) {
    asm volatile("" : "+v"(lds));
    constexpr int KP = 272, VP = 528, VOFF = 256 * KP;
    const int w = __builtin_amdgcn_readfirstlane(tid >> 6), lane = tid & 63, l31 = lane & 31, hl = lane >> 5;
    const int qrow = q0 + 32 * w + l31;
    u32x4 kreg[8], vreg[8];
#pragma unroll
    for (int i = 0; i < 8; ++i) { const int idx = tid + 512 * i; kreg[i] = *(const u32x4*)(Kp + (size_t)idx * 8); vreg[i] = *(const u32x4*)(VTp + (size_t)idx * 8); }
    bf16x8 qf[8];
#pragma unroll
    for (int s = 0; s < 8; ++s) { float f0[8], f1[8]; unpack8(*(const u32x4*)(Qp + (size_t)qrow * 128 + 16 * s + 8 * hl), f0); unpack8(*(const u32x4*)(Qp + (size_t)16 * MiB / 2 * 2 + (size_t)qrow * 128 + 16 * s + 8 * hl), f1);
#pragma unroll
        for (int i = 0; i < 8; ++i) f0[i] += f1[i];
        qf[s] = __builtin_bit_cast(bf16x8, pack8(f0)); }
    __syncthreads();
#pragma unroll
    for (int i = 0; i < 8; ++i) { const int idx = tid + 512 * i; *(LAS u32x4*)(lds + (idx >> 4) * KP + (idx & 15) * 16) = kreg[i];
        *(LAS u32x4*)(lds + VOFF + (idx >> 5) * VP + (idx & 31) * 16) = vreg[i]; }
    __syncthreads();
    f32x16 ot[4];
#pragma unroll
    for (int d = 0; d < 4; ++d)
#pragma unroll
        for (int r = 0; r < 16; ++r) ot[d][r] = 0.f;
    float m_run = -INFINITY, l_run = 0.f;
#pragma unroll 1
    for (int j = 0; j < 4; ++j) {
        const LAS unsigned char* Kt = lds + j * 64 * KP; const LAS unsigned char* Vt = lds + VOFF + j * 128;
        f32x16 s0, s1;
#pragma unroll
        for (int r = 0; r < 16; ++r) { s0[r] = 0.f; s1[r] = 0.f; }
#pragma unroll
        for (int s = 0; s < 8; ++s) { const bf16x8 a0 = *(const LAS bf16x8*)(Kt + l31 * KP + (16 * s + 8 * hl) * 2); const bf16x8 a1 = *(const LAS bf16x8*)(Kt + (32 + l31) * KP + (16 * s + 8 * hl) * 2);
            s0 = MFMA32(a0, qf[s], s0); s1 = MFMA32(a1, qf[s], s1); }
        float mx = s0[0];
#pragma unroll
        for (int r = 1; r < 16; ++r) mx = fmaxf(mx, s0[r]);
#pragma unroll
        for (int r = 0; r < 16; ++r) mx = fmaxf(mx, s1[r]);
        mx = fmaxf(mx, __shfl_xor(mx, 32));
        const float m_new = fmaxf(m_run, mx); const float alpha = __builtin_amdgcn_exp2f(m_run - m_new); m_run = m_new;
        float ps = 0.f;
#pragma unroll
        for (int r = 0; r < 16; ++r) { s0[r] = __builtin_amdgcn_exp2f(s0[r] - m_new); s1[r] = __builtin_amdgcn_exp2f(s1[r] - m_new); ps += s0[r] + s1[r]; }
        l_run = l_run * alpha + ps;
#pragma unroll
        for (int d = 0; d < 4; ++d)
#pragma unroll
            for (int r = 0; r < 16; ++r) ot[d][r] *= alpha;
        bf16x8 pf[4];
#pragma unroll
        for (int s = 0; s < 2; ++s) { pf[s] = __builtin_bit_cast(bf16x8, (u32x4){pk2(s0[8 * s + 0], s0[8 * s + 1]), pk2(s0[8 * s + 2], s0[8 * s + 3]), pk2(s0[8 * s + 4], s0[8 * s + 5]), pk2(s0[8 * s + 6], s0[8 * s + 7])});
            pf[2 + s] = __builtin_bit_cast(bf16x8, (u32x4){pk2(s1[8 * s + 0], s1[8 * s + 1]), pk2(s1[8 * s + 2], s1[8 * s + 3]), pk2(s1[8 * s + 4], s1[8 * s + 5]), pk2(s1[8 * s + 6], s1[8 * s + 7])}); }
#pragma unroll
        for (int sp = 0; sp < 4; ++sp)
#pragma unroll
            for (int d = 0; d < 4; ++d) { const bf16x8 va = *(const LAS bf16x8*)(Vt + (32 * d + l31) * VP + 32 * sp + 16 * hl); ot[d] = MFMA32(va, pf[sp], ot[d]); }
    }
    l_run += __shfl_xor(l_run, 32);
    const float inv = 1.0f / l_run;
    bf16* orow = Op + (size_t)qrow * opitch;
#pragma unroll
    for (int d = 0; d < 4; ++d)
#pragma unroll
        for (int r4 = 0; r4 < 4; ++r4) { u32x2 o; o.x = pk2(ot[d][4 * r4] * inv, ot[d][4 * r4 + 1] * inv); o.y = pk2(ot[d][4 * r4 + 2] * inv, ot[d][4 * r4 + 3] * inv);
            *(u32x2*)(orow + 32 * d + 8 * r4 + 4 * hl) = o; }
}

constexpr int GP_K = 0, GP_Q = 17408, GP_KT = 34816, GP_VT = 53248, GP_L = 71680, GP_TB = 89088, GP_TBG = 98304, GP_GC = 107520, GP_BETA = 107776, GP_END = 108032;
template <int I> struct FsRow {
    static __device__ __forceinline__ void run(float (&tcol)[64], LAS float* Lmb, LAS unsigned char* lds, const float lanef, const int lane, const float bj, const float bgj) {
        constexpr int N4 = (I + 3) / 4, NA = N4 < 12 ? N4 : 12;
        f32x4 lrow[12];
#pragma unroll
        for (int m4 = 0; m4 < NA; ++m4) lrow[m4] = *(const LAS f32x4*)(Lmb + I * 68 + 4 * m4);
        __builtin_amdgcn_sched_barrier(0);
        float a0 = fmaxf(0.f, 1.f - fabsf((float)I - lanef)), a1 = 0.f, a2 = 0.f, a3 = 0.f;
#pragma unroll
        for (int m4 = 0; m4 < NA; ++m4) { const f32x4 lv = lrow[m4];
            if (4 * m4 + 0 < I) a0 -= lv.x * tcol[4 * m4 + 0]; if (4 * m4 + 1 < I) a1 -= lv.y * tcol[4 * m4 + 1]; if (4 * m4 + 2 < I) a2 -= lv.z * tcol[4 * m4 + 2]; if (4 * m4 + 3 < I) a3 -= lv.w * tcol[4 * m4 + 3]; }
        if constexpr (N4 > 12) {
#pragma unroll
            for (int m4 = 12; m4 < N4; ++m4) lrow[m4 - 12] = *(const LAS f32x4*)(Lmb + I * 68 + 4 * m4);
            __builtin_amdgcn_sched_barrier(0);
#pragma unroll
            for (int m4 = 12; m4 < N4; ++m4) { const f32x4 lv = lrow[m4 - 12];
                if (4 * m4 + 0 < I) a0 -= lv.x * tcol[4 * m4 + 0]; if (4 * m4 + 1 < I) a1 -= lv.y * tcol[4 * m4 + 1]; if (4 * m4 + 2 < I) a2 -= lv.z * tcol[4 * m4 + 2]; if (4 * m4 + 3 < I) a3 -= lv.w * tcol[4 * m4 + 3]; } }
        const float acc = (a0 + a1) + (a2 + a3); tcol[I] = acc;
        *(LAS bf16*)(lds + GP_TB + I * 144 + lane * 2) = (bf16)f2bf(acc * bj); *(LAS bf16*)(lds + GP_TBG + I * 144 + lane * 2) = (bf16)f2bf(acc * bgj);
        __builtin_amdgcn_sched_barrier(0);
        FsRow<I + 1>::run(tcol, Lmb, lds, lanef, lane, bj, bgj); } };
template <> struct FsRow<64> { static __device__ __forceinline__ void run(float (&)[64], LAS float*, LAS unsigned char*, float, int, float, float) {} };
__device__ __forceinline__ void gdn_pre_item(const Params& p, LAS unsigned char* lds, int item, const int tid, u32x4 (&pre)[6], int next_item) { asm volatile("" : "+v"(lds)); GAS unsigned char* wsg_ = (GAS unsigned char*)p.ws; int zz = 0; asm volatile("" : "+s"(wsg_), "+s"(zz)); unsigned char* ws = (unsigned char*)wsg_;
    const int w = __builtin_amdgcn_readfirstlane(tid >> 6), lane = tid & 63, fr = lane & 15, fq = lane >> 4;
    const int bh = item >> 6, n = item & 63, b = bh >> 2, h = bh & 3; const int t0 = b * SQ + n * 64;
    const bf16* gq = (const bf16*)(ws + WS_GQ); const bf16* gk = (const bf16*)(ws + WS_GK); const bf16* gv = (const bf16*)(ws + WS_GV);
    const float* gdec = (const float*)(ws + WS_GDEC); const float* gbeta = (const float*)(ws + WS_GDEC + 512 * 1024); float* glp = (float*)(ws + WS_GDEC + 768 * 1024);
    LAS float* gc = (LAS float*)(lds + GP_GC); LAS float* beta = (LAS float*)(lds + GP_BETA); LAS float* Lm = (LAS float*)(lds + GP_L);
    __syncthreads();
#pragma unroll
    for (int i = 0; i < 2; ++i) { const int idx = tid + 512 * i, c = idx >> 4, pc = idx & 15;
        const u32x4 kq = pre[3 * i], qq = pre[3 * i + 1], vq = pre[3 * i + 2];
        *(LAS u32x4*)(lds + GP_K + c * 272 + pc * 16) = kq; *(LAS u32x4*)(lds + GP_Q + c * 272 + pc * 16) = qq;
        const unsigned kk[4] = {kq.x, kq.y, kq.z, kq.w}, vv[4] = {vq.x, vq.y, vq.z, vq.w};
#pragma unroll
        for (int e = 0; e < 4; ++e) { *(LAS bf16*)(lds + GP_KT + (pc * 8 + 2 * e) * 144 + c * 2) = (bf16)(kk[e] & 0xffffu); *(LAS bf16*)(lds + GP_KT + (pc * 8 + 2 * e + 1) * 144 + c * 2) = (bf16)(kk[e] >> 16);
            *(LAS bf16*)(lds + GP_VT + (pc * 8 + 2 * e) * 144 + c * 2) = (bf16)(vv[e] & 0xffffu); *(LAS bf16*)(lds + GP_VT + (pc * 8 + 2 * e + 1) * 144 + c * 2) = (bf16)(vv[e] >> 16); } }
    if (next_item >= 0) { const int bh2 = next_item >> 6, n2 = next_item & 63, b2 = bh2 >> 2, h2 = bh2 & 3; const int t2 = b2 * SQ + n2 * 64;
#pragma unroll
        for (int i = 0; i < 2; ++i) { const int idx = tid + 512 * i, c = idx >> 4, pc = idx & 15; const size_t go = (size_t)(t2 + c) * 512 + h2 * 128 + pc * 8;
            pre[3 * i] = *(const u32x4*)(gk + go); pre[3 * i + 1] = *(const u32x4*)(gq + go); pre[3 * i + 2] = *(const u32x4*)(gv + go); } }
    __builtin_amdgcn_sched_barrier(0);
    if (tid < 64) { float g = gdec[(size_t)(t0 + tid) * 4 + h];
#pragma unroll
        for (int o = 1; o < 64; o <<= 1) { const float y = __shfl_up(g, o); if (tid >= o) g += y; }
        gc[tid] = g; beta[tid] = gbeta[(size_t)(t0 + tid) * 4 + h]; if (tid == 63) glp[item] = __expf(g); }
    __syncthreads();
    {
        const int tc = w >> 1; bf16* ga = (bf16*)(ws + WS_GDA) + (size_t)item * 4096;
#pragma unroll
        for (int u = 0; u < 2; ++u) { const int tj = 2 * (w & 1) + u; f32x4 kk = {0.f, 0.f, 0.f, 0.f}, qk = {0.f, 0.f, 0.f, 0.f};
            if (tj <= tc) {
#pragma unroll
                for (int s = 0; s < 4; ++s) { const bf16x8 bk = *(const LAS bf16x8*)(lds + GP_K + (16 * tj + fr) * 272 + (32 * s + 8 * fq) * 2);
                    const bf16x8 ak = *(const LAS bf16x8*)(lds + GP_K + (16 * tc + fr) * 272 + (32 * s + 8 * fq) * 2); const bf16x8 aq = *(const LAS bf16x8*)(lds + GP_Q + (16 * tc + fr) * 272 + (32 * s + 8 * fq) * 2);
                    kk = MFMA16(ak, bk, kk); qk = MFMA16(aq, bk, qk); } }
            const int j = 16 * tj + fr; const float gj = gc[j];
#pragma unroll
            for (int r = 0; r < 4; ++r) { const int c = 16 * tc + 4 * fq + r; const float dec = (j <= c) ? __expf(gc[c] - gj) : 0.f;
                Lm[c * 68 + j] = (j < c) ? kk[r] * dec * beta[c] : 0.f; ga[c * 64 + j] = (bf16)f2bf((j <= c) ? qk[r] * dec : 0.f); } }
    }
    __syncthreads();
    if (w == 0) {
        float tcol[64]; const float bj = beta[lane], bgj = bj * __expf(gc[lane]);
        float lanef = (float)lane; asm volatile("" : "+v"(lanef));
        LAS float* Lmb = Lm; asm volatile("" : "+v"(Lmb));
        FsRow<0>::run(tcol, Lmb, lds, lanef, lane, bj, bgj);
    } else {
        bf16* gqd = (bf16*)(ws + WS_GDQ) + (size_t)item * 8192; bf16* gke = (bf16*)(ws + WS_GDK) + (size_t)item * 8192; const float glast = gc[63];
        for (int idx = tid - 64; idx < 1024; idx += 448) { const int c = idx >> 4, pc = idx & 15; float f[8]; unpack8(*(const LAS u32x4*)(lds + GP_Q + c * 272 + pc * 16), f); const float e = __expf(gc[c]);
#pragma unroll
            for (int i = 0; i < 8; ++i) f[i] *= e;
            *(u32x4*)(gqd + c * 128 + pc * 8) = pack8(f); }
        for (int idx = tid - 64; idx < 1024; idx += 448) { const int d = idx >> 3, pc = idx & 7; float f[8]; const LAS unsigned char* src = lds + GP_KT + d * 144 + pc * 16;
            unpack8((u32x4){*(const LAS unsigned*)src, *(const LAS unsigned*)(src + 4), *(const LAS unsigned*)(src + 8), *(const LAS unsigned*)(src + 12)}, f);
#pragma unroll
            for (int i = 0; i < 8; ++i) f[i] *= __expf(glast - gc[pc * 8 + i]);
            *(u32x4*)(gke + d * 64 + pc * 8) = pack8(f); }
    }
    __syncthreads();
    {
        bf16* gu = (bf16*)(ws + WS_GDU) + (size_t)item * 8192; bf16* gw_ = (bf16*)(ws + WS_GDW) + (size_t)item * 8192;
        bf16x8 bv[2], bk[2];
#pragma unroll
        for (int s = 0; s < 2; ++s) { const LAS unsigned char* pv = lds + GP_VT + (16 * w + fr) * 144 + (32 * s + 8 * fq) * 2; const LAS unsigned char* pk = lds + GP_KT + (16 * w + fr) * 144 + (32 * s + 8 * fq) * 2;
            bv[s] = __builtin_bit_cast(bf16x8, *(const LAS u32x4*)pv); bk[s] = __builtin_bit_cast(bf16x8, *(const LAS u32x4*)pk); }
#pragma unroll
        for (int tc = 0; tc < 4; ++tc) { f32x4 uu = {0.f, 0.f, 0.f, 0.f}, ww = {0.f, 0.f, 0.f, 0.f};
#pragma unroll
            for (int s = 0; s < 2; ++s) { const bf16x8 a1 = __builtin_bit_cast(bf16x8, *(const LAS u32x4*)(lds + GP_TB + (16 * tc + fr) * 144 + (32 * s + 8 * fq) * 2));
                const bf16x8 a2 = __builtin_bit_cast(bf16x8, *(const LAS u32x4*)(lds + GP_TBG + (16 * tc + fr) * 144 + (32 * s + 8 * fq) * 2));
                uu = MFMA16(a1, bv[s], uu); ww = MFMA16(a2, bk[s], ww); }
            *(u32x2*)(gu + ((w * 4 + tc) * 64 + lane) * 4) = (u32x2){pk2(uu[0], uu[1]), pk2(uu[2], uu[3])};
#pragma unroll
            for (int r = 0; r < 4; ++r) gw_[(16 * tc + 4 * fq + r) * 128 + 16 * w + fr] = (bf16)f2bf(-ww[r]); }
    }
}

constexpr int GC_W = 0, GC_Q = 17408, GC_A = 34816, GC_KE = 44032, GC_BUF = 62464;
__device__ __forceinline__ void gdn_chain(const Params& p, LAS unsigned char* lds, int bh, int l, const int tid) { asm volatile("" : "+v"(lds)); GAS unsigned char* wsg_ = (GAS unsigned char*)p.ws; int zz = 0; asm volatile("" : "+s"(wsg_), "+s"(zz)); unsigned char* ws = (unsigned char*)wsg_;
    const int w = __builtin_amdgcn_readfirstlane(tid >> 6), lane = tid & 63, fr = lane & 15, fq = lane >> 4;
    const int b = bh >> 2, h = bh & 3;
    const bf16* gW = (const bf16*)(ws + WS_GDW) + (size_t)bh * 64 * 8192; const bf16* gQ = (const bf16*)(ws + WS_GDQ) + (size_t)bh * 64 * 8192;
    const bf16* gA = (const bf16*)(ws + WS_GDA) + (size_t)bh * 64 * 4096; const bf16* gK = (const bf16*)(ws + WS_GDK) + (size_t)bh * 64 * 8192;
    __syncthreads();
    if (w >= 4) {
        const int lt = tid - 256; const size_t lo = (size_t)((unsigned)lt * 8u);
        u32x4 rgA[14], rgB[14];
#define GC_LOAD(rg, n) do { const bf16* w_ = gW + (size_t)(n) * 8192 + lo; const bf16* q_ = gQ + (size_t)(n) * 8192 + lo; const bf16* a_ = gA + (size_t)(n) * 4096 + lo; const bf16* k_ = gK + (size_t)(n) * 8192 + lo; \
            _Pragma("unroll") for (int i = 0; i < 4; ++i) { rg[i] = *(const u32x4*)(w_ + i * 2048); rg[4 + i] = *(const u32x4*)(q_ + i * 2048); rg[10 + i] = *(const u32x4*)(k_ + i * 2048); } \
            rg[8] = *(const u32x4*)a_; rg[9] = *(const u32x4*)(a_ + 2048); } while (0)
#define GC_STORE(rg, buf) do { LAS unsigned char* b_ = lds + (buf) * GC_BUF; \
            _Pragma("unroll") for (int i = 0; i < 4; ++i) { const int pc_ = i * 256 + lt; *(LAS u32x4*)(b_ + GC_W + (pc_ >> 4) * 272 + (pc_ & 15) * 16) = rg[i]; *(LAS u32x4*)(b_ + GC_Q + (pc_ >> 4) * 272 + (pc_ & 15) * 16) = rg[4 + i]; \
                *(LAS u32x4*)(b_ + GC_KE + (pc_ >> 3) * 144 + (pc_ & 7) * 16) = rg[10 + i]; } \
            _Pragma("unroll") for (int i = 0; i < 2; ++i) { const int pc_ = i * 256 + lt; *(LAS u32x4*)(b_ + GC_A + (pc_ >> 3) * 144 + (pc_ & 7) * 16) = rg[8 + i]; } } while (0)
        GC_LOAD(rgA, 0); GC_STORE(rgA, 0); GC_LOAD(rgA, 1); GC_LOAD(rgB, 2);
#pragma unroll 1
        for (int n = 0; n < 64; n += 2) {
            __syncthreads();
            GC_STORE(rgA, 1); GC_LOAD(rgA, (n + 3 < 64) ? n + 3 : 63); __builtin_amdgcn_sched_barrier(0);
            __syncthreads();
            GC_STORE(rgB, 0); GC_LOAD(rgB, (n + 4 < 64) ? n + 4 : 63); __builtin_amdgcn_sched_barrier(0);
        }
#undef GC_LOAD
#undef GC_STORE
    } else {
        const bf16* gU = (const bf16*)(ws + WS_GDU) + (size_t)bh * 64 * 8192 + (size_t)((unsigned)(2 * w * 4 * 64 + lane) * 4u);
        const float glv = ((const float*)(ws + WS_GDEC + 768 * 1024))[bh * 64 + lane];
        unsigned char* ybase_u = ws + WS_MIX + ((size_t)b * SQ * DM + 1536 + h * 128 + 32 * w) * 2; const unsigned yoff = (unsigned)(fr * DM + 4 * fq) * 2u;
#define YST(row, ct, lo_, hi_) (*(u32x2*)(ybase_u + (size_t)(row) * (DM * 2) + (size_t)(yoff + 32u * (ct))) = (u32x2){(lo_), (hi_)})
        f32x4 S[2][8];
#pragma unroll
        for (int ct = 0; ct < 2; ++ct)
#pragma unroll
            for (int t = 0; t < 8; ++t) S[ct][t] = (f32x4){0.f, 0.f, 0.f, 0.f};
        u32x2 unA[2][4], unB[2][4]; unsigned yprev[2][8];
#pragma unroll
        for (int ct = 0; ct < 2; ++ct)
#pragma unroll
            for (int i = 0; i < 8; ++i) yprev[ct][i] = 0u;
#define GC_LOADU(un, n) do { _Pragma("unroll") for (int ct = 0; ct < 2; ++ct) _Pragma("unroll") for (int t = 0; t < 4; ++t) un[ct][t] = *(const u32x2*)(gU + (size_t)(n) * 8192 + ct * 1024 + t * 256); } while (0)
#define GC_STEP(n, BUF, UN) do { \
            __syncthreads(); \
            f32x4 vn[2][4], o[2][4]; \
            _Pragma("unroll") for (int ct = 0; ct < 2; ++ct) _Pragma("unroll") for (int t = 0; t < 4; ++t) { vn[ct][t] = (f32x4){bflo(UN[ct][t].x), bfhi(UN[ct][t].x), bflo(UN[ct][t].y), bfhi(UN[ct][t].y)}; o[ct][t] = (f32x4){0.f, 0.f, 0.f, 0.f}; } \
            { const int n2_ = ((n) + 2 < 64) ? (n) + 2 : 63; GC_LOADU(UN, n2_); } \
            __builtin_amdgcn_sched_barrier(0); \
            { const int np_ = ((n) > 0) ? (n) - 1 : 0; _Pragma("unroll") for (int ct = 0; ct < 2; ++ct) _Pragma("unroll") for (int t = 0; t < 4; ++t) \
                YST(np_ * 64 + 16 * t, ct, yprev[ct][2 * t], yprev[ct][2 * t + 1]); } \
            const LAS unsigned char* B_ = lds + (BUF) * GC_BUF; \
            _Pragma("unroll") for (int s = 0; s < 4; ++s) { bf16x8 sbs[2]; \
              _Pragma("unroll") for (int ct = 0; ct < 2; ++ct) sbs[ct] = __builtin_bit_cast(bf16x8, (u32x4){pk2(S[ct][2 * s][0], S[ct][2 * s][1]), pk2(S[ct][2 * s][2], S[ct][2 * s][3]), pk2(S[ct][2 * s + 1][0], S[ct][2 * s + 1][1]), pk2(S[ct][2 * s + 1][2], S[ct][2 * s + 1][3])}); \
              _Pragma("unroll") for (int t = 0; t < 4; ++t) { \
                const LAS unsigned char* pw = B_ + GC_W + (16 * t + fr) * 272 + (32 * s + 4 * fq) * 2; const LAS unsigned char* pq = B_ + GC_Q + (16 * t + fr) * 272 + (32 * s + 4 * fq) * 2; \
                const bf16x8 aw = mk8(*(const LAS u32x2*)pw, *(const LAS u32x2*)(pw + 32)); const bf16x8 aq = mk8(*(const LAS u32x2*)pq, *(const LAS u32x2*)(pq + 32)); \
                _Pragma("unroll") for (int ct = 0; ct < 2; ++ct) { vn[ct][t] = MFMA16(aw, sbs[ct], vn[ct][t]); o[ct][t] = MFMA16(sbs[ct], aq, o[ct][t]); } \
                if (t == 3) __builtin_amdgcn_sched_barrier(0); } } \
            bf16x8 vb[2][2]; \
            _Pragma("unroll") for (int ct = 0; ct < 2; ++ct) _Pragma("unroll") for (int s = 0; s < 2; ++s) vb[ct][s] = __builtin_bit_cast(bf16x8, (u32x4){pk2(vn[ct][2 * s][0], vn[ct][2 * s][1]), pk2(vn[ct][2 * s][2], vn[ct][2 * s][3]), pk2(vn[ct][2 * s + 1][0], vn[ct][2 * s + 1][1]), pk2(vn[ct][2 * s + 1][2], vn[ct][2 * s + 1][3])}); \
            _Pragma("unroll") for (int s = 0; s < 2; ++s) _Pragma("unroll") for (int t = 0; t < 4; ++t) { \
                const LAS unsigned char* pa = B_ + GC_A + (16 * t + fr) * 144 + (32 * s + 4 * fq) * 2; const bf16x8 aa = mk8(*(const LAS u32x2*)pa, *(const LAS u32x2*)(pa + 32)); \
                _Pragma("unroll") for (int ct = 0; ct < 2; ++ct) o[ct][t] = MFMA16(vb[ct][s], aa, o[ct][t]); if (t == 3) __builtin_amdgcn_sched_barrier(0); } \
            const float gl = __builtin_bit_cast(float, __builtin_amdgcn_readlane(__builtin_bit_cast(int, glv), (n))); \
            _Pragma("unroll") for (int ct = 0; ct < 2; ++ct) _Pragma("unroll") for (int t = 0; t < 8; ++t) S[ct][t] = S[ct][t] * gl; \
            _Pragma("unroll") for (int s = 0; s < 2; ++s) _Pragma("unroll") for (int t = 0; t < 8; ++t) { \
                const LAS unsigned char* pk = B_ + GC_KE + (16 * t + fr) * 144 + (32 * s + 4 * fq) * 2; const bf16x8 ak = mk8(*(const LAS u32x2*)pk, *(const LAS u32x2*)(pk + 32)); \
                _Pragma("unroll") for (int ct = 0; ct < 2; ++ct) S[ct][t] = MFMA16(ak, vb[ct][s], S[ct][t]); if ((t & 3) == 3) __builtin_amdgcn_sched_barrier(0); } \
            _Pragma("unroll") for (int ct = 0; ct < 2; ++ct) _Pragma("unroll") for (int t = 0; t < 4; ++t) { yprev[ct][2 * t] = pk2(o[ct][t][0], o[ct][t][1]); yprev[ct][2 * t + 1] = pk2(o[ct][t][2], o[ct][t][3]); } \
        } while (0)
        GC_LOADU(unA, 0); GC_LOADU(unB, 1);
#pragma unroll 1
        for (int n = 0; n < 64; n += 2) { GC_STEP(n, 0, unA); GC_STEP(n + 1, 1, unB); }
#pragma unroll
        for (int ct = 0; ct < 2; ++ct)
#pragma unroll
            for (int t = 0; t < 4; ++t) YST(63 * 64 + 16 * t, ct, yprev[ct][2 * t], yprev[ct][2 * t + 1]);
#undef YST
#undef GC_LOADU
#undef GC_STEP
    }
}

__device__ __forceinline__ void router_rows(const Params& p, int l, LAS unsigned char* lds, bf16* x2, int bid, int G, const int tid, const bf16* LNV = nullptr, const float* lng = nullptr, const float* lnb = nullptr) { GAS unsigned char* wsg_ = (GAS unsigned char*)p.ws; int zz = 0; asm volatile("" : "+s"(wsg_), "+s"(zz)); unsigned char* ws = (unsigned char*)wsg_; asm volatile("" : "+v"(lds));
    const int wave = __builtin_amdgcn_readfirstlane(tid >> 6), lane = tid & 63, fr = lane & 15, fq = lane >> 4;
    const float* wr = (const float*)(ws + WS_MISC) + (size_t)l * 48 * 2048;
    int* tok_e = (int*)(ws + WS_ROUTE); float* tok_g = (float*)(ws + WS_ROUTE + 256 * 1024); int* ccnt = (int*)(ws + WS_MISC + 900 * 1024);
    const float* bg = (const float*)p.in[zz + 34] + l * 4; const float* be = (const float*)p.in[zz + 36] + l * 32;
    LAS float* scr = (LAS float*)(lds + wave * 13312);
    LAS float* sum = (LAS float*)(lds + 8 * 13312);
    LAS int* lcnt = (LAS int*)(lds + 8 * 13312 + 10240);
    for (int ch = bid; ch < TT / 64; ch += G) {
        if (tid < 32) lcnt[tid] = 0;
        const int tok0 = ch * 64;
        if (LNV) { const int r0 = tok0 + wave * 8; ln_rows<4>(LNV, nullptr, nullptr, false, lng, lnb, x2, nullptr, r0, 1, lane, r0 + 8); asm volatile("s_waitcnt vmcnt(0)" ::: "memory"); __syncthreads(); }
        f32x4 acc[4][3];
#pragma unroll
        for (int rt = 0; rt < 4; ++rt)
#pragma unroll
            for (int nt = 0; nt < 3; ++nt) acc[rt][nt] = (f32x4){0.f, 0.f, 0.f, 0.f};
        const bf16* xa = x2 + (size_t)(tok0 + fr) * DM + wave * 256 + 4 * fq; const float* wb = wr + (size_t)fr * 2048 + wave * 256 + 4 * fq;
        f32x4 a[4][4], b[4][3];
#define RT_LOAD(buf, i) do { _Pragma("unroll") for (int rt = 0; rt < 4; ++rt) { const u32x2 xw_ = *(const u32x2*)(xa + (size_t)rt * 16 * DM + 16 * (i)); a[buf][rt] = (f32x4){bflo(xw_.x), bfhi(xw_.x), bflo(xw_.y), bfhi(xw_.y)}; } \
            _Pragma("unroll") for (int nt = 0; nt < 3; ++nt) b[buf][nt] = *(const f32x4*)(wb + (size_t)nt * 16 * 2048 + 16 * (i)); } while (0)
#define RT_MMA(buf) do { _Pragma("unroll") for (int j = 0; j < 4; ++j) _Pragma("unroll") for (int rt = 0; rt < 4; ++rt) _Pragma("unroll") for (int nt = 0; nt < 3; ++nt) \
            acc[rt][nt] = __builtin_amdgcn_mfma_f32_16x16x4f32(a[buf][rt][j], b[buf][nt][j], acc[rt][nt], 0, 0, 0); } while (0)
#define RT_SB __builtin_amdgcn_sched_barrier(0)
#define RT_CL(x) (((x) < 15) ? (x) : 15)
        RT_LOAD(0, 0); RT_SB; RT_LOAD(1, 1); RT_SB; RT_LOAD(2, 2); RT_SB;
#pragma unroll 1
        for (int i0 = 0; i0 < 16; i0 += 4) {
            RT_LOAD(3, RT_CL(i0 + 3)); RT_SB; RT_MMA(0); RT_SB;
            RT_LOAD(0, RT_CL(i0 + 4)); RT_SB; RT_MMA(1); RT_SB;
            RT_LOAD(1, RT_CL(i0 + 5)); RT_SB; RT_MMA(2); RT_SB;
            RT_LOAD(2, RT_CL(i0 + 6)); RT_SB; RT_MMA(3); RT_SB; }
#undef RT_SB
#undef RT_CL
#undef RT_LOAD
#undef RT_MMA
#pragma unroll
        for (int rt = 0; rt < 4; ++rt)
#pragma unroll
            for (int nt = 0; nt < 3; ++nt)
#pragma unroll
                for (int r = 0; r < 4; ++r) scr[(16 * rt + 4 * fq + r) * 52 + 16 * nt + fr] = acc[rt][nt][r];
        __syncthreads();
        { const int t = tid & 63, g = tid >> 6;
#pragma unroll
          for (int jj = 0; jj < 5; ++jj) { const int j = 5 * g + jj; float s = 0.f;
#pragma unroll
              for (int w8 = 0; w8 < 8; ++w8) s += ((const LAS float*)(lds + w8 * 13312))[t * 52 + j];
              sum[t * 40 + j] = s; } }
        __syncthreads();
        if (tid < 64) { const LAS float* lg = sum + tid * 40; const int t = tok0 + tid;
            float gbest = lg[0] + bg[0]; int gi = 0; float gl[4]; gl[0] = gbest;
#pragma unroll
            for (int j = 1; j < 4; ++j) { gl[j] = lg[j] + bg[j]; if (gl[j] > gbest) { gbest = gl[j]; gi = j; } }
            float gs = 0.f;
#pragma unroll
            for (int j = 0; j < 4; ++j) gs += expf(gl[j] - gbest);
            const float pg = 1.0f / gs;
            float e1 = -INFINITY, e2 = -INFINITY; int i1 = 0, i2 = 0;
#pragma unroll
            for (int j = 0; j < 8; ++j) { const float v = lg[4 + gi * 8 + j] + be[gi * 8 + j]; if (v > e1) { e2 = e1; i2 = i1; e1 = v; i1 = j; } else if (v > e2) { e2 = v; i2 = j; } }
            const float w2 = expf(e2 - e1), den = 1.0f + w2;
            const int ea = gi * 8 + i1, eb = gi * 8 + i2;
            tok_e[2 * t] = ea; tok_e[2 * t + 1] = eb; tok_g[2 * t] = pg / den; tok_g[2 * t + 1] = pg * w2 / den;
            __hip_atomic_fetch_add(lcnt + ea, 1, __ATOMIC_RELAXED, __HIP_MEMORY_SCOPE_WORKGROUP); __hip_atomic_fetch_add(lcnt + eb, 1, __ATOMIC_RELAXED, __HIP_MEMORY_SCOPE_WORKGROUP); }
        __syncthreads();
        if (tid < 32) ccnt[ch * 32 + tid] = lcnt[tid];
    }
}

using pg8::Unit;
struct ProbG {
    const char* A; const char* Bt; unsigned a_rs, b_rs; size_t a_zs, b_zs; int nt;
    size_t a_kstep, b_kstep, a_hstep, b_hstep;
    __device__ __forceinline__ ProbG(const void* A_, unsigned a_rs_, size_t a_zs_, const void* B_, unsigned b_rs_, size_t b_zs_, int K)
        : A((const char*)A_), Bt((const char*)B_), a_rs(a_rs_), b_rs(b_rs_), a_zs(a_zs_), b_zs(b_zs_), nt(K / 64), a_kstep(128), b_kstep(128), a_hstep((size_t)128 * a_rs_), b_hstep((size_t)128 * b_rs_) {}
    __device__ __forceinline__ const char* a_base(const Unit& u) const { return A + (size_t)u.z * a_zs + (size_t)u.pm * 256 * a_rs; }
    __device__ __forceinline__ const char* b_base(const Unit& u) const { return Bt + (size_t)u.z * b_zs + (size_t)u.pn * 256 * b_rs; }
    __device__ __forceinline__ unsigned a_voff(int R, int C) const { return (unsigned)R * a_rs + (unsigned)C * 2u; }
    __device__ __forceinline__ unsigned b_voff(int R, int C) const { return (unsigned)R * b_rs + (unsigned)C * 2u; }
};
struct ProbS5 {
    const char* A; const char* Bt; unsigned b_rs; size_t b_zs; int nt; size_t a_kstep, b_kstep, a_hstep, b_hstep;
    __device__ __forceinline__ ProbS5(const void* proj, const void* B_, int nrowsB) : A((const char*)proj), Bt((const char*)B_), b_rs(1024), b_zs((size_t)nrowsB * 1024), nt(8),
        a_kstep((size_t)4 * NIN * 2), b_kstep(128), a_hstep((size_t)128 * 32 * NIN * 2), b_hstep((size_t)128 * 1024) {}
    __device__ __forceinline__ const char* a_base(const Unit& u) const { return A + ((size_t)u.pm * 256 * 32 * NIN + (size_t)u.z * 16) * 2; }
    __device__ __forceinline__ const char* b_base(const Unit& u) const { return Bt + (size_t)u.z * b_zs + (size_t)u.pn * 256 * b_rs; }
    __device__ __forceinline__ unsigned a_voff(int R, int C) const { return ((unsigned)(R * 32 + (C >> 4)) * NIN + (unsigned)(C & 15)) * 2u; }
    __device__ __forceinline__ unsigned b_voff(int R, int C) const { return (unsigned)R * b_rs + (unsigned)C * 2u; }
};
struct StaticOrder {
    int nM, nN, nwg, G, c;
    __device__ __forceinline__ StaticOrder(int M, int N, int G_, int c_) : nM(M / 256), nN(N / 256), nwg((M / 256) * (N / 256)), G(G_), c(c_) {}
    __device__ __forceinline__ bool next(int i, Unit& u) const {
        const long L = (long)i * G + c; if (L >= nwg) return false;
        int wgid = (int)L; { const int q = nwg / 8, r = nwg % 8, xcd = wgid % 8, off = wgid / 8; wgid = (xcd < r ? xcd * (q + 1) : r * (q + 1) + (xcd - r) * q) + off; }
        const int nig = 8 * nN, gid = wgid / nig, fm = gid * 8, gsz = (nM - fm) < 8 ? (nM - fm) : 8;
        u.pm = fm + ((wgid % nig) % gsz); u.pn = (wgid % nig) / gsz; u.z = 0; return true;
    }
};
struct BatchOrder {
    int nM, nN, total, G, c;
    __device__ __forceinline__ BatchOrder(int nz, int nM_, int nN_, int G_, int c_) : nM(nM_), nN(nN_), total(nz * nM_ * nN_), G(G_), c(c_) {}
    __device__ __forceinline__ bool next(int i, Unit& u) const { const int L = i * G + c; if (c < 0 || L >= total) return false; u.pn = L % nN; const int r = L / nN; u.pm = r % nM; u.z = r / nM; return true; }
};
constexpr int MOE_TAB_OFF = RING_BYTES + 1024;
struct MoeOrder {
    const volatile LAS int* tab; int nN, G, c;
    __device__ __forceinline__ bool next(int i, Unit& u) const { const int L = i * G + c; const int np = tab[0]; if (L >= np * nN) return false; const int pi = L / nN; u.pn = L - pi * nN; const int e = tab[1 + pi]; u.z = e & 255; u.pm = e >> 8; return true; }
};
__device__ __forceinline__ void moe_build_table(const Params& p, int l, LAS unsigned char* lds, const int tid) { GAS unsigned char* wsg_ = (GAS unsigned char*)p.ws; int zz = 0; asm volatile("" : "+s"(wsg_), "+s"(zz)); unsigned char* ws = (unsigned char*)wsg_;
    volatile LAS int* tab = (volatile LAS int*)(lds + MOE_TAB_OFF);
    __syncthreads();
    if (tid == 0) { const unsigned* ecnt = (const unsigned*)(ws + WS_CTL) + CW_ECNT + l * 32; int np = 0, row = 0;
        for (int e = 0; e < 32; ++e) { const int cnt = (int)__hip_atomic_load(ecnt + e, RLX_AGENT); tab[192 + e] = row; tab[224 + e] = cnt; const int k = (cnt + 255) >> 8;
            for (int j = 0; j < k; ++j) { if (np < 160) tab[1 + np] = e | (((row >> 8) + j) << 8); ++np; } row += k * 256; }
        tab[0] = np < 160 ? np : 160; }
    __syncthreads();
}

__device__ __forceinline__ void moe_build_table_chunks(const Params& p, int l, LAS unsigned char* lds, const int tid, const int bid) { GAS unsigned char* wsg_ = (GAS unsigned char*)p.ws; int zz = 0; asm volatile("" : "+s"(wsg_), "+s"(zz)); unsigned char* ws = (unsigned char*)wsg_;
    volatile LAS int* tab = (volatile LAS int*)(lds + MOE_TAB_OFF); const int* ccnt = (const int*)(ws + WS_MISC + 900 * 1024);
    __syncthreads();
    { const int e = tid & 31, part = tid >> 5; int cv[16]; int s = 0; LAS int* px = (LAS int*)(lds + RING_OFF + 4096);
#pragma unroll
      for (int c = 0; c < 16; ++c) cv[c] = ccnt[(part * 16 + c) * 32 + e];
#pragma unroll
      for (int c = 0; c < 16; ++c) { px[(part * 16 + c) * 32 + e] = s; s += cv[c]; }
      tab[256 + part * 32 + e] = s; }
    __syncthreads();
    if (tid < 32) { int s = 0;
#pragma unroll
        for (int part = 0; part < 16; ++part) s += tab[256 + part * 32 + tid];
        tab[224 + tid] = s; if (bid == 0) __hip_atomic_store((unsigned*)(ws + WS_CTL) + CW_ECNT + l * 32 + tid, (unsigned)s, RLX_AGENT); }
    __syncthreads();
    if (tid == 0) { int np = 0, row = 0;
        for (int e = 0; e < 32; ++e) { const int cnt = tab[224 + e]; tab[192 + e] = row; const int k = (cnt + 255) >> 8;
            for (int j = 0; j < k; ++j) { if (np < 160) tab[1 + np] = e | (((row >> 8) + j) << 8); ++np; } row += k * 256; }
        tab[0] = np < 160 ? np : 160; }
    __syncthreads();
}

#define EPI_ROWS const int row0 = u.pm * 256 + wr * 64 + fr
typedef f32x4 AccT[2][2][4][2];
struct EpiBf16 { static constexpr bool PERM = true; bf16* O; int ldc;
    __device__ __forceinline__ void operator()(const AccT& acc, const Unit& u, int wr, int wc, int fr, int fq) const { EPI_ROWS; const int col0 = u.pn * 256 + wc * 32 + 8 * fq;
#pragma unroll
        for (int ai = 0; ai < 2; ++ai)
#pragma unroll
            for (int m = 0; m < 4; ++m) { bf16* rp = O + (size_t)(row0 + ai * 128 + m * 16) * ldc + col0;
#pragma unroll
                for (int bj = 0; bj < 2; ++bj) { const f32x4 v0 = acc[ai][bj][m][0], v1 = acc[ai][bj][m][1]; *(u32x4*)(rp + bj * 128) = (u32x4){pk2(v0[0], v0[1]), pk2(v0[2], v0[3]), pk2(v1[0], v1[1]), pk2(v1[2], v1[3])}; } } } };
struct EpiMlaQ { static constexpr bool PERM = true; bf16* Q; const float* rt; float sc;
    __device__ __forceinline__ void operator()(const AccT& acc, const Unit& u, int wr, int wc, int fr, int fq) const { EPI_ROWS;
#pragma unroll
        for (int ai = 0; ai < 2; ++ai)
#pragma unroll
            for (int m = 0; m < 4; ++m) { const int row = row0 + ai * 128 + m * 16, b = row >> 12, s = row & 4095;
                if (u.pn < 4) {
#pragma unroll
                    for (int bj = 0; bj < 2; ++bj) { const int h = 2 * u.pn + bj; const f32x4 v0 = acc[ai][bj][m][0] * sc, v1 = acc[ai][bj][m][1] * sc;
                        *(u32x4*)(Q + ((size_t)(b * 8 + h) * SQ + s) * 192 + wc * 32 + 8 * fq) = (u32x4){pk2(v0[0], v0[1]), pk2(v0[2], v0[3]), pk2(v1[0], v1[1]), pk2(v1[2], v1[3])}; }
                } else { const int h = 4 * (u.pn - 4) + wc; const f32x4* cs = (const f32x4*)(rt + ((size_t)row * 32 + 8 * fq) * 2); float o1[8], o2[8];
#pragma unroll
                    for (int n = 0; n < 2; ++n) { const f32x4 c01 = cs[2 * n], c23 = cs[2 * n + 1]; const f32x4 x1 = acc[ai][0][m][n], x2 = acc[ai][1][m][n];
                        const float cc[4] = {c01[0], c01[2], c23[0], c23[2]}, ss[4] = {c01[1], c01[3], c23[1], c23[3]};
#pragma unroll
                        for (int r = 0; r < 4; ++r) { o1[4 * n + r] = (x1[r] * cc[r] - x2[r] * ss[r]) * sc; o2[4 * n + r] = (x2[r] * cc[r] + x1[r] * ss[r]) * sc; } }
                    bf16* qp = Q + ((size_t)(b * 8 + h) * SQ + s) * 192 + 128 + 8 * fq; *(u32x4*)qp = pack8(o1); *(u32x4*)(qp + 32) = pack8(o2); } } } };
struct EpiMlaKV { static constexpr bool PERM = true; bf16* K; bf16* VT;
    __device__ __forceinline__ void operator()(const AccT& acc, const Unit& u, int wr, int wc, int fr, int fq) const { EPI_ROWS; const int h = u.pn;
#pragma unroll
        for (int ai = 0; ai < 2; ++ai)
#pragma unroll
            for (int m = 0; m < 4; ++m) { const int row = row0 + ai * 128 + m * 16, b = row >> 12, s = row & 4095;
                { const f32x4 v0 = acc[ai][0][m][0], v1 = acc[ai][0][m][1]; *(u32x4*)(K + ((size_t)(b * 8 + h) * SQ + s) * 192 + wc * 32 + 8 * fq) = (u32x4){pk2(v0[0], v0[1]), pk2(v0[2], v0[3]), pk2(v1[0], v1[1]), pk2(v1[2], v1[3])}; }
#pragma unroll
                for (int n = 0; n < 2; ++n)
#pragma unroll
                    for (int r = 0; r < 4; ++r) VT[((size_t)(b * 8 + h) * 128 + wc * 32 + 8 * fq + 4 * n + r) * SQ + ((s & ~15) | (s & 3) | ((s & 4) << 1) | ((s & 8) >> 1))] = (bf16)f2bf(acc[ai][1][m][n][r]); } } };
struct EpiXloc { static constexpr bool PERM = false; float* X;
    __device__ __forceinline__ void operator()(const AccT& acc, const Unit& u, int wr, int wc, int fr, int fq) const { EPI_ROWS;
#pragma unroll
        for (int ai = 0; ai < 2; ++ai)
#pragma unroll
            for (int m = 0; m < 4; ++m) { float* rp = X + ((size_t)u.z * 512 + row0 + ai * 128 + m * 16) * 128 + wc * 32 + 4 * fq;
#pragma unroll
                for (int n = 0; n < 2; ++n) *(f32x4*)(rp + 16 * n) = acc[ai][0][m][n]; } } };
struct EpiYtoep { static constexpr bool PERM = false; float* Y;
    __device__ __forceinline__ void operator()(const AccT& acc, const Unit& u, int wr, int wc, int fr, int fq) const { EPI_ROWS;
#pragma unroll
        for (int ai = 0; ai < 2; ++ai)
#pragma unroll
            for (int m = 0; m < 4; ++m) { const int cr = row0 + ai * 128 + m * 16;
#pragma unroll
                for (int bj = 0; bj < 2; ++bj)
#pragma unroll
                    for (int n = 0; n < 2; ++n) { const int t = 16 * u.pn + 8 * bj + 2 * wc + n; *(f32x4*)(Y + ((size_t)cr * 32 + t) * 512 + u.z * 16 + 4 * fq) = acc[ai][bj][m][n]; } } } };
struct EpiYfin { static constexpr bool PERM = false; const float* Y; bf16* YB;
    __device__ __forceinline__ void operator()(const AccT& acc, const Unit& u, int wr, int wc, int fr, int fq) const { EPI_ROWS;
#pragma unroll
        for (int ai = 0; ai < 2; ++ai)
#pragma unroll
            for (int m = 0; m < 4; ++m) { const int cr = row0 + ai * 128 + m * 16;
#pragma unroll
                for (int bj = 0; bj < 2; ++bj)
#pragma unroll
                    for (int n = 0; n < 2; ++n) { const int t = 16 * u.pn + 8 * bj + 2 * wc + n; const size_t o = ((size_t)cr * 32 + t) * 512 + u.z * 16 + 4 * fq; const f32x4 v = acc[ai][bj][m][n] + *(const f32x4*)(Y + o);
                        *(u32x2*)(YB + o) = (u32x2){pk2(gelu_tanh(v[0]), gelu_tanh(v[1])), pk2(gelu_tanh(v[2]), gelu_tanh(v[3]))}; } } } };
struct EpiGlu { static constexpr bool PERM = true; const bf16* YB; bf16* ZB; const float* bias;
    __device__ __forceinline__ void operator()(const AccT& acc, const Unit& u, int wr, int wc, int fr, int fq) const { EPI_ROWS; const int col0 = u.pn * 256 + wc * 32 + 8 * fq;
#pragma unroll
        for (int ai = 0; ai < 2; ++ai)
#pragma unroll
            for (int m = 0; m < 4; ++m) { const size_t ro = (size_t)(row0 + ai * 128 + m * 16) * 512;
#pragma unroll
                for (int bj = 0; bj < 2; ++bj) { const int col = col0 + bj * 128; float y[8]; unpack8(*(const u32x4*)(YB + ro + col), y); const f32x4 b0 = *(const f32x4*)(bias + col), b1 = *(const f32x4*)(bias + col + 4);
                    const f32x4 v0 = acc[ai][bj][m][0] + b0, v1 = acc[ai][bj][m][1] + b1;
#pragma unroll
                    for (int r = 0; r < 4; ++r) { y[r] *= sigmoidf_(v0[r]); y[4 + r] *= sigmoidf_(v1[r]); }
                    *(u32x4*)(ZB + ro + col) = pack8(y); } } } };
struct EpiResid { static constexpr bool PERM = true; const bf16* X; bf16* V;
    __device__ __forceinline__ void operator()(const AccT& acc, const Unit& u, int wr, int wc, int fr, int fq) const { EPI_ROWS; const int col0 = u.pn * 256 + wc * 32 + 8 * fq;
#pragma unroll
        for (int ai = 0; ai < 2; ++ai) { u32x4 xr[4][2];
#pragma unroll
            for (int m = 0; m < 4; ++m)
#pragma unroll
                for (int bj = 0; bj < 2; ++bj) xr[m][bj] = *(const u32x4*)(X + (size_t)(row0 + ai * 128 + m * 16) * DM + col0 + bj * 128);
#pragma unroll
            for (int m = 0; m < 4; ++m) { const size_t ro = (size_t)(row0 + ai * 128 + m * 16) * DM + col0;
#pragma unroll
                for (int bj = 0; bj < 2; ++bj) { float x[8]; unpack8(xr[m][bj], x); const f32x4 v0 = acc[ai][bj][m][0], v1 = acc[ai][bj][m][1];
#pragma unroll
                    for (int r = 0; r < 4; ++r) { x[r] = x[r] * DN_ALPHA + v0[r]; x[4 + r] = x[4 + r] * DN_ALPHA + v1[r]; }
                    *(u32x4*)(V + ro + bj * 128) = pack8(x); } } } } };
struct EpiXaKV { static constexpr bool PERM = true; bf16* K; bf16* VT;
    __device__ __forceinline__ void operator()(const AccT& acc, const Unit& u, int wr, int wc, int fr, int fq) const { EPI_ROWS;
#pragma unroll
        for (int ai = 0; ai < 2; ++ai)
#pragma unroll
            for (int m = 0; m < 4; ++m) { const int row = row0 + ai * 128 + m * 16, b = row >> 8, mm = row & 255;
#pragma unroll
                for (int bj = 0; bj < 2; ++bj) { const int h = 2 * (u.pn & 1) + bj;
                    if (u.pn < 2) { const f32x4 v0 = acc[ai][bj][m][0], v1 = acc[ai][bj][m][1]; *(u32x4*)(K + ((size_t)(b * 4 + h) * 256 + mm) * 128 + wc * 32 + 8 * fq) = (u32x4){pk2(v0[0], v0[1]), pk2(v0[2], v0[3]), pk2(v1[0], v1[1]), pk2(v1[2], v1[3])}; }
                    else {
#pragma unroll
                        for (int n = 0; n < 2; ++n)
#pragma unroll
                            for (int r = 0; r < 4; ++r) VT[((size_t)(b * 4 + h) * 128 + wc * 32 + 8 * fq + 4 * n + r) * 256 + ((mm & ~15) | (mm & 3) | ((mm & 4) << 1) | ((mm & 8) >> 1))] = (bf16)f2bf(acc[ai][bj][m][n][r]); } } } } };
struct EpiXaQ { static constexpr bool PERM = true; bf16* Q; float sc;
    __device__ __forceinline__ void operator()(const AccT& acc, const Unit& u, int wr, int wc, int fr, int fq) const { EPI_ROWS;
#pragma unroll
        for (int ai = 0; ai < 2; ++ai)
#pragma unroll
            for (int m = 0; m < 4; ++m) { const int row = row0 + ai * 128 + m * 16, b = row >> 12, s = row & 4095;
#pragma unroll
                for (int bj = 0; bj < 2; ++bj) { const int h = 2 * u.pn + bj; const f32x4 v0 = acc[ai][bj][m][0] * sc, v1 = acc[ai][bj][m][1] * sc;
                    *(u32x4*)(Q + (size_t)u.z * ((size_t)32 * MiB / 2) + ((size_t)(b * 4 + h) * SQ + s) * 128 + wc * 32 + 8 * fq) = (u32x4){pk2(v0[0], v0[1]), pk2(v0[2], v0[3]), pk2(v1[0], v1[1]), pk2(v1[2], v1[3])}; } } } };
struct EpiMoeGU { static constexpr bool PERM = true; bf16* H;
    __device__ __forceinline__ void operator()(const AccT& acc, const Unit& u, int wr, int wc, int fr, int fq) const { EPI_ROWS;
#pragma unroll
        for (int ai = 0; ai < 2; ++ai)
#pragma unroll
            for (int m = 0; m < 4; ++m) { float o[8];
#pragma unroll
                for (int n = 0; n < 2; ++n)
#pragma unroll
                    for (int r = 0; r < 4; ++r) o[4 * n + r] = siluf_(acc[ai][0][m][n][r]) * acc[ai][1][m][n][r];
                *(u32x4*)(H + (size_t)(row0 + ai * 128 + m * 16) * 512 + u.pn * 128 + wc * 32 + 8 * fq) = pack8(o); } } };
struct EpiMoeDown { static constexpr bool PERM = true; bf16* Y; const int* row_tok; const float* row_gate;
    __device__ __forceinline__ void operator()(const AccT& acc, const Unit& u, int wr, int wc, int fr, int fq) const { EPI_ROWS; const int col0 = u.pn * 256 + wc * 32 + 8 * fq;
        int ts[8]; float gg[8];
#pragma unroll
        for (int i = 0; i < 8; ++i) { const int row = row0 + (i >> 2) * 128 + (i & 3) * 16; ts[i] = row_tok[row]; gg[i] = row_gate[row]; }
#pragma unroll
        for (int ai = 0; ai < 2; ++ai)
#pragma unroll
            for (int m = 0; m < 4; ++m) { const int tsi = ts[ai * 4 + m]; if (tsi < 0) continue; const float g = gg[ai * 4 + m];
                bf16* yp = Y + ((size_t)(tsi & 1) * TT + (tsi >> 1)) * DM + col0;
#pragma unroll
                for (int bj = 0; bj < 2; ++bj) { const f32x4 v0 = acc[ai][bj][m][0] * g, v1 = acc[ai][bj][m][1] * g; *(u32x4*)(yp + bj * 128) = (u32x4){pk2(v0[0], v0[1]), pk2(v0[2], v0[3]), pk2(v1[0], v1[1]), pk2(v1[2], v1[3])}; } } } };

#ifndef EN_S5
#define EN_S5 1
#endif
#ifndef EN_MLA
#define EN_MLA 1
#endif
#ifndef EN_GDN
#define EN_GDN 1
#endif
#ifndef EN_XA
#define EN_XA 1
#endif
#ifndef EN_MOE
#define EN_MOE 1
#endif
#ifndef EN_MIX
#define EN_MIX 1
#endif
#ifndef REP_MASK
#define REP_MASK 0
#endif
#define REPEAT(bit) for (int rep_ = 0; rep_ < ((((REP_MASK) >> (bit)) & 1) + 1); ++rep_)
constexpr int NPH = 17, NPHASES = 1 + NL * NPH;

__global__ void __launch_bounds__(NWAVES * 64, 2) hybrid_fwd(Params p) {
    extern __shared__ __attribute__((aligned(16))) unsigned char lds_raw[];
    LAS unsigned char* lds0 = (LAS unsigned char*)lds_raw;
    const int tid0 = threadIdx.x; const int wave0 = __builtin_amdgcn_readfirstlane(tid0 >> 6);
    const int G = gridDim.x, bid = blockIdx.x; const int NGW = G * NWAVES;
    unsigned* ctl0 = (unsigned*)(p.ws + WS_CTL);
    for (int u = tid0; u < (LDS_BYTES - LDSCTL_OFF) / 4; u += NWAVES * 64) ((LAS unsigned*)(lds0 + LDSCTL_OFF))[u] = 0u;
    __syncthreads();
    volatile LAS unsigned* MISC = (volatile LAS unsigned*)(lds0 + MISC_OFF);
    const bool use_bar = (p.ph_hi - p.ph_lo) > 1;
    XcdBarrier bar; bar.bar = ctl0 + CW_BAR; bar.x = 0; bar.st = MISC + 8;
    if (use_bar) bar = xcd_barrier_post(ctl0 + CW_BAR, MISC + 8);
    const int lo = p.ph_lo, hi = p.ph_hi;
#define IN(k) (lo <= (k) && (k) < hi)
#define PH_VARS int wv_ = wave0; unsigned m1_ = ~0u; asm volatile("" : "+s"(wv_), "+s"(m1_)); int tid = wv_ * 64 + (int)__builtin_amdgcn_mbcnt_hi(m1_, __builtin_amdgcn_mbcnt_lo(m1_, 0u)); LAS unsigned char* lds = lds0; asm volatile("" : "+v"(tid), "+v"(lds)); const int lane = tid & 63, wave = __builtin_amdgcn_readfirstlane(tid >> 6); const int gw = bid * NWAVES + wave; LAS float* wscr = (LAS float*)(lds + RING_OFF + wave * 16384); GAS unsigned char* wsg_ = (GAS unsigned char*)p.ws; int zz = 0; asm volatile("" : "+s"(wsg_), "+s"(zz)); unsigned char* ws = (unsigned char*)wsg_; unsigned* ctl = (unsigned*)(ws + WS_CTL); bf16* V = (bf16*)(ws + WS_V); bf16* XB = (bf16*)(ws + WS_XB); bf16* PROJ = (bf16*)(ws + WS_PROJ); bf16* MIX = (bf16*)(ws + WS_MIX); \
    (void)lane; (void)gw; (void)wscr; (void)ctl; (void)V; (void)XB; (void)PROJ; (void)MIX
#ifndef PROBE
#define PROBE 0
#endif
#define TS_OFF (LDSCTL_OFF + 8192)
#define STAMP(i) do { if (PROBE && bid == 0 && wave0 == 0 && __builtin_amdgcn_mbcnt_lo(~0u, 0u) == 0u) { unsigned long long t_; asm volatile("s_memrealtime %0\n\ts_waitcnt lgkmcnt(0)" : "=s"(t_) :: "memory"); ((volatile LAS unsigned long long*)(lds0 + TS_OFF))[i] = t_; } } while (0)
#define SEAM(k) do { if (IN(k) && IN((k) + 1)) xcd_barrier(bar); STAMP((k) + 1); } while (0)

    STAMP(0);
    if (IN(0)) REPEAT(0) { const int l = 0; PH_VARS;
        p0_weights(p, gw, NGW, lane);
        p0_tables(p, gw, NGW, lane);
        p0_s5(p, wscr, gw, NGW, lane);
        cvt_rows((const float*)p.in[zz + 0], XB, TT, gw, NGW, lane);
        cvt_rows((const float*)p.in[zz + 1], (bf16*)(ws + WS_MEMB), NB * MEML, gw, NGW, lane);
    }
    SEAM(0);

    { constexpr int l = 0; constexpr int P0 = 1 + 0 * NPH;
        if (IN(P0 + 0)) REPEAT(1) { PH_VARS;
#if EN_MIX
            ProbG P(XB, DM * 2, 0, ws + WS_WIN_T + (size_t)l * NIN * 2048 * 2, DM * 2, 0, DM); StaticOrder S(TT, NIN, G, bid); EpiBf16 E{PROJ, NIN};
            pg8::gemm_phase(lds0 + RING_OFF, P, S, E, tid);
#endif
#if EN_XA
            { ProbG P(ws + WS_MEMB, DM * 2, 0, ws + WS_XKV_T + (size_t)l * 1024 * 2048 * 2, DM * 2, 0, DM); StaticOrder S(NB * MEML, 1024, G, (bid + 64) % G); EpiXaKV E{(bf16*)(ws + WS_XAK), (bf16*)(ws + WS_XAVT)};
              pg8::gemm_phase(lds0 + RING_OFF, P, S, E, tid); }
#endif
        }
        SEAM(P0 + 0);
        if (IN(P0 + 1)) REPEAT(2) { PH_VARS;
#if EN_MLA || EN_GDN
            ph2_token(p, l, gw, NGW, lane);
#endif
#if EN_GDN
            ph2_conv(p, l, gw, NGW, lane);
#endif
#if EN_S5
            { ProbS5 P(PROJ, ws + WS_MEND_T + (size_t)l * 32 * 256 * 512 * 2, 256); BatchOrder S(32, 2, 1, G, bid); EpiXloc E{(float*)(ws + WS_XLOC)}; pg8::gemm_phase(lds0 + RING_OFF, P, S, E, tid); }
            { ProbS5 P(PROJ, ws + WS_TOEP_T + (size_t)l * 32 * 512 * 512 * 2, 512); BatchOrder S(32, 2, 2, G, (bid + 192) % G); EpiYtoep E{(float*)(ws + WS_YTOEP)}; pg8::gemm_phase(lds0 + RING_OFF, P, S, E, tid); }
#endif
        }
        SEAM(P0 + 1);
        if (IN(P0 + 2)) REPEAT(3) { PH_VARS;
#if EN_S5
            if (bid >= G - 32) { const int q = (bid - (G - 32)) * 512 + tid;
                if (q < 8192) { const int b = q >> 11, g = (q >> 6) & 31, pp = q & 63; const float* al = (const float*)(ws + WS_MISC + 800 * 1024) + ((l * 32 + g) * 64 + pp) * 2; const float ar = al[0], ai = al[1];
                    const float* xl = (const float*)(ws + WS_XLOC) + ((size_t)g * 512 + b * 128) * 128; bf16* xs = (bf16*)(ws + WS_XSB) + ((size_t)g * 512 + b * 128) * 128; float sr = 0.f, si = 0.f;
#pragma unroll 1
                    for (int c0 = 0; c0 < 128; c0 += 16) { float lr_[16], li_[16];
#pragma unroll
                        for (int i = 0; i < 16; ++i) { lr_[i] = xl[(c0 + i) * 128 + pp]; li_[i] = xl[(c0 + i) * 128 + 64 + pp]; }
#pragma unroll
                        for (int i = 0; i < 16; ++i) { xs[(c0 + i) * 128 + pp] = (bf16)f2bf(sr); xs[(c0 + i) * 128 + 64 + pp] = (bf16)f2bf(si);
                            const float nr = ar * sr - ai * si + lr_[i], ni = ar * si + ai * sr + li_[i]; sr = nr; si = ni; } } } }
#endif
#if EN_MLA
            { ProbG P(ws + WS_CQN, 2048, 0, ws + WS_WUQ_T + (size_t)l * 1536 * 512 * 2, 1024, 0, 512); StaticOrder S(TT, 1536, G, bid); EpiMlaQ E{(bf16*)(ws + WS_QB), (const float*)(ws + WS_ROPE), 0.07216878364870323f * LOG2E};
              pg8::gemm_phase(lds0 + RING_OFF, P, S, E, tid); }
            { ProbG P(ws + WS_CQN + 1024, 2048, 0, ws + WS_WUKV_T + (size_t)l * 2048 * 512 * 2, 1024, 0, 512); StaticOrder S(TT, 2048, G, (bid + 128) % G); EpiMlaKV E{(bf16*)(ws + WS_KB), (bf16*)(ws + WS_VT)};
              pg8::gemm_phase(lds0 + RING_OFF, P, S, E, tid); }
#endif
#if EN_GDN
            { u32x4 pre[6];
              if (bid < 1024) { const bf16* gq_ = (const bf16*)(ws + WS_GQ); const bf16* gk_ = (const bf16*)(ws + WS_GK); const bf16* gv_ = (const bf16*)(ws + WS_GV); const int bh_ = bid >> 6, n_ = bid & 63; const int t_ = (bh_ >> 2) * SQ + n_ * 64, h_ = bh_ & 3;
#pragma unroll
                  for (int i = 0; i < 2; ++i) { const int idx = tid + 512 * i, c = idx >> 4, pc = idx & 15; const size_t go = (size_t)(t_ + c) * 512 + h_ * 128 + pc * 8;
                      pre[3 * i] = *(const u32x4*)(gk_ + go); pre[3 * i + 1] = *(const u32x4*)(gq_ + go); pre[3 * i + 2] = *(const u32x4*)(gv_ + go); } }
              for (int it = bid; it < 1024; it += G) gdn_pre_item(p, lds + RING_OFF, it, tid, pre, (it + G < 1024) ? it + G : -1); }
#endif
        }
        SEAM(P0 + 2);
        if (IN(P0 + 3)) REPEAT(7) { PH_VARS;
#if EN_GDN
            if (bid < 16) gdn_chain(p, lds + RING_OFF, bid, l, tid);
#else
            zero_mix_cols(p, 1536, 512, gw, NGW, lane);
#endif
#if EN_S5
            { ProbG P(ws + WS_XSB, 256, (size_t)512 * 256, ws + WS_MST_T + (size_t)l * 32 * 512 * 128 * 2, 256, (size_t)512 * 256, 128); BatchOrder S(32, 2, 2, G - 16, bid - 16); EpiYfin E{(const float*)(ws + WS_YTOEP), (bf16*)(ws + WS_YB)};
              pg8::gemm_phase(lds0 + RING_OFF, P, S, E, tid); }
#endif
#if EN_MOE
#define MOE_CVT_LOOP() do { unsigned* head2 = ctl + CW_QUEUE + (8 + l) * 64; volatile LAS int* qslot = (volatile LAS int*)(lds + MISC_OFF);     \
              for (;;) { __syncthreads(); if (tid == 0) qslot[0] = (int)__hip_atomic_fetch_add(head2, 1u, RLX_AGENT); __syncthreads(); const int q0_ = qslot[0] * NWAVES; if (q0_ >= MOE_CVT_ITEMS) break; \
                  if (q0_ + wave < MOE_CVT_ITEMS) moe_convert_item(p, l, q0_ + wave, lane); } } while (0)
#else
#define MOE_CVT_LOOP() do { } while (0)
#endif
            if (bid >= 16 && bid < 80) MOE_CVT_LOOP();
#if EN_MLA
            { unsigned* head = ctl + CW_QUEUE + (l * 2 + rep_) * 64; volatile LAS int* qslot = (volatile LAS int*)(lds + MISC_OFF);
              for (;;) { __syncthreads(); if (tid == 0) qslot[0] = (int)__hip_atomic_fetch_add(head, 1u, RLX_AGENT); __syncthreads(); const int q = qslot[0]; if (q >= 512) break;
                  const int qb = 15 - (q >> 5), bh = q & 31, b = bh >> 3, h = bh & 7;
                  attn_unit<192, true>(lds + RING_OFF, (const bf16*)(ws + WS_QB) + (size_t)bh * SQ * 192, (const bf16*)(ws + WS_KB) + (size_t)bh * SQ * 192, (const bf16*)(ws + WS_VT) + (size_t)bh * 128 * SQ, SQ, qb * 256, 4 * qb + 4,
                                       (bf16*)(ws + WS_OB) + (size_t)b * SQ * 1024 + h * 128, 1024, tid); } }
#endif
            MOE_CVT_LOOP();
#undef MOE_CVT_LOOP
        }
        SEAM(P0 + 3);
        if (IN(P0 + 4)) REPEAT(4) { PH_VARS;
#if EN_S5
            { ProbG P(ws + WS_YB, 1024, 0, ws + WS_GLU_T + (size_t)l * 512 * 512 * 2, 1024, 0, 512); StaticOrder S(TT, 512, G, bid); EpiGlu E{(const bf16*)(ws + WS_YB), (bf16*)(ws + WS_ZB), (const float*)p.in[zz + 13] + l * 512};
              pg8::gemm_phase(lds0 + RING_OFF, P, S, E, tid); }
#endif
#if EN_MLA
            mixnorm_rows(p, l, false, true, EN_GDN != 0, gw, NGW, lane);
#else
            zero_mix_cols(p, 512, 1024, gw, NGW, lane);
#endif
        }
        SEAM(P0 + 4);
        if (IN(P0 + 5)) REPEAT(4) { PH_VARS;
#if EN_S5
            mixnorm_rows(p, l, true, false, false, gw, NGW, lane);
#else
            zero_mix_cols(p, 0, 512, gw, NGW, lane);
#endif
        }
        SEAM(P0 + 5);
        if (IN(P0 + 6)) REPEAT(1) { PH_VARS;
#if EN_MIX
            ProbG P(MIX, DM * 2, 0, ws + WS_WOUT_T + (size_t)l * 2048 * 2048 * 2, DM * 2, 0, DM); StaticOrder S(TT, DM, G, bid); EpiResid E{XB, V};
            pg8::gemm_phase(lds0 + RING_OFF, P, S, E, tid);
#else
            scale_rows(XB, V, gw, NGW, lane);
#endif
        }
        SEAM(P0 + 6);
        if (IN(P0 + 7)) REPEAT(5) { PH_VARS; ln_rows<4>(V, nullptr, nullptr, false, (const float*)p.in[zz + 25] + l * DM, (const float*)p.in[zz + 26] + l * DM, XB, nullptr, gw, NGW, lane); }
        SEAM(P0 + 7);
        if (IN(P0 + 8)) REPEAT(1) { PH_VARS;
#if EN_XA
            ProbG P(XB, DM * 2, 1024 * 2, ws + WS_XQ_T + (size_t)l * 512 * 2048 * 2, DM * 2, 1024 * 2, 1024); BatchOrder S(2, TT / 256, 2, G, bid); EpiXaQ E{(bf16*)(ws + WS_XAQ), 0.08838834764831845f * LOG2E};
            pg8::gemm_phase(lds0 + RING_OFF, P, S, E, tid);
#endif
        }
        SEAM(P0 + 8);
        if (IN(P0 + 9)) REPEAT(6) { PH_VARS;
#if EN_XA
            for (int q = bid; q < 256; q += G) { const int bh = q >> 4, qb = q & 15, b = bh >> 2, h = bh & 3;
                xattn_unit(lds + RING_OFF, (const bf16*)(ws + WS_XAQ) + (size_t)bh * SQ * 128, (const bf16*)(ws + WS_XAK) + (size_t)bh * 256 * 128, (const bf16*)(ws + WS_XAVT) + (size_t)bh * 128 * 256, qb * 256,
                           (bf16*)(ws + WS_XAO) + (size_t)b * SQ * 512 + h * 128, 512, tid); }
#endif
        }
        SEAM(P0 + 9);
        if (IN(P0 + 10)) REPEAT(1) { PH_VARS;
#if EN_XA
            ProbG P(ws + WS_XAO, 1024, 0, ws + WS_XO_T + (size_t)l * 2048 * 512 * 2, 1024, 0, 512); StaticOrder S(TT, DM, G, bid); EpiResid E{XB, V};
            pg8::gemm_phase(lds0 + RING_OFF, P, S, E, tid);
#else
            scale_rows(XB, V, gw, NGW, lane);
#endif
        }
        SEAM(P0 + 10);
#if !EN_MOE
        if (IN(P0 + 11)) { PH_VARS; ln_rows(V, nullptr, nullptr, false, (const float*)p.in[zz + 31] + l * DM, (const float*)p.in[zz + 32] + l * DM, XB, nullptr, gw, NGW, lane); }
        SEAM(P0 + 11);
#endif
        STAMP(P0 + 12);
        if (IN(P0 + 12)) { PH_VARS;
#if EN_MOE
            router_rows(p, l, lds + RING_OFF, XB, bid, G, tid, V, (const float*)p.in[zz + 31] + l * DM, (const float*)p.in[zz + 32] + l * DM);
#endif
        }
        SEAM(P0 + 12);
        if (IN(P0 + 13)) { PH_VARS;
#if EN_MOE
            moe_build_table_chunks(p, l, lds, tid, bid);
            { volatile LAS int* tab = (volatile LAS int*)(lds + MOE_TAB_OFF); const int* tok_e = (const int*)(ws + WS_ROUTE); const float* tok_g = (const float*)(ws + WS_ROUTE + 256 * 1024); const int* ccnt = (const int*)(ws + WS_MISC + 900 * 1024);
              int* row_tok = (int*)(ws + WS_ROUTE + 512 * 1024); float* row_gate = (float*)(ws + WS_ROUTE + 768 * 1024); bf16* XG = (bf16*)(ws + WS_XG);
              for (int e = gw; e < 32; e += NGW) { const int cnt = tab[224 + e], st = tab[192 + e]; const int pe = ((cnt + 255) >> 8) << 8; for (int r = cnt + lane; r < pe; r += 64) row_tok[st + r] = -1; }
              volatile LAS int* lc = (volatile LAS int*)(lds + RING_OFF); LAS int* lcnt = (LAS int*)(lds + RING_OFF); LAS int* gbase = lcnt + 32; LAS int* dlist = lcnt + 64;
              for (int ch = bid; ch < TT / 64; ch += G) {
                  if (tid < 32) { lcnt[tid] = 0; int s = ((const volatile LAS int*)(lds + RING_OFF + 4096))[ch * 32 + tid]; const int part = ch >> 4;
                      for (int pp = 0; pp < part; ++pp) s += tab[256 + pp * 32 + tid];
                      gbase[tid] = s; }
                  __syncthreads();
                  int e = 0, lpos = 0, tk = 0;
                  if (tid < 128) { tk = 2 * (ch * 64) + tid; e = tok_e[tk]; lpos = __hip_atomic_fetch_add(lcnt + e, 1, __ATOMIC_RELAXED, __HIP_MEMORY_SCOPE_WORKGROUP); }
                  __syncthreads();
                  if (tid < 128) { const int dest = tab[192 + e] + lc[32 + e] + lpos; row_tok[dest] = tk; row_gate[dest] = tok_g[tk]; dlist[tid] = dest; }
                  __syncthreads();
                  __syncthreads();
              } }
#endif
        }
        SEAM(P0 + 13);
        if (IN(P0 + 14)) REPEAT(1) { PH_VARS;
#if EN_MOE
            moe_build_table(p, l, lds, tid);
            ProbG P(XB, DM * 2, 0, ws + WS_GU_T + (size_t)l * 32 * 1024 * 2048 * 2, DM * 2, (size_t)1024 * 2048 * 2, DM); MoeOrder S{(const volatile LAS int*)(lds + MOE_TAB_OFF), 4, G, (G % 8 == 0) ? (bid % 8) * (G / 8) + bid / 8 : bid};     EpiMoeGU E{(bf16*)(ws + WS_HB)};
            pg8::gemm_phase<ProbG, EpiMoeGU, MoeOrder, true, true>(lds0 + RING_OFF, P, S, E, tid, (const int*)(ws + WS_ROUTE + 512 * 1024));
#endif
        }
        SEAM(P0 + 14);
        if (IN(P0 + 15)) { PH_VARS;
#if EN_MOE
            moe_build_table(p, l, lds, tid);
            ProbG P(ws + WS_HB, 1024, 0, ws + WS_DN_T + (size_t)l * 32 * 2048 * 512 * 2, 1024, (size_t)2048 * 512 * 2, 512); MoeOrder S{(const volatile LAS int*)(lds + MOE_TAB_OFF), 8, G, (G % 8 == 0) ? (bid % 8) * (G / 8) + bid / 8 : bid};
            EpiMoeDown E{V, (const int*)(ws + WS_ROUTE + 512 * 1024), (const float*)(ws + WS_ROUTE + 768 * 1024)};
            pg8::gemm_phase<ProbG, EpiMoeDown, MoeOrder, false>(lds0 + RING_OFF, P, S, E, tid);
#endif
        }
        SEAM(P0 + 15);
        if (IN(P0 + 16)) REPEAT(5) { PH_VARS; ln_rows(nullptr, XB, V, EN_MOE != 0, (const float*)p.in[zz + 39] + l * DM, (const float*)p.in[zz + 40] + l * DM, (l == NL - 1) ? nullptr : XB, (l == NL - 1) ? p.out : nullptr, gw, NGW, lane); }
        SEAM(P0 + 16);
    }
    { constexpr int l = 1; constexpr int P0 = 1 + 1 * NPH;
        if (IN(P0 + 0)) REPEAT(1) { PH_VARS;
#if EN_MIX
            ProbG P(XB, DM * 2, 0, ws + WS_WIN_T + (size_t)l * NIN * 2048 * 2, DM * 2, 0, DM); StaticOrder S(TT, NIN, G, bid); EpiBf16 E{PROJ, NIN};
            pg8::gemm_phase(lds0 + RING_OFF, P, S, E, tid);
#endif
#if EN_XA
            { ProbG P(ws + WS_MEMB, DM * 2, 0, ws + WS_XKV_T + (size_t)l * 1024 * 2048 * 2, DM * 2, 0, DM); StaticOrder S(NB * MEML, 1024, G, (bid + 64) % G); EpiXaKV E{(bf16*)(ws + WS_XAK), (bf16*)(ws + WS_XAVT)};
              pg8::gemm_phase(lds0 + RING_OFF, P, S, E, tid); }
#endif
        }
        SEAM(P0 + 0);
        if (IN(P0 + 1)) REPEAT(2) { PH_VARS;
#if EN_MLA || EN_GDN
            ph2_token(p, l, gw, NGW, lane);
#endif
#if EN_GDN
            ph2_conv(p, l, gw, NGW, lane);
#endif
#if EN_S5
            { ProbS5 P(PROJ, ws + WS_MEND_T + (size_t)l * 32 * 256 * 512 * 2, 256); BatchOrder S(32, 2, 1, G, bid); EpiXloc E{(float*)(ws + WS_XLOC)}; pg8::gemm_phase(lds0 + RING_OFF, P, S, E, tid); }
            { ProbS5 P(PROJ, ws + WS_TOEP_T + (size_t)l * 32 * 512 * 512 * 2, 512); BatchOrder S(32, 2, 2, G, (bid + 192) % G); EpiYtoep E{(float*)(ws + WS_YTOEP)}; pg8::gemm_phase(lds0 + RING_OFF, P, S, E, tid); }
#endif
        }
        SEAM(P0 + 1);
        if (IN(P0 + 2)) REPEAT(3) { PH_VARS;
#if EN_S5
            if (bid >= G - 32) { const int q = (bid - (G - 32)) * 512 + tid;
                if (q < 8192) { const int b = q >> 11, g = (q >> 6) & 31, pp = q & 63; const float* al = (const float*)(ws + WS_MISC + 800 * 1024) + ((l * 32 + g) * 64 + pp) * 2; const float ar = al[0], ai = al[1];
                    const float* xl = (const float*)(ws + WS_XLOC) + ((size_t)g * 512 + b * 128) * 128; bf16* xs = (bf16*)(ws + WS_XSB) + ((size_t)g * 512 + b * 128) * 128; float sr = 0.f, si = 0.f;
#pragma unroll 1
                    for (int c0 = 0; c0 < 128; c0 += 16) { float lr_[16], li_[16];
#pragma unroll
                        for (int i = 0; i < 16; ++i) { lr_[i] = xl[(c0 + i) * 128 + pp]; li_[i] = xl[(c0 + i) * 128 + 64 + pp]; }
#pragma unroll
                        for (int i = 0; i < 16; ++i) { xs[(c0 + i) * 128 + pp] = (bf16)f2bf(sr); xs[(c0 + i) * 128 + 64 + pp] = (bf16)f2bf(si);
                            const float nr = ar * sr - ai * si + lr_[i], ni = ar * si + ai * sr + li_[i]; sr = nr; si = ni; } } } }
#endif
#if EN_MLA
            { ProbG P(ws + WS_CQN, 2048, 0, ws + WS_WUQ_T + (size_t)l * 1536 * 512 * 2, 1024, 0, 512); StaticOrder S(TT, 1536, G, bid); EpiMlaQ E{(bf16*)(ws + WS_QB), (const float*)(ws + WS_ROPE), 0.07216878364870323f * LOG2E};
              pg8::gemm_phase(lds0 + RING_OFF, P, S, E, tid); }
            { ProbG P(ws + WS_CQN + 1024, 2048, 0, ws + WS_WUKV_T + (size_t)l * 2048 * 512 * 2, 1024, 0, 512); StaticOrder S(TT, 2048, G, (bid + 128) % G); EpiMlaKV E{(bf16*)(ws + WS_KB), (bf16*)(ws + WS_VT)};
              pg8::gemm_phase(lds0 + RING_OFF, P, S, E, tid); }
#endif
#if EN_GDN
            { u32x4 pre[6];
              if (bid < 1024) { const bf16* gq_ = (const bf16*)(ws + WS_GQ); const bf16* gk_ = (const bf16*)(ws + WS_GK); const bf16* gv_ = (const bf16*)(ws + WS_GV); const int bh_ = bid >> 6, n_ = bid & 63; const int t_ = (bh_ >> 2) * SQ + n_ * 64, h_ = bh_ & 3;
#pragma unroll
                  for (int i = 0; i < 2; ++i) { const int idx = tid + 512 * i, c = idx >> 4, pc = idx & 15; const size_t go = (size_t)(t_ + c) * 512 + h_ * 128 + pc * 8;
                      pre[3 * i] = *(const u32x4*)(gk_ + go); pre[3 * i + 1] = *(const u32x4*)(gq_ + go); pre[3 * i + 2] = *(const u32x4*)(gv_ + go); } }
              for (int it = bid; it < 1024; it += G) gdn_pre_item(p, lds + RING_OFF, it, tid, pre, (it + G < 1024) ? it + G : -1); }
#endif
        }
        SEAM(P0 + 2);
        if (IN(P0 + 3)) REPEAT(7) { PH_VARS;
#if EN_GDN
            if (bid < 16) gdn_chain(p, lds + RING_OFF, bid, l, tid);
#else
            zero_mix_cols(p, 1536, 512, gw, NGW, lane);
#endif
#if EN_S5
            { ProbG P(ws + WS_XSB, 256, (size_t)512 * 256, ws + WS_MST_T + (size_t)l * 32 * 512 * 128 * 2, 256, (size_t)512 * 256, 128); BatchOrder S(32, 2, 2, G - 16, bid - 16); EpiYfin E{(const float*)(ws + WS_YTOEP), (bf16*)(ws + WS_YB)};
              pg8::gemm_phase(lds0 + RING_OFF, P, S, E, tid); }
#endif
#if EN_MOE
#define MOE_CVT_LOOP() do { unsigned* head2 = ctl + CW_QUEUE + (8 + l) * 64; volatile LAS int* qslot = (volatile LAS int*)(lds + MISC_OFF);     \
              for (;;) { __syncthreads(); if (tid == 0) qslot[0] = (int)__hip_atomic_fetch_add(head2, 1u, RLX_AGENT); __syncthreads(); const int q0_ = qslot[0] * NWAVES; if (q0_ >= MOE_CVT_ITEMS) break; \
                  if (q0_ + wave < MOE_CVT_ITEMS) moe_convert_item(p, l, q0_ + wave, lane); } } while (0)
#else
#define MOE_CVT_LOOP() do { } while (0)
#endif
            if (bid >= 16 && bid < 80) MOE_CVT_LOOP();
#if EN_MLA
            { unsigned* head = ctl + CW_QUEUE + (l * 2 + rep_) * 64; volatile LAS int* qslot = (volatile LAS int*)(lds + MISC_OFF);
              for (;;) { __syncthreads(); if (tid == 0) qslot[0] = (int)__hip_atomic_fetch_add(head, 1u, RLX_AGENT); __syncthreads(); const int q = qslot[0]; if (q >= 512) break;
                  const int qb = 15 - (q >> 5), bh = q & 31, b = bh >> 3, h = bh & 7;
                  attn_unit<192, true>(lds + RING_OFF, (const bf16*)(ws + WS_QB) + (size_t)bh * SQ * 192, (const bf16*)(ws + WS_KB) + (size_t)bh * SQ * 192, (const bf16*)(ws + WS_VT) + (size_t)bh * 128 * SQ, SQ, qb * 256, 4 * qb + 4,
                                       (bf16*)(ws + WS_OB) + (size_t)b * SQ * 1024 + h * 128, 1024, tid); } }
#endif
            MOE_CVT_LOOP();
#undef MOE_CVT_LOOP
        }
        SEAM(P0 + 3);
        if (IN(P0 + 4)) REPEAT(4) { PH_VARS;
#if EN_S5
            { ProbG P(ws + WS_YB, 1024, 0, ws + WS_GLU_T + (size_t)l * 512 * 512 * 2, 1024, 0, 512); StaticOrder S(TT, 512, G, bid); EpiGlu E{(const bf16*)(ws + WS_YB), (bf16*)(ws + WS_ZB), (const float*)p.in[zz + 13] + l * 512};
              pg8::gemm_phase(lds0 + RING_OFF, P, S, E, tid); }
#endif
#if EN_MLA
            mixnorm_rows(p, l, false, true, EN_GDN != 0, gw, NGW, lane);
#else
            zero_mix_cols(p, 512, 1024, gw, NGW, lane);
#endif
        }
        SEAM(P0 + 4);
        if (IN(P0 + 5)) REPEAT(4) { PH_VARS;
#if EN_S5
            mixnorm_rows(p, l, true, false, false, gw, NGW, lane);
#else
            zero_mix_cols(p, 0, 512, gw, NGW, lane);
#endif
        }
        SEAM(P0 + 5);
        if (IN(P0 + 6)) REPEAT(1) { PH_VARS;
#if EN_MIX
            ProbG P(MIX, DM * 2, 0, ws + WS_WOUT_T + (size_t)l * 2048 * 2048 * 2, DM * 2, 0, DM); StaticOrder S(TT, DM, G, bid); EpiResid E{XB, V};
            pg8::gemm_phase(lds0 + RING_OFF, P, S, E, tid);
#else
            scale_rows(XB, V, gw, NGW, lane);
#endif
        }
        SEAM(P0 + 6);
        if (IN(P0 + 7)) REPEAT(5) { PH_VARS; ln_rows<4>(V, nullptr, nullptr, false, (const float*)p.in[zz + 25] + l * DM, (const float*)p.in[zz + 26] + l * DM, XB, nullptr, gw, NGW, lane); }
        SEAM(P0 + 7);
        if (IN(P0 + 8)) REPEAT(1) { PH_VARS;
#if EN_XA
            ProbG P(XB, DM * 2, 1024 * 2, ws + WS_XQ_T + (size_t)l * 512 * 2048 * 2, DM * 2, 1024 * 2, 1024); BatchOrder S(2, TT / 256, 2, G, bid); EpiXaQ E{(bf16*)(ws + WS_XAQ), 0.08838834764831845f * LOG2E};
            pg8::gemm_phase(lds0 + RING_OFF, P, S, E, tid);
#endif
        }
        SEAM(P0 + 8);
        if (IN(P0 + 9)) REPEAT(6) { PH_VARS;
#if EN_XA
            for (int q = bid; q < 256; q += G) { const int bh = q >> 4, qb = q & 15, b = bh >> 2, h = bh & 3;
                xattn_unit(lds + RING_OFF, (const bf16*)(ws + WS_XAQ) + (size_t)bh * SQ * 128, (const bf16*)(ws + WS_XAK) + (size_t)bh * 256 * 128, (const bf16*)(ws + WS_XAVT) + (size_t)bh * 128 * 256, qb * 256,
                           (bf16*)(ws + WS_XAO) + (size_t)b * SQ * 512 + h * 128, 512, tid); }
#endif
        }
        SEAM(P0 + 9);
        if (IN(P0 + 10)) REPEAT(1) { PH_VARS;
#if EN_XA
            ProbG P(ws + WS_XAO, 1024, 0, ws + WS_XO_T + (size_t)l * 2048 * 512 * 2, 1024, 0, 512); StaticOrder S(TT, DM, G, bid); EpiResid E{XB, V};
            pg8::gemm_phase(lds0 + RING_OFF, P, S, E, tid);
#else
            scale_rows(XB, V, gw, NGW, lane);
#endif
        }
        SEAM(P0 + 10);
#if !EN_MOE
        if (IN(P0 + 11)) { PH_VARS; ln_rows(V, nullptr, nullptr, false, (const float*)p.in[zz + 31] + l * DM, (const float*)p.in[zz + 32] + l * DM, XB, nullptr, gw, NGW, lane); }
        SEAM(P0 + 11);
#endif
        STAMP(P0 + 12);
        if (IN(P0 + 12)) { PH_VARS;
#if EN_MOE
            router_rows(p, l, lds + RING_OFF, XB, bid, G, tid, V, (const float*)p.in[zz + 31] + l * DM, (const float*)p.in[zz + 32] + l * DM);
#endif
        }
        SEAM(P0 + 12);
        if (IN(P0 + 13)) { PH_VARS;
#if EN_MOE
            moe_build_table_chunks(p, l, lds, tid, bid);
            { volatile LAS int* tab = (volatile LAS int*)(lds + MOE_TAB_OFF); const int* tok_e = (const int*)(ws + WS_ROUTE); const float* tok_g = (const float*)(ws + WS_ROUTE + 256 * 1024); const int* ccnt = (const int*)(ws + WS_MISC + 900 * 1024);
              int* row_tok = (int*)(ws + WS_ROUTE + 512 * 1024); float* row_gate = (float*)(ws + WS_ROUTE + 768 * 1024); bf16* XG = (bf16*)(ws + WS_XG);
              for (int e = gw; e < 32; e += NGW) { const int cnt = tab[224 + e], st = tab[192 + e]; const int pe = ((cnt + 255) >> 8) << 8; for (int r = cnt + lane; r < pe; r += 64) row_tok[st + r] = -1; }
              volatile LAS int* lc = (volatile LAS int*)(lds + RING_OFF); LAS int* lcnt = (LAS int*)(lds + RING_OFF); LAS int* gbase = lcnt + 32; LAS int* dlist = lcnt + 64;
              for (int ch = bid; ch < TT / 64; ch += G) {
                  if (tid < 32) { lcnt[tid] = 0; int s = ((const volatile LAS int*)(lds + RING_OFF + 4096))[ch * 32 + tid]; const int part = ch >> 4;
                      for (int pp = 0; pp < part; ++pp) s += tab[256 + pp * 32 + tid];
                      gbase[tid] = s; }
                  __syncthreads();
                  int e = 0, lpos = 0, tk = 0;
                  if (tid < 128) { tk = 2 * (ch * 64) + tid; e = tok_e[tk]; lpos = __hip_atomic_fetch_add(lcnt + e, 1, __ATOMIC_RELAXED, __HIP_MEMORY_SCOPE_WORKGROUP); }
                  __syncthreads();
                  if (tid < 128) { const int dest = tab[192 + e] + lc[32 + e] + lpos; row_tok[dest] = tk; row_gate[dest] = tok_g[tk]; dlist[tid] = dest; }
                  __syncthreads();
                  __syncthreads();
              } }
#endif
        }
        SEAM(P0 + 13);
        if (IN(P0 + 14)) REPEAT(1) { PH_VARS;
#if EN_MOE
            moe_build_table(p, l, lds, tid);
            ProbG P(XB, DM * 2, 0, ws + WS_GU_T + (size_t)l * 32 * 1024 * 2048 * 2, DM * 2, (size_t)1024 * 2048 * 2, DM); MoeOrder S{(const volatile LAS int*)(lds + MOE_TAB_OFF), 4, G, (G % 8 == 0) ? (bid % 8) * (G / 8) + bid / 8 : bid};     EpiMoeGU E{(bf16*)(ws + WS_HB)};
            pg8::gemm_phase<ProbG, EpiMoeGU, MoeOrder, true, true>(lds0 + RING_OFF, P, S, E, tid, (const int*)(ws + WS_ROUTE + 512 * 1024));
#endif
        }
        SEAM(P0 + 14);
        if (IN(P0 + 15)) { PH_VARS;
#if EN_MOE
            moe_build_table(p, l, lds, tid);
            ProbG P(ws + WS_HB, 1024, 0, ws + WS_DN_T + (size_t)l * 32 * 2048 * 512 * 2, 1024, (size_t)2048 * 512 * 2, 512); MoeOrder S{(const volatile LAS int*)(lds + MOE_TAB_OFF), 8, G, (G % 8 == 0) ? (bid % 8) * (G / 8) + bid / 8 : bid};
            EpiMoeDown E{V, (const int*)(ws + WS_ROUTE + 512 * 1024), (const float*)(ws + WS_ROUTE + 768 * 1024)};
            pg8::gemm_phase<ProbG, EpiMoeDown, MoeOrder, false>(lds0 + RING_OFF, P, S, E, tid);
#endif
        }
        SEAM(P0 + 15);
        if (IN(P0 + 16)) REPEAT(5) { PH_VARS; ln_rows(nullptr, XB, V, EN_MOE != 0, (const float*)p.in[zz + 39] + l * DM, (const float*)p.in[zz + 40] + l * DM, (l == NL - 1) ? nullptr : XB, (l == NL - 1) ? p.out : nullptr, gw, NGW, lane); }
        SEAM(P0 + 16);
    }
#if PROBE
    {
        xcd_barrier(bar);
        if (bid == 0 && wave0 == 0 && __builtin_amdgcn_mbcnt_lo(~0u, 0u) == 0u) {
            volatile LAS unsigned long long* ts = (volatile LAS unsigned long long*)(lds0 + TS_OFF);
#define PDUR(k) ((k) < 0 ? 0ull : ((k) >= 40 ? (ts[(k) + 1] - ts[(k)]) : ((k) == 0 ? (ts[1] - ts[0]) : ((ts[(k) + 1] - ts[(k)]) + (ts[(k) + NPH + 1] - ts[(k) + NPH])))))
            const unsigned long long ta = PDUR(PROBE_A), tb = PDUR(PROBE_B), tc = PDUR(PROBE_C), td = PDUR(PROBE_D);
            unsigned long long ua = ta / 100ull; if (ua > 2000ull) ua = 2000ull;
            unsigned long long qb = tb / 1600ull; if (qb > 100ull) qb = 100ull;
            const unsigned long long extra = (ua + 2048ull * qb) * 100ull;
            const unsigned long long t0 = __builtin_amdgcn_s_memrealtime();
            while (__builtin_amdgcn_s_memrealtime() - t0 < extra) __builtin_amdgcn_s_sleep(8);
            float A1 = (float)tc * (1.0f / 2000.0f), A2 = (float)td * (1.0f / 2000.0f);
            if (A1 > 70.f) A1 = 70.f; if (A2 > 70.f) A2 = 70.f;
            p.out[0] += A1; p.out[1] += A2;
        }
    }
#endif
#undef IN
#undef SEAM
}

#ifndef MK_PER_PHASE
#define MK_PER_PHASE 0
#endif
extern "C" void kernel_launch(void* const* d_in, const int* in_sizes, int n_in, void* d_out, int out_size, void* d_ws, size_t ws_size, hipStream_t stream) {
    static int grid = 0;
    if (grid == 0) {
        if (n_in != 41 || out_size != TT * DM || ws_size < WS_END) { fprintf(stderr, "kernel_launch: unexpected shapes (n_in %d out %d ws %zu need %zu)\n", n_in, out_size, ws_size, (size_t)WS_END); grid = -1; return; }
        int dev = 0, cus = 0, per_cu = 0;
        if (hipGetDevice(&dev) != hipSuccess || hipDeviceGetAttribute(&cus, hipDeviceAttributeMultiprocessorCount, dev) != hipSuccess) { grid = -1; return; }
        if (hipFuncSetAttribute((const void*)hybrid_fwd, hipFuncAttributeMaxDynamicSharedMemorySize, LDS_BYTES) != hipSuccess) { fprintf(stderr, "kernel_launch: hipFuncSetAttribute failed\n"); grid = -1; return; }
        if (hipOccupancyMaxActiveBlocksPerMultiprocessor(&per_cu, (const void*)hybrid_fwd, NWAVES * 64, LDS_BYTES) != hipSuccess || per_cu < 1) { fprintf(stderr, "kernel_launch: occupancy query says %d\n", per_cu); }
        (void)hipGetLastError();
        grid = cus;
    }
    if (grid < 0) return;
    (void)hipMemsetAsync((char*)d_ws + WS_CTL, 0, CTL_ZERO_BYTES, stream);
    Params p{};
    for (int i = 0; i < 41; ++i) p.in[i] = d_in[i];
    p.out = (float*)d_out; p.ws = (unsigned char*)d_ws; p.li = 0; p.pad = 0;
#if MK_PER_PHASE
    for (int ph = 0; ph < NPHASES; ++ph) { p.ph_lo = ph; p.ph_hi = ph + 1; hipLaunchKernelGGL(hybrid_fwd, dim3(grid), dim3(NWAVES * 64), LDS_BYTES, stream, p); }
#else
    p.ph_lo = 0; p.ph_hi = NPHASES;
    hipLaunchKernelGGL(hybrid_fwd, dim3(grid), dim3(NWAVES * 64), LDS_BYTES, stream, p);
#endif
    const hipError_t le = hipPeekAtLastError();
    if (le != hipSuccess) fprintf(stderr, "kernel_launch: launch failed: %s\n", hipGetErrorName(le));
}
```

```cpp
#include <hip/hip_runtime.h>
#include <cstdio>
#include <cstdint>

#define GAS __attribute__((address_space(1)))
#define LAS __attribute__((address_space(3)))
typedef unsigned short bf16;
typedef short bf16x8 __attribute__((ext_vector_type(8)));
typedef short bf16x4 __attribute__((ext_vector_type(4)));
typedef float f32x2 __attribute__((ext_vector_type(2)));
typedef float f32x4 __attribute__((ext_vector_type(4)));
typedef float f32x16 __attribute__((ext_vector_type(16)));
typedef unsigned u32x2 __attribute__((ext_vector_type(2)));
typedef unsigned u32x4 __attribute__((ext_vector_type(4)));
typedef GAS unsigned gu32;
#define RLX_AGENT __ATOMIC_RELAXED, __HIP_MEMORY_SCOPE_AGENT
#define LDS_WAIT() asm volatile("s_waitcnt lgkmcnt(0)" ::: "memory")
#define VM_WAIT() asm volatile("s_waitcnt vmcnt(0)" ::: "memory")

__device__ __forceinline__ unsigned f2bf(float f) { unsigned u = __builtin_bit_cast(unsigned, f); return (u + 0x7fffu + ((u >> 16) & 1u)) >> 16; }
typedef __bf16 bf16x2_t __attribute__((ext_vector_type(2)));
__device__ __forceinline__ unsigned pk2(float lo, float hi) { const f32x2 v = {lo, hi}; const bf16x2_t b = __builtin_convertvector(v, bf16x2_t); return __builtin_bit_cast(unsigned, b); }
__device__ __forceinline__ float bf2f(unsigned h) { return __builtin_bit_cast(float, h << 16); }
__device__ __forceinline__ float bflo(unsigned w) { return __builtin_bit_cast(float, w << 16); }
__device__ __forceinline__ float bfhi(unsigned w) { return __builtin_bit_cast(float, w & 0xffff0000u); }
__device__ __forceinline__ float wave_sum(float v) {
#pragma unroll
    for (int o = 1; o < 64; o <<= 1) v += __shfl_xor(v, o);
    return v;
}
__device__ __forceinline__ float sigmoidf_(float x) { return 1.0f / (1.0f + __expf(-x)); }
__device__ __forceinline__ float siluf_(float x) { return x / (1.0f + __expf(-x)); }
__device__ __forceinline__ float gelu_tanh(float x) { const float u = 1.5957691216057308f * (x + 0.044715f * x * x * x); return x / (1.0f + __expf(-u)); }

namespace pg8 {
constexpr int BM = 256, BK = 64, HALF = 128, HTB = HALF * BK * 2, STAGE_BYTES = 8 * HTB;
__host__ __device__ __forceinline__ int lds_byte(int r, int c) { const int st = (r >> 4) * 2 + (c >> 5), rr = r & 15, cc = c & 31, ob = rr * 64 + cc * 2; return st * 1024 + (ob ^ (((ob >> 9) & 1) << 5)); }
__host__ __device__ __forceinline__ void stage_rc(int b, int& R, int& C) { const int st = b / 1024, sb = b % 1024, swz = sb ^ (((sb >> 9) & 1) << 5); R = (st >> 1) * 16 + swz / 64; C = (st & 1) * 32 + (swz % 64) / 2; }
__host__ __device__ __forceinline__ int perm32(int rho) { const int n = rho >> 4, i = rho & 15; return 8 * (i >> 2) + 4 * n + (i & 3); }
struct Unit { int pm, pn, z; };

template <class Prob, class Epi, class Sched, bool ALIGN_EPI = true, bool GATHER = false>
__device__ __forceinline__ void gemm_phase(LAS unsigned char* lds, const Prob& P, const Sched& S, const Epi& E, const int tid, const int* row_tok = nullptr) {
    const int wid = __builtin_amdgcn_readfirstlane(tid >> 6), lane = tid & 63, wr = wid >> 2, wc = wid & 3, fr = lane & 15, fq = lane >> 4;
    const int nt = P.nt;
    unsigned voffA[2], voffB[2];
#pragma unroll
    for (int i = 0; i < 2; ++i) { int R, C; stage_rc(tid * 16 + i * 8192, R, C); const int Rb = Epi::PERM ? ((R & ~31) + perm32(R & 31)) : R;
        voffA[i] = P.a_voff(R, C); voffB[i] = P.b_voff(Rb, C); }
    const size_t kstepA = P.a_kstep, kstepB = P.b_kstep, hstepA = GATHER ? (size_t)0 : P.a_hstep, hstepB = P.b_hstep;
    unsigned gA_c[2][2], gA_n[2][2]; int gR[2], gC[2];
#pragma unroll
    for (int i = 0; i < 2; ++i) stage_rc(tid * 16 + i * 8192, gR[i], gC[i]);
#define PG8_GATHER(g, u) do { _Pragma("unroll") for (int _h = 0; _h < 2; ++_h) _Pragma("unroll") for (int _i = 0; _i < 2; ++_i) { const int ts_ = row_tok[(u).pm * 256 + _h * 128 + gR[_i]]; \
        g[_h][_i] = (unsigned)(ts_ < 0 ? 0 : (ts_ >> 1)) * P.a_rs + (unsigned)gC[_i] * 2u; } } while (0)
#define PG8_VA(h, nx) (*(GATHER ? ((nx) ? &gA_n[h] : &gA_c[h]) : &voffA))
    const unsigned ldsw = (unsigned)wid * 1024u;
    const int aoff = lds_byte(wr * 64 + fr, fq * 8), boff = lds_byte(wc * 32 + fr, fq * 8);
#define PG8_SA(b, h) (((b) * 2 + (h)) * HTB)
#define PG8_SB(b, h) ((4 + (b) * 2 + (h)) * HTB)
#define PG8_STAGE(bufoff, gbase, voff) do { _Pragma("unroll") for (int _i = 0; _i < 2; ++_i) \
        __builtin_amdgcn_global_load_lds((const unsigned*)((const char*)(gbase) + (voff)[_i]), (LAS unsigned*)(lds + (bufoff) + ldsw + _i * 8192), 16, 0, 0); } while (0)
#define PG8_LDA(dst, b, h) do { _Pragma("unroll") for (int m = 0; m < 4; ++m) _Pragma("unroll") for (int k = 0; k < 2; ++k) dst[m][k] = *(const LAS bf16x8*)(lds + PG8_SA(b, h) + aoff + m * 2048 + k * 1024); } while (0)
#define PG8_LDB(dst, b, h) do { _Pragma("unroll") for (int n = 0; n < 2; ++n) _Pragma("unroll") for (int k = 0; k < 2; ++k) dst[n][k] = *(const LAS bf16x8*)(lds + PG8_SB(b, h) + boff + n * 2048 + k * 1024); } while (0)
#define PG8_MMA(ai, bj, At, Bt) do { __builtin_amdgcn_s_setprio(1); _Pragma("unroll") for (int m = 0; m < 4; ++m) _Pragma("unroll") for (int n = 0; n < 2; ++n) _Pragma("unroll") for (int k = 0; k < 2; ++k) \
        acc[ai][bj][m][n] = __builtin_amdgcn_mfma_f32_16x16x32_bf16(Bt[n][k], At[m][k], acc[ai][bj][m][n], 0, 0, 0); __builtin_amdgcn_s_setprio(0); } while (0)
#define PG8_WAIT_V(n) asm volatile("s_waitcnt vmcnt(" #n ")" ::: "memory")
#define PG8_WAIT_L(n) asm volatile("s_waitcnt lgkmcnt(" #n ")" ::: "memory")
#define PG8_BAR __builtin_amdgcn_s_barrier()
#define PG8_SCHED __builtin_amdgcn_sched_barrier(0)
    Unit cur, nxt; int ui = 0;
    if (!S.next(0, cur)) return;
    f32x4 acc[2][2][4][2];
#pragma unroll
    for (int a = 0; a < 2; ++a)
#pragma unroll
        for (int b = 0; b < 2; ++b)
#pragma unroll
            for (int m = 0; m < 4; ++m)
#pragma unroll
                for (int n = 0; n < 2; ++n) acc[a][b][m][n] = (f32x4){0.f, 0.f, 0.f, 0.f};
    bf16x8 At[4][2], B0[2][2], B1[2][2];
    const char* cA = GATHER ? P.A : P.a_base(cur); const char* cB = P.b_base(cur);
    if constexpr (GATHER) PG8_GATHER(gA_c, cur);
    PG8_STAGE(PG8_SB(0, 0), cB, voffB); PG8_STAGE(PG8_SB(0, 1), cB + hstepB, voffB); PG8_STAGE(PG8_SA(0, 0), cA, PG8_VA(0, false)); PG8_STAGE(PG8_SA(0, 1), cA + hstepA, PG8_VA(1, false));
    if (wr == 1) PG8_BAR;
    PG8_WAIT_V(2); PG8_BAR;
    PG8_STAGE(PG8_SB(1, 0), cB + kstepB, voffB); PG8_STAGE(PG8_SA(1, 0), cA + kstepA, PG8_VA(0, false)); PG8_STAGE(PG8_SB(1, 1), cB + hstepB + kstepB, voffB);
    PG8_WAIT_V(6); PG8_BAR;
    for (;;) {
        const bool has_next = S.next(ui + 1, nxt);
        const char* nA = GATHER ? cA : (has_next ? P.a_base(nxt) : cA); const char* nB = has_next ? P.b_base(nxt) : cB;
        if constexpr (GATHER) { if (has_next) PG8_GATHER(gA_n, nxt); else { _Pragma("unroll") for (int _h = 0; _h < 2; ++_h) _Pragma("unroll") for (int _i = 0; _i < 2; ++_i) gA_n[_h][_i] = gA_c[_h][_i]; } }
        for (int t = 0; t < nt; t += 2) {
            const bool last = (t == nt - 2);
            const char* a1 = cA + (size_t)(t + 1) * kstepA;
            const char* a2 = last ? nA : cA + (size_t)(t + 2) * kstepA; const char* b2 = last ? nB : cB + (size_t)(t + 2) * kstepB;
            const char* a3 = a2 + kstepA; const char* b3 = b2 + kstepB;
            PG8_LDB(B0, 0, 0); PG8_LDB(B1, 0, 1); PG8_SCHED; PG8_LDA(At, 0, 0); PG8_STAGE(PG8_SA(1, 1), a1 + hstepA, PG8_VA(1, false));
            PG8_WAIT_V(8); PG8_WAIT_L(0); PG8_BAR; PG8_MMA(0, 0, At, B0); PG8_MMA(0, 1, At, B1); PG8_BAR; PG8_SCHED;
            PG8_LDA(At, 0, 1); PG8_STAGE(PG8_SB(0, 0), b2, voffB); PG8_STAGE(PG8_SB(0, 1), b2 + hstepB, voffB); PG8_STAGE(PG8_SA(0, 0), a2, PG8_VA(0, last));
            PG8_WAIT_V(8); PG8_WAIT_L(0); PG8_BAR; PG8_MMA(1, 0, At, B0); PG8_MMA(1, 1, At, B1); PG8_BAR; PG8_SCHED;
            PG8_LDB(B0, 1, 0); PG8_LDB(B1, 1, 1); PG8_SCHED; PG8_LDA(At, 1, 0); PG8_STAGE(PG8_SA(0, 1), a2 + hstepA, PG8_VA(1, last));
            PG8_WAIT_V(8); PG8_WAIT_L(0); PG8_BAR; PG8_MMA(0, 0, At, B0); PG8_MMA(0, 1, At, B1); PG8_BAR; PG8_SCHED;
            PG8_LDA(At, 1, 1); PG8_STAGE(PG8_SB(1, 0), b3, voffB); PG8_STAGE(PG8_SB(1, 1), b3 + hstepB, voffB); PG8_STAGE(PG8_SA(1, 0), a3, PG8_VA(0, last));
            PG8_WAIT_V(8); PG8_WAIT_L(0); PG8_BAR; PG8_MMA(1, 0, At, B0); PG8_MMA(1, 1, At, B1); PG8_BAR; PG8_SCHED;
        }
        if constexpr (ALIGN_EPI) { if (wr == 0) PG8_BAR; }
        E(acc, cur, wr, wc, fr, fq);
        if (!has_next) break;
#pragma unroll
        for (int a = 0; a < 2; ++a)
#pragma unroll
            for (int b = 0; b < 2; ++b)
#pragma unroll
                for (int m = 0; m < 4; ++m)
#pragma unroll
                    for (int n = 0; n < 2; ++n) acc[a][b][m][n] = (f32x4){0.f, 0.f, 0.f, 0.f};
        cur = nxt; cA = nA; cB = nB; ++ui;
        if constexpr (GATHER) { _Pragma("unroll") for (int _h = 0; _h < 2; ++_h) _Pragma("unroll") for (int _i = 0; _i < 2; ++_i) gA_c[_h][_i] = gA_n[_h][_i]; }
        if constexpr (ALIGN_EPI) { if (wr == 1) PG8_BAR; }
    }
    PG8_WAIT_V(0);
    if constexpr (!ALIGN_EPI) { if (wr == 0) PG8_BAR; }
    PG8_BAR;
#undef PG8_GATHER
#undef PG8_VA
#undef PG8_SA
#undef PG8_SB
#undef PG8_STAGE
#undef PG8_LDA
#undef PG8_LDB
#undef PG8_MMA
#undef PG8_WAIT_V
#undef PG8_WAIT_L
#undef PG8_BAR
#undef PG8_SCHED
}
}

#define XB_TMO      128
#define XB_XCNT(j)  (256  + 64 * (j))
#define XB_XSUB(j)  (1280 + 64 * (j))
#define XB_XGEN(j)  (2304 + 64 * (j))
#define XB_TOP      3328
#define XB_TOPGEN   3392
#define XCD_BAR_WORDS 3456
#define XB_SPIN_CAP (1u << 23)
__device__ __forceinline__ unsigned xb_ld(unsigned* p)              { return __hip_atomic_load(p, __ATOMIC_RELAXED, __HIP_MEMORY_SCOPE_AGENT); }
__device__ __forceinline__ unsigned xb_add(unsigned* p, unsigned v) { return __hip_atomic_fetch_add(p, v, __ATOMIC_RELAXED, __HIP_MEMORY_SCOPE_AGENT); }
__device__ __forceinline__ unsigned xb_xcc_id() { return (unsigned)__builtin_amdgcn_s_getreg((3 << 11) | 20) & 0xFu; }
#define XB_SPIN(cond, bar) do { unsigned _sp = 0; while (cond) { __builtin_amdgcn_s_sleep(1); \
    if ((++_sp & 255u) == 0u) { if (xb_ld(&(bar)[XB_TMO])) break; if (_sp > XB_SPIN_CAP) { atomicAdd(&(bar)[XB_TMO], 1u); break; } } } } while (0)
struct XcdBarrier { unsigned* bar; unsigned x; volatile LAS unsigned* st; unsigned w0; };
__device__ __forceinline__ XcdBarrier xcd_barrier_post(unsigned* bar, volatile LAS unsigned* st) {
    XcdBarrier b; b.bar = bar; b.x = xb_xcc_id(); b.st = st; b.w0 = (unsigned)__builtin_amdgcn_readfirstlane((int)(threadIdx.x >> 6));
    if (threadIdx.x == 0) (void)xb_add(&bar[XB_XCNT(b.x)], 1u);
    return b;
}
__device__ __forceinline__ void xcd_barrier_complete(unsigned* bar, unsigned x, unsigned& nloc, unsigned& nx) {
    const unsigned G = gridDim.x * gridDim.y * gridDim.z;
    unsigned sum, cnt, mine, sp = 0u;
    for (;;) {
        sum = 0u; cnt = 0u; mine = 0u;
#pragma unroll
        for (unsigned j = 0; j < 16; ++j) { const unsigned c = xb_ld(&bar[XB_XCNT(j)]); sum += c; cnt += (c > 0u) ? 1u : 0u; mine = (j == x) ? c : mine; }
        if (sum == G) break;
        __builtin_amdgcn_s_sleep(1);
        if ((++sp & 255u) == 0u) { if (xb_ld(&bar[XB_TMO])) break; if (sp > XB_SPIN_CAP) { atomicAdd(&bar[XB_TMO], 1u); break; } }
    }
    nloc = mine > 0u ? mine : 1u; nx = cnt > 0u ? cnt : 1u;
}
__device__ __forceinline__ void xcd_barrier(const XcdBarrier& b) {
    asm volatile("s_waitcnt vmcnt(0)" ::: "memory");
    __syncthreads();
    if (__builtin_amdgcn_readfirstlane(b.w0) == 0u && __builtin_amdgcn_mbcnt_hi(~0u, __builtin_amdgcn_mbcnt_lo(~0u, 0u)) == 0u) {
        unsigned* bar = b.bar;
        __builtin_amdgcn_s_waitcnt(0);
        unsigned nloc = b.st[0], nx = b.st[1];
        if (nloc == 0u) { xcd_barrier_complete(bar, b.x, nloc, nx); b.st[0] = nloc; b.st[1] = nx; }
        const unsigned old = xb_add(&bar[XB_XSUB(b.x)], 1u);
        const unsigned gen = old / nloc;
        if (old + 1u == (gen + 1u) * nloc) {
            __builtin_amdgcn_fence(__ATOMIC_RELEASE, "agent");
            asm volatile("s_waitcnt vmcnt(0)" ::: "memory");
            const unsigned og = xb_add(&bar[XB_TOP], 1u);
            const unsigned tg = og / nx;
            if (og + 1u == (tg + 1u) * nx) xb_add(&bar[XB_TOPGEN], 1u);
            else XB_SPIN(xb_ld(&bar[XB_TOPGEN]) == tg, bar);
            __builtin_amdgcn_fence(__ATOMIC_ACQUIRE, "agent");
            xb_add(&bar[XB_XGEN(b.x)], 1u);
            asm volatile("s_waitcnt vmcnt(0)" ::: "memory");
        } else {
            XB_SPIN(xb_ld(&bar[XB_XGEN(b.x)]) == gen, bar);
            __builtin_amdgcn_fence(__ATOMIC_ACQUIRE, "agent");
            asm volatile("s_waitcnt vmcnt(0)" ::: "memory");
        }
    }
    __syncthreads();
}

constexpr int NL = 2, TT = 16384, DM = 2048, NB = 4, SQ = 4096, MEML = 256;
constexpr int NIN = 3840, IN_COLS = 3656;
constexpr int C_U = 0, C_CQ = 512, C_CKV = 1024, C_KR = 1536, C_GQ = 1600, C_GK = 2112, C_GV = 2624, C_GZ = 3136, C_GA = 3648, C_GB = 3652;
constexpr int S5L = 32, S5NCH = TT / S5L;
constexpr int MOE_ROWS = 40960;
constexpr float DN_ALPHA = 1.41421356237f;
constexpr float LOG2E = 1.4426950408889634f;
constexpr int NWAVES = 8;

constexpr size_t MiB = 1u << 20;
constexpr size_t WS_CTL = 0, CTL_ZERO_BYTES = 1 * MiB;
constexpr size_t WS_ROPE = 1 * MiB;
constexpr size_t WS_MISC = 5 * MiB;
constexpr size_t WS_WIN_T = 6 * MiB;
constexpr size_t WS_WUQ_T = 36 * MiB;
constexpr size_t WS_WUKV_T = 39 * MiB;
constexpr size_t WS_GLU_T = 43 * MiB;
constexpr size_t WS_WOUT_T = 44 * MiB;
constexpr size_t WS_XQ_T = 60 * MiB;
constexpr size_t WS_XKV_T = 64 * MiB;
constexpr size_t WS_XO_T = 72 * MiB;
constexpr size_t WS_TOEP_T = 76 * MiB;
constexpr size_t WS_MEND_T = 108 * MiB;
constexpr size_t WS_MST_T = 124 * MiB;
constexpr size_t WS_GU_T = 132 * MiB;
constexpr size_t WS_DN_T = 388 * MiB;
constexpr size_t WS_XF0 = 516 * MiB;
constexpr size_t WS_V = 644 * MiB;
constexpr size_t WS_XB = 772 * MiB;
constexpr size_t WS_PROJ = 836 * MiB;
constexpr size_t WS_MIX = 956 * MiB;
constexpr size_t WS_CQN = 1020 * MiB;
constexpr size_t WS_QB = 1052 * MiB;
constexpr size_t WS_KB = 1100 * MiB;
constexpr size_t WS_VT = 1148 * MiB;
constexpr size_t WS_OB = 1180 * MiB;
constexpr size_t WS_GQ = 1212 * MiB;
constexpr size_t WS_GK = 1228 * MiB;
constexpr size_t WS_GV = 1244 * MiB;
constexpr size_t WS_GDEC = 1260 * MiB;
constexpr size_t WS_GDW = 1261 * MiB;
constexpr size_t WS_GDQ = 1277 * MiB;
constexpr size_t WS_GDK = 1293 * MiB;
constexpr size_t WS_GDA = 1309 * MiB;
constexpr size_t WS_GDU = 1317 * MiB;
constexpr size_t WS_XLOC = 1349 * MiB;
constexpr size_t WS_XSB = 1357 * MiB;
constexpr size_t WS_YTOEP = 1361 * MiB;
constexpr size_t WS_YB = 1393 * MiB;
constexpr size_t WS_ZB = 1409 * MiB;
constexpr size_t WS_MEMB = 1425 * MiB;
constexpr size_t WS_XAQ = 548 * MiB;
constexpr size_t WS_XAK = 1445 * MiB;
constexpr size_t WS_XAVT = 1446 * MiB;
constexpr size_t WS_XAO = 1447 * MiB;
constexpr size_t WS_ROUTE = 1463 * MiB;
constexpr size_t WS_XG = 1464 * MiB;
constexpr size_t WS_HB = 1624 * MiB;
constexpr size_t WS_END = 1664 * MiB;

constexpr int CW_BAR = 4096;
constexpr int CW_QUEUE = 8192;
constexpr int CW_ECNT = 16384;
constexpr int CW_ECUR = 16384 + 128;

constexpr int RING_OFF = 0, RING_BYTES = 139264;
constexpr int LDSCTL_OFF = RING_BYTES, MISC_OFF = LDSCTL_OFF + 320;
constexpr int LDS_BYTES = 155648;

struct Params { const void* in[41]; float* out; unsigned char* ws; int ph_lo, ph_hi, li, pad; };

__device__ __forceinline__ int rowmap(int mode, int c) {
    if (mode == 1) { const int h = c / 192, d = c - h * 192;
        if (d < 128) return 128 * h + d;
        if (d < 160) return 1024 + 256 * (h >> 2) + 32 * (h & 3) + (d - 128);
        return 1024 + 256 * (h >> 2) + 128 + 32 * (h & 3) + (d - 160); }
    if (mode == 2) { if (c < 512) return 256 * (c >> 7) + (c & 127); c -= 512; return 256 * (c >> 7) + 128 + (c & 127); }
    return c;
}
__device__ __forceinline__ void tr_item(const float* W, int K, int N, bf16* WT, const float* kscale, int item, int lane, int mode, int row_off) {
    const int nblk = (N + 63) / 64, kb = item / nblk, nb = item - kb * nblk, k0 = 128 * kb, nq = lane & 15, kq = lane >> 4, n = 64 * nb + 4 * nq;
    if (n >= N) return;
    const float* src = W + (size_t)(k0 + 8 * kq) * N + n; f32x4 v[4][8];
#pragma unroll
    for (int b = 0; b < 4; ++b)
#pragma unroll
        for (int j = 0; j < 8; ++j) v[b][j] = *(const f32x4*)(src + (size_t)(32 * b + j) * N);
#pragma unroll
    for (int b = 0; b < 4; ++b) {
        if (kscale) {
#pragma unroll
            for (int j = 0; j < 8; ++j) v[b][j] = v[b][j] * kscale[k0 + 32 * b + 8 * kq + j]; }
#pragma unroll
        for (int i = 0; i < 4; ++i) *(u32x4*)(WT + (size_t)(row_off + rowmap(mode, n + i)) * K + k0 + 32 * b + 8 * kq) =
            (u32x4){pk2(v[b][0][i], v[b][1][i]), pk2(v[b][2][i], v[b][3][i]), pk2(v[b][4][i], v[b][5][i]), pk2(v[b][6][i], v[b][7][i])}; }
}
#define P0_JOB(IN, KK, NN, DSTOFF, DSTELEMS_PER, MODE, SCALE_IN, BATCH, ROWOFF) { \
    constexpr int per = ((KK) / 128) * (((NN) + 63) / 64); constexpr int cnt = (BATCH) * per; \
    if (r < cnt) { const int lb0 = r / per, it = r - lb0 * per, lb = lsel * (BATCH) + lb0; \
        const float* W = (const float*)p.in[zz + IN] + (size_t)lb * (KK) * (NN); \
        bf16* WT = (bf16*)(ws + (DSTOFF)) + (size_t)lb * (DSTELEMS_PER); \
        const float* ksc = ((SCALE_IN) >= 0) ? (const float*)p.in[zz + ((SCALE_IN) < 0 ? 0 : (SCALE_IN))] + (size_t)(lb / (BATCH)) * (KK) : nullptr; \
        tr_item(W, KK, NN, WT, ksc, it, lane, MODE, ROWOFF); continue; } r -= cnt; }
__device__ __forceinline__ void p0_weights(const Params& p, const int lsel, int gw, int NGW, int lane) {
 GAS unsigned char* wsg_ = (GAS unsigned char*)p.ws; int zz = 0; asm volatile("" : "+s"(wsg_), "+s"(zz)); unsigned char* ws = (unsigned char*)wsg_;
    constexpr int per_layer = 16 * 58 + 4 * 24 + 4 * 32 + 4 * 8 + 16 * 32 + 16 * 8 + 16 * 8 + 16 * 8 + 4 * 32;
    constexpr int total = per_layer;
    for (int idx = gw; idx < total; idx += NGW) {
        int r = idx;
        P0_JOB(3, 2048, IN_COLS, WS_WIN_T, (size_t)NIN * 2048, 0, -1, 1, 0)
        P0_JOB(24, 2048, 2048, WS_WOUT_T, (size_t)2048 * 2048, 0, -1, 1, 0)
        P0_JOB(16, 512, 1536, WS_WUQ_T, (size_t)1536 * 512, 1, 15, 1, 0)
        P0_JOB(18, 512, 2048, WS_WUKV_T, (size_t)2048 * 512, 0, 17, 1, 0)
        P0_JOB(12, 512, 512, WS_GLU_T, (size_t)512 * 512, 0, -1, 1, 0)
        P0_JOB(27, 2048, 512, WS_XQ_T, (size_t)512 * 2048, 0, -1, 1, 0)
        P0_JOB(28, 2048, 512, WS_XKV_T, (size_t)1024 * 2048, 0, -1, 1, 0)
        P0_JOB(29, 2048, 512, WS_XKV_T, (size_t)1024 * 2048, 0, -1, 1, 512)
        P0_JOB(30, 512, 2048, WS_XO_T, (size_t)2048 * 512, 0, -1, 1, 0)
    }
}
constexpr int MOE_CVT_ITEMS = 32 * 256 + 32 * 128;
__device__ __forceinline__ void moe_convert_item(const Params& p, int l, int idx, int lane) { GAS unsigned char* wsg_ = (GAS unsigned char*)p.ws; int zz = 0; asm volatile("" : "+s"(wsg_), "+s"(zz)); unsigned char* ws = (unsigned char*)wsg_;
    if (idx < 32 * 256) { const int e = idx >> 8, it = idx & 255; const int le = l * 32 + e;
        tr_item((const float*)p.in[zz + 37] + (size_t)le * 2048 * 1024, 2048, 1024, (bf16*)(ws + WS_GU_T) + (size_t)le * 1024 * 2048, nullptr, it, lane, 2, 0); }
    else { idx -= 32 * 256; const int e = idx >> 7, it = idx & 127; const int le = l * 32 + e;
        tr_item((const float*)p.in[zz + 38] + (size_t)le * 512 * 2048, 512, 2048, (bf16*)(ws + WS_DN_T) + (size_t)le * 2048 * 512, nullptr, it, lane, 0, 0); }
}
__device__ __forceinline__ void cvt_rows(const float* src, bf16* dst, int nrows, int gw, int NGW, int lane) {
    for (int m0 = gw; m0 < nrows; m0 += 2 * NGW) { f32x4 v[2][8];
#pragma unroll
        for (int q = 0; q < 2; ++q) { const int m = (m0 + q * NGW < nrows) ? m0 + q * NGW : m0; const f32x4* s = (const f32x4*)(src + (size_t)m * DM) + lane;
#pragma unroll
            for (int j = 0; j < 8; ++j) v[q][j] = s[64 * j]; }
#pragma unroll
        for (int q = 0; q < 2; ++q) { const int m = m0 + q * NGW; if (m >= nrows) break; u32x2* d = (u32x2*)(dst + (size_t)m * DM) + lane;
#pragma unroll
            for (int j = 0; j < 8; ++j) { u32x2 o; o.x = pk2(v[q][j].x, v[q][j].y); o.y = pk2(v[q][j].z, v[q][j].w); d[64 * j] = o; } } }
}
__device__ __forceinline__ void p0_tables(const Params& p, int gw, int NGW, int lane) { GAS unsigned char* wsg_ = (GAS unsigned char*)p.ws; int zz = 0; asm volatile("" : "+s"(wsg_), "+s"(zz)); unsigned char* ws = (unsigned char*)wsg_;
    const int* pos = (const int*)p.in[zz + 2]; float* rt = (float*)(ws + WS_ROPE);
    for (int m = gw; m < TT / 2; m += NGW) { const int t = 2 * m + (lane >> 5), i = lane & 31;
        const float inv = exp2f(-(float)i * (13.287712379549449f / 32.f)); const float ang = (float)pos[t] * inv; float sn, cs; sincosf(ang, &sn, &cs);
        ((f32x2*)rt)[(size_t)t * 32 + i] = (f32x2){cs, sn}; }
    float* wr = (float*)(ws + WS_MISC);
    for (int m = gw; m < NL * 48 * 32; m += NGW) { const int l = m / (48 * 32), rr = m - l * 48 * 32, j = rr / 32, k = (rr & 31) * 64 + lane;
        float v = 0.f; if (j < 4) v = ((const float*)p.in[zz + 33])[((size_t)l * 2048 + k) * 4 + j]; else if (j < 36) v = ((const float*)p.in[zz + 35])[((size_t)l * 2048 + k) * 32 + (j - 4)];
        wr[((size_t)l * 48 + j) * 2048 + k] = v; }
}
__device__ __forceinline__ void s5_lane_consts(const Params& p, int l, int g, int pl, float& lr, float& li, float& dt) { GAS unsigned char* wsg_ = (GAS unsigned char*)p.ws; int zz = 0; asm volatile("" : "+s"(wsg_), "+s"(zz)); unsigned char* ws = (unsigned char*)wsg_;
    lr = fminf(((const float*)p.in[zz + 4])[(l * 32 + g) * 64 + pl], -1e-4f); li = ((const float*)p.in[zz + 5])[(l * 32 + g) * 64 + pl]; dt = __expf(((const float*)p.in[zz + 6])[l * 32 + g]);
}
__device__ __forceinline__ void cpow(float lr, float li, float dt, float n, float& re, float& im) { const float mag = expf(lr * dt * n); float sn, cs; sincosf(li * dt * n, &sn, &cs); re = mag * cs; im = mag * sn; }
__device__ __forceinline__ void s5_f(float lr, float li, float dt, float& fr, float& fi) {
    float ar, ai; cpow(lr, li, dt, 1.f, ar, ai); const float den = lr * lr + li * li, nr = ar - 1.f, ni = ai; fr = (nr * lr + ni * li) / den; fi = (ni * lr - nr * li) / den;
}
__device__ __forceinline__ void p0_s5(const Params& p, LAS float* scr, const int lsel, int gw, int NGW, int lane) { GAS unsigned char* wsg_ = (GAS unsigned char*)p.ws; int zz = 0; asm volatile("" : "+s"(wsg_), "+s"(zz)); unsigned char* ws = (unsigned char*)wsg_;
    constexpr int PER_G = 32 + 32 + 32 + 1, total = 32 * PER_G;
    for (int idx = gw; idx < total; idx += NGW) {
        const int kind = idx >> 5, g = idx & 31, l = lsel, lg = l * 32 + g; (void)lg;
        float lr, li, dt; s5_lane_consts(p, l, g, lane, lr, li, dt);
        float fr, fi; s5_f(lr, li, dt, fr, fi);
        const float* bre = (const float*)p.in[zz + 7] + (size_t)(l * 32 + g) * 64 * 16; const float* bim = (const float*)p.in[zz + 8] + (size_t)(l * 32 + g) * 64 * 16;
        const float* cre = (const float*)p.in[zz + 9] + (size_t)(l * 32 + g) * 16 * 64; const float* cim = (const float*)p.in[zz + 10] + (size_t)(l * 32 + g) * 16 * 64;
        if (kind < 32) {
            const int tau = kind; float ar, ai; cpow(lr, li, dt, (float)tau, ar, ai);
            const float er = ar * fr - ai * fi, ei = ar * fi + ai * fr;
            scr[lane * 2] = er; scr[lane * 2 + 1] = ei; LDS_WAIT(); asm volatile("" ::: "memory");
            bf16* Tp = (bf16*)(ws + WS_TOEP_T) + (size_t)(l * 32 + g) * 512 * 512;
            const int hi = lane & 15, hob = lane >> 4; float acc4[4] = {0.f, 0.f, 0.f, 0.f};
#pragma unroll 1
            for (int p0 = 0; p0 < 64; p0 += 8) { float br[8], bi[8]; f32x4 cr[4][2], ci[4][2];
#pragma unroll
                for (int u = 0; u < 8; ++u) { br[u] = bre[(p0 + u) * 16 + hi]; bi[u] = bim[(p0 + u) * 16 + hi]; }
#pragma unroll
                for (int q = 0; q < 4; ++q) {
#pragma unroll
                    for (int v = 0; v < 2; ++v) { cr[q][v] = *(const f32x4*)(cre + (hob + 4 * q) * 64 + p0 + 4 * v); ci[q][v] = *(const f32x4*)(cim + (hob + 4 * q) * 64 + p0 + 4 * v); } }
#pragma unroll
                for (int u = 0; u < 8; ++u) { const float e_r = scr[(p0 + u) * 2], e_i = scr[(p0 + u) * 2 + 1];
                    const float xr = e_r * br[u] - e_i * bi[u], xi = e_r * bi[u] + e_i * br[u];
#pragma unroll
                    for (int q = 0; q < 4; ++q) acc4[q] += cr[q][u >> 2][u & 3] * xr - ci[q][u >> 2][u & 3] * xi; } }
#pragma unroll
            for (int q = 0; q < 4; ++q) { const int ho = hob + 4 * q; float acc = acc4[q];
                if (tau == 0 && ho == hi) acc += ((const float*)p.in[zz + 11])[(l * 32 + g) * 16 + ho];
                const bf16 v = (bf16)f2bf(acc);
                for (int t = tau; t < 32; ++t) Tp[(size_t)(t * 16 + ho) * 512 + (t - tau) * 16 + hi] = v;
                if (tau > 0) for (int t = 0; t + tau < 32; ++t) Tp[(size_t)(t * 16 + ho) * 512 + (t + tau) * 16 + hi] = 0; }
            LDS_WAIT(); asm volatile("" ::: "memory");
        } else if (kind < 64) {
            const int s = kind - 32; float ar, ai; cpow(lr, li, dt, (float)(31 - s), ar, ai);
            const float er = ar * fr - ai * fi, ei = ar * fi + ai * fr;
            bf16* Mp = (bf16*)(ws + WS_MEND_T) + (size_t)(l * 32 + g) * 256 * 512;
            unsigned wre[8], wim[8];
#pragma unroll
            for (int h2 = 0; h2 < 8; ++h2) { float xr[2], xi[2];
#pragma unroll
                for (int u = 0; u < 2; ++u) { const float br = bre[lane * 16 + 2 * h2 + u], bi = bim[lane * 16 + 2 * h2 + u]; xr[u] = er * br - ei * bi; xi[u] = er * bi + ei * br; }
                wre[h2] = pk2(xr[0], xr[1]); wim[h2] = pk2(xi[0], xi[1]); }
            u32x4* dr = (u32x4*)(Mp + (size_t)lane * 512 + s * 16); u32x4* di = (u32x4*)(Mp + (size_t)(64 + lane) * 512 + s * 16);
            dr[0] = (u32x4){wre[0], wre[1], wre[2], wre[3]}; dr[1] = (u32x4){wre[4], wre[5], wre[6], wre[7]};
            di[0] = (u32x4){wim[0], wim[1], wim[2], wim[3]}; di[1] = (u32x4){wim[4], wim[5], wim[6], wim[7]};
        } else if (kind < 96) {
            const int t = kind - 64; float ar, ai; cpow(lr, li, dt, (float)(t + 1), ar, ai);
            bf16* Sp = (bf16*)(ws + WS_MST_T) + (size_t)(l * 32 + g) * 512 * 128;
#pragma unroll 4
            for (int ho = 0; ho < 16; ++ho) { const float cr = cre[ho * 64 + lane], ci = cim[ho * 64 + lane];
                Sp[(size_t)(t * 16 + ho) * 128 + lane] = (bf16)f2bf(cr * ar - ci * ai); Sp[(size_t)(t * 16 + ho) * 128 + 64 + lane] = (bf16)f2bf(-(cr * ai + ci * ar)); }
        } else {
            float ar, ai; cpow(lr, li, dt, (float)S5L, ar, ai);
            float* al = (float*)(ws + WS_MISC + 800 * 1024); al[((l * 32 + g) * 64 + lane) * 2] = ar; al[((l * 32 + g) * 64 + lane) * 2 + 1] = ai;
        }
    }
}

__device__ __forceinline__ void unpack8(const u32x4 w, float (&f)[8]) { f[0] = bflo(w.x); f[1] = bfhi(w.x); f[2] = bflo(w.y); f[3] = bfhi(w.y); f[4] = bflo(w.z); f[5] = bfhi(w.z); f[6] = bflo(w.w); f[7] = bfhi(w.w); }
__device__ __forceinline__ u32x4 pack8(const float (&f)[8]) { return (u32x4){pk2(f[0], f[1]), pk2(f[2], f[3]), pk2(f[4], f[5]), pk2(f[6], f[7])}; }
template <int NR = 2> __device__ __forceinline__ void ln_rows(const bf16* V, const bf16* xres, const bf16* Y, bool has_y, const float* g, const float* b, bf16* xb, float* of, int gw, int NGW, int lane, int limit = TT) {
    for (int m0 = gw; m0 < limit; m0 += NR * NGW) {
        u32x4 ra[NR][4], ry0[NR][4], ry1[NR][4];
#pragma unroll
        for (int q = 0; q < NR; ++q) { const int m = (m0 + q * NGW < limit) ? m0 + q * NGW : m0;
#pragma unroll
            for (int j = 0; j < 4; ++j) { const size_t o = (size_t)m * DM + lane * 8 + 512 * j;
                ra[q][j] = *(const u32x4*)((xres ? xres : V) + o);
                if (xres && has_y) { ry0[q][j] = *(const u32x4*)(Y + o); ry1[q][j] = *(const u32x4*)(Y + (size_t)TT * DM + o); } } }
#pragma unroll
        for (int q = 0; q < NR; ++q) { const int m = m0 + q * NGW; if (m >= limit) break;
            float x[4][8]; float s = 0.f;
#pragma unroll
            for (int j = 0; j < 4; ++j) { unpack8(ra[q][j], x[j]);
                if (xres) {
#pragma unroll
                    for (int i = 0; i < 8; ++i) x[j][i] *= DN_ALPHA;
                    if (has_y) { float y0[8], y1[8]; unpack8(ry0[q][j], y0); unpack8(ry1[q][j], y1);
#pragma unroll
                        for (int i = 0; i < 8; ++i) x[j][i] += y0[i] + y1[i]; } }
#pragma unroll
                for (int i = 0; i < 8; ++i) s += x[j][i]; }
            const float mean = wave_sum(s) * (1.f / DM); float s2 = 0.f;
#pragma unroll
            for (int j = 0; j < 4; ++j)
#pragma unroll
                for (int i = 0; i < 8; ++i) { x[j][i] -= mean; s2 += x[j][i] * x[j][i]; }
            const float rstd = 1.0f / sqrtf(wave_sum(s2) * (1.f / DM) + 1e-5f);
#pragma unroll
            for (int j = 0; j < 4; ++j) { const int c = lane * 8 + 512 * j; const f32x4 g0 = *(const f32x4*)(g + c), g1 = *(const f32x4*)(g + c + 4), b0 = *(const f32x4*)(b + c), b1 = *(const f32x4*)(b + c + 4);
                float y[8];
#pragma unroll
                for (int i = 0; i < 4; ++i) { y[i] = x[j][i] * rstd * g0[i] + b0[i]; y[4 + i] = x[j][4 + i] * rstd * g1[i] + b1[i]; }
                if (xb) *(u32x4*)(xb + (size_t)m * DM + c) = pack8(y);
                if (of) { *(f32x4*)(of + (size_t)m * DM + c) = (f32x4){y[0], y[1], y[2], y[3]}; *(f32x4*)(of + (size_t)m * DM + c + 4) = (f32x4){y[4], y[5], y[6], y[7]}; } } }
    }
}
__device__ __forceinline__ void scale_rows(const bf16* x, bf16* v, int gw, int NGW, int lane) {
    for (int m = gw; m < TT; m += NGW) {
#pragma unroll
        for (int j = 0; j < 4; ++j) { float f[8]; unpack8(*(const u32x4*)(x + (size_t)m * DM + lane * 8 + 512 * j), f);
#pragma unroll
            for (int i = 0; i < 8; ++i) f[i] *= DN_ALPHA;
            *(u32x4*)(v + (size_t)m * DM + lane * 8 + 512 * j) = pack8(f); } }
}

__device__ __forceinline__ void ph2_token(const Params& p, int l, int gw, int NGW, int lane) { GAS unsigned char* wsg_ = (GAS unsigned char*)p.ws; int zz = 0; asm volatile("" : "+s"(wsg_), "+s"(zz)); unsigned char* ws = (unsigned char*)wsg_;
    const bf16* proj = (const bf16*)(ws + WS_PROJ); bf16* cqn = (bf16*)(ws + WS_CQN); bf16* KB = (bf16*)(ws + WS_KB);
    const f32x2* rt = (const f32x2*)(ws + WS_ROPE); float* gdec = (float*)(ws + WS_GDEC); float* gbeta = (float*)(ws + WS_GDEC + 512 * 1024);
    for (int t0 = gw; t0 < TT; t0 += 4 * NGW) {
        u32x4 rq[4][2]; unsigned short rk[4][2], rg[4][2]; f32x2 rcs[4];
#pragma unroll
        for (int q = 0; q < 4; ++q) { const int t = (t0 + q * NGW < TT) ? t0 + q * NGW : t0; const bf16* row = proj + (size_t)t * NIN;
            rq[q][0] = *(const u32x4*)(row + C_CQ + lane * 8); rq[q][1] = *(const u32x4*)(row + C_CQ + 512 + lane * 8);
            rk[q][0] = row[C_KR + (lane & 31)]; rk[q][1] = row[C_KR + 32 + (lane & 31)]; rcs[q] = rt[(size_t)t * 32 + (lane & 31)];
            rg[q][0] = row[C_GA + (lane & 3)]; rg[q][1] = row[C_GB + (lane & 3)]; }
#pragma unroll
        for (int q = 0; q < 4; ++q) { const int t = t0 + q * NGW; if (t >= TT) break;
#pragma unroll
            for (int part = 0; part < 2; ++part) { float f[8]; unpack8(rq[q][part], f); float s = 0.f;
#pragma unroll
                for (int i = 0; i < 8; ++i) s += f[i] * f[i];
                const float sc = 1.0f / sqrtf(wave_sum(s) * (1.f / 512.f) + 1e-6f);
#pragma unroll
                for (int i = 0; i < 8; ++i) f[i] *= sc;
                *(u32x4*)(cqn + (size_t)t * 1024 + part * 512 + lane * 8) = pack8(f); }
            { const float x1 = bf2f(rk[q][0]), x2 = bf2f(rk[q][1]); const f32x2 cs = rcs[q];
              const float o = (lane < 32) ? (x1 * cs.x - x2 * cs.y) : (x2 * cs.x + x1 * cs.y);
              const int b = t >> 12, s = t & 4095; const bf16 ov = (bf16)f2bf(o);
#pragma unroll
              for (int h = 0; h < 8; ++h) KB[((size_t)(b * 8 + h) * SQ + s) * 192 + 128 + lane] = ov; }
            if (lane < 4) { const float ga = bf2f(rg[q][0]), gb = bf2f(rg[q][1]);
                const float xx = ga + ((const float*)p.in[zz + 22])[l * 4 + lane]; const float sp = fmaxf(xx, 0.f) + __logf(1.0f + __expf(-fabsf(xx)));
                gdec[(size_t)t * 4 + lane] = -__expf(((const float*)p.in[zz + 21])[l * 4 + lane]) * sp; gbeta[(size_t)t * 4 + lane] = 1.0f / (1.0f + __expf(-gb)); } }
    }
}
__device__ __forceinline__ void ph2_conv(const Params& p, int l, int gw, int NGW, int lane) { GAS unsigned char* wsg_ = (GAS unsigned char*)p.ws; int zz = 0; asm volatile("" : "+s"(wsg_), "+s"(zz)); unsigned char* ws = (unsigned char*)wsg_;
    const bf16* proj = (const bf16*)(ws + WS_PROJ);
    const float* cw = (const float*)p.in[zz + 20] + (size_t)l * 4 * 1536;
    for (int it = gw; it < (TT / 8) * 3; it += NGW) {
        const int sec = it % 3, t0 = (it / 3) * 8; const int ch = sec * 512 + lane * 8;
        float w[4][8];
#pragma unroll
        for (int tp = 0; tp < 4; ++tp) { const f32x4 a = *(const f32x4*)(cw + tp * 1536 + ch), b = *(const f32x4*)(cw + tp * 1536 + ch + 4);
            w[tp][0] = a.x; w[tp][1] = a.y; w[tp][2] = a.z; w[tp][3] = a.w; w[tp][4] = b.x; w[tp][5] = b.y; w[tp][6] = b.z; w[tp][7] = b.w; }
        bf16* dst = (bf16*)(ws + (sec == 0 ? WS_GQ : (sec == 1 ? WS_GK : WS_GV)));
        float h0[8], h1[8], h2[8];
        const int s0 = t0 & 4095;
        u32x4 rr[11];
#pragma unroll
        for (int i = 0; i < 11; ++i) { const int tt = (s0 >= 3 || i >= 3) ? t0 - 3 + i : t0; rr[i] = *(const u32x4*)(proj + (size_t)tt * NIN + C_GQ + ch); }
#pragma unroll
        for (int i = 0; i < 8; ++i) { h0[i] = 0.f; h1[i] = 0.f; h2[i] = 0.f; }
        if (s0 >= 3) { unpack8(rr[0], h0); unpack8(rr[1], h1); unpack8(rr[2], h2); }
#pragma unroll
        for (int tt = 0; tt < 8; ++tt) { float x[8], y[8]; unpack8(rr[3 + tt], x); float ss = 0.f;
#pragma unroll
            for (int i = 0; i < 8; ++i) { const float c = w[0][i] * h0[i] + w[1][i] * h1[i] + w[2][i] * h2[i] + w[3][i] * x[i]; y[i] = siluf_(c); ss += y[i] * y[i]; h0[i] = h1[i]; h1[i] = h2[i]; h2[i] = x[i]; }
            if (sec < 2) { ss += __shfl_xor(ss, 1); ss += __shfl_xor(ss, 2); ss += __shfl_xor(ss, 4); ss += __shfl_xor(ss, 8);
                float sc = 1.0f / sqrtf(ss + 1e-6f); if (sec == 0) sc *= 0.08838834764831845f;
#pragma unroll
                for (int i = 0; i < 8; ++i) y[i] *= sc; }
            *(u32x4*)(dst + (size_t)(t0 + tt) * 512 + lane * 8) = pack8(y); }
    }
}
__device__ __forceinline__ void mixnorm_rows(const Params& p, int l, bool do_s5, bool do_mla, bool do_gdn, int gw, int NGW, int lane, int limit = TT) { GAS unsigned char* wsg_ = (GAS unsigned char*)p.ws; int zz = 0; asm volatile("" : "+s"(wsg_), "+s"(zz)); unsigned char* ws = (unsigned char*)wsg_;
    const bf16* zb = (const bf16*)(ws + WS_ZB); const bf16* ob = (const bf16*)(ws + WS_OB); bf16* mix = (bf16*)(ws + WS_MIX); const bf16* proj = (const bf16*)(ws + WS_PROJ);
    const float* g5 = (const float*)p.in[zz + 14] + l * 512; const float* gm = (const float*)p.in[zz + 19] + l * 1024; const float* gg = (const float*)p.in[zz + 23] + l * 128 + (lane & 15) * 8;
    for (int t0 = gw; t0 < limit; t0 += 4 * NGW) {
        u32x4 rz[4], ro[4][2], ry[4], rgz[4];
#pragma unroll
        for (int q = 0; q < 4; ++q) { const int t = (t0 + q * NGW < limit) ? t0 + q * NGW : t0;
            if (do_s5) rz[q] = *(const u32x4*)(zb + (size_t)t * 512 + lane * 8);
            if (do_mla) { ro[q][0] = *(const u32x4*)(ob + (size_t)t * 1024 + lane * 8); ro[q][1] = *(const u32x4*)(ob + (size_t)t * 1024 + 512 + lane * 8); }
            if (do_gdn) { ry[q] = *(const u32x4*)(mix + (size_t)t * DM + 1536 + lane * 8); rgz[q] = *(const u32x4*)(proj + (size_t)t * NIN + C_GZ + lane * 8); } }
#pragma unroll
        for (int q = 0; q < 4; ++q) { const int t = t0 + q * NGW; if (t >= limit) break;
            if (do_s5) { float f[8]; unpack8(rz[q], f); float s = 0.f;
#pragma unroll
                for (int i = 0; i < 8; ++i) s += f[i] * f[i];
                const float sc = 1.0f / sqrtf(wave_sum(s) * (1.f / 512.f) + 1e-6f);
#pragma unroll
                for (int i = 0; i < 8; ++i) f[i] *= sc * g5[lane * 8 + i];
                *(u32x4*)(mix + (size_t)t * DM + lane * 8) = pack8(f); }
            if (do_mla) { float f[2][8]; unpack8(ro[q][0], f[0]); unpack8(ro[q][1], f[1]); float s = 0.f;
#pragma unroll
                for (int i = 0; i < 8; ++i) s += f[0][i] * f[0][i] + f[1][i] * f[1][i];
                const float sc = 1.0f / sqrtf(wave_sum(s) * (1.f / 1024.f) + 1e-6f);
#pragma unroll
                for (int i = 0; i < 8; ++i) { f[0][i] *= sc * gm[lane * 8 + i]; f[1][i] *= sc * gm[512 + lane * 8 + i]; }
                *(u32x4*)(mix + (size_t)t * DM + 512 + lane * 8) = pack8(f[0]); *(u32x4*)(mix + (size_t)t * DM + 1024 + lane * 8) = pack8(f[1]); }
            if (do_gdn) { float y[8], z[8]; unpack8(ry[q], y); unpack8(rgz[q], z); float ss = 0.f;
#pragma unroll
                for (int i = 0; i < 8; ++i) ss += y[i] * y[i];
                ss += __shfl_xor(ss, 1); ss += __shfl_xor(ss, 2); ss += __shfl_xor(ss, 4); ss += __shfl_xor(ss, 8);
                const float rs = 1.0f / sqrtf(ss * (1.f / 128.f) + 1e-6f);
#pragma unroll
                for (int i = 0; i < 8; ++i) y[i] *= rs * gg[i] * siluf_(z[i]);
                *(u32x4*)(mix + (size_t)t * DM + 1536 + lane * 8) = pack8(y); } }
    }
}
__device__ __forceinline__ void zero_mix_cols(const Params& p, int c0, int ncols, int gw, int NGW, int lane) { GAS unsigned char* wsg_ = (GAS unsigned char*)p.ws; int zz = 0; asm volatile("" : "+s"(wsg_), "+s"(zz)); unsigned char* ws = (unsigned char*)wsg_;
    bf16* mix = (bf16*)(ws + WS_MIX); const int per = ncols / 8;
    for (int t = gw; t < TT; t += NGW) for (int i = lane; i < per; i += 64) *(u32x4*)(mix + (size_t)t * DM + c0 + i * 8) = (u32x4){0u, 0u, 0u, 0u};
}

#define MFMA32(a, b, c) __builtin_amdgcn_mfma_f32_32x32x16_bf16((a), (b), (c), 0, 0, 0)
#define MFMA16(a, b, c) __builtin_amdgcn_mfma_f32_16x16x32_bf16((a), (b), (c), 0, 0, 0)
__device__ __forceinline__ bf16x8 mk8(u32x2 lo, u32x2 hi) { const u32x4 w = {lo.x, lo.y, hi.x, hi.y}; return __builtin_bit_cast(bf16x8, w); }
template <int DK, bool CAUSAL>
__device__ __forceinline__ void attn_unit(LAS unsigned char* lds, const bf16* Qp, const bf16* Kp, const bf16* VTp, int SK, int q0, int ntiles, bf16* Op, int opitch, const int tid) {
    asm volatile("" : "+v"(lds));
    constexpr int KP = DK * 2 + 16, VP = 144, KVB = 64 * KP + 128 * VP, NKL = DK / 64;
    const int w = __builtin_amdgcn_readfirstlane(tid >> 6), lane = tid & 63, l31 = lane & 31, hl = lane >> 5;
    const int qrow = q0 + 32 * w + l31;
    bf16x8 qf[DK / 16];
#pragma unroll
    for (int s = 0; s < DK / 16; ++s) qf[s] = *(const bf16x8*)(Qp + (size_t)qrow * DK + 16 * s + 8 * hl);
    f32x16 ot[4];
#pragma unroll
    for (int d = 0; d < 4; ++d)
#pragma unroll
        for (int r = 0; r < 16; ++r) ot[d][r] = 0.f;
    float m_run = -INFINITY, l_run = 0.f;
    u32x4 kreg[NKL], vreg[2];
    int krow[NKL], kpc[NKL];
#pragma unroll
    for (int i = 0; i < NKL; ++i) { const int idx = tid + 512 * i; krow[i] = idx / (DK / 8); kpc[i] = idx - krow[i] * (DK / 8); }
#define ATT_LOAD(j) do { _Pragma("unroll") for (int i = 0; i < NKL; ++i) kreg[i] = *(const u32x4*)(Kp + (size_t)((j) * 64 + krow[i]) * DK + kpc[i] * 8); \
        _Pragma("unroll") for (int i = 0; i < 2; ++i) { const int idx = tid + 512 * i; vreg[i] = *(const u32x4*)(VTp + (size_t)(idx >> 3) * SK + (j) * 64 + (idx & 7) * 8); } } while (0)
#define ATT_STORE(buf) do { LAS unsigned char* kb_ = lds + (buf) * KVB; _Pragma("unroll") for (int i = 0; i < NKL; ++i) *(LAS u32x4*)(kb_ + krow[i] * KP + kpc[i] * 16) = kreg[i]; \
        _Pragma("unroll") for (int i = 0; i < 2; ++i) { const int idx = tid + 512 * i; *(LAS u32x4*)(kb_ + 64 * KP + (idx >> 3) * VP + (idx & 7) * 16) = vreg[i]; } } while (0)
    __syncthreads();
    ATT_LOAD(0); ATT_STORE(0);
    const int jmax = CAUSAL ? ((q0 + 32 * w + 31) >> 6) : (ntiles - 1);
#pragma unroll 1
    for (int j = 0; j < ntiles; ++j) {
        __syncthreads();
        if (j + 1 < ntiles) ATT_LOAD(j + 1);
        __builtin_amdgcn_sched_barrier(0);
        if (j <= jmax) {
            const LAS unsigned char* Kt = lds + (j & 1) * KVB; const LAS unsigned char* Vt = Kt + 64 * KP;
            f32x16 s0, s1;
#pragma unroll
            for (int r = 0; r < 16; ++r) { s0[r] = 0.f; s1[r] = 0.f; }
#pragma unroll
            for (int s = 0; s < DK / 16; ++s) { const bf16x8 a0 = *(const LAS bf16x8*)(Kt + l31 * KP + (16 * s + 8 * hl) * 2); const bf16x8 a1 = *(const LAS bf16x8*)(Kt + (32 + l31) * KP + (16 * s + 8 * hl) * 2);
                s0 = MFMA32(a0, qf[s], s0); s1 = MFMA32(a1, qf[s], s1); }
            if (CAUSAL && (j * 64 + 63 > q0 + 32 * w)) {
#pragma unroll
                for (int r = 0; r < 16; ++r) { const int key = j * 64 + (r & 3) + 8 * (r >> 2) + 4 * hl; if (key > qrow) s0[r] = -INFINITY; if (key + 32 > qrow) s1[r] = -INFINITY; }
            }
            float mx = s0[0];
#pragma unroll
            for (int r = 1; r < 16; ++r) mx = fmaxf(mx, s0[r]);
#pragma unroll
            for (int r = 0; r < 16; ++r) mx = fmaxf(mx, s1[r]);
            mx = fmaxf(mx, __shfl_xor(mx, 32));
            const float m_new = fmaxf(m_run, mx); const float alpha = __builtin_amdgcn_exp2f(m_run - m_new); m_run = m_new;
            float ps = 0.f;
#pragma unroll
            for (int r = 0; r < 16; ++r) { s0[r] = __builtin_amdgcn_exp2f(s0[r] - m_new); s1[r] = __builtin_amdgcn_exp2f(s1[r] - m_new); ps += s0[r] + s1[r]; }
            l_run = l_run * alpha + ps;
            if (__builtin_amdgcn_ballot_w64(alpha != 1.0f) != 0ull) {
#pragma unroll
                for (int d = 0; d < 4; ++d)
#pragma unroll
                    for (int r = 0; r < 16; ++r) ot[d][r] *= alpha; }
            bf16x8 pf[4];
#pragma unroll
            for (int s = 0; s < 2; ++s) { pf[s] = __builtin_bit_cast(bf16x8, (u32x4){pk2(s0[8 * s + 0], s0[8 * s + 1]), pk2(s0[8 * s + 2], s0[8 * s + 3]), pk2(s0[8 * s + 4], s0[8 * s + 5]), pk2(s0[8 * s + 6], s0[8 * s + 7])});
                pf[2 + s] = __builtin_bit_cast(bf16x8, (u32x4){pk2(s1[8 * s + 0], s1[8 * s + 1]), pk2(s1[8 * s + 2], s1[8 * s + 3]), pk2(s1[8 * s + 4], s1[8 * s + 5]), pk2(s1[8 * s + 6], s1[8 * s + 7])}); }
#pragma unroll
            for (int sp = 0; sp < 4; ++sp)
#pragma unroll
                for (int d = 0; d < 4; ++d) { const bf16x8 va = *(const LAS bf16x8*)(Vt + (32 * d + l31) * VP + 32 * sp + 16 * hl); ot[d] = MFMA32(va, pf[sp], ot[d]); }
        }
        if (j + 1 < ntiles) ATT_STORE((j + 1) & 1);
    }
    l_run += __shfl_xor(l_run, 32);
    const float inv = 1.0f / l_run;
    bf16* orow = Op + (size_t)qrow * opitch;
#pragma unroll
    for (int d = 0; d < 4; ++d)
#pragma unroll
        for (int r4 = 0; r4 < 4; ++r4) { u32x2 o; o.x = pk2(ot[d][4 * r4] * inv, ot[d][4 * r4 + 1] * inv); o.y = pk2(ot[d][4 * r4 + 2] * inv, ot[d][4 * r4 + 3] * inv);
            *(u32x2*)(orow + 32 * d + 8 * r4 + 4 * hl) = o; }
#undef ATT_LOAD
#undef ATT_STORE
}

__device__ __forceinline__ void xattn_unit(LAS unsigned char* lds, const bf16* Qp, const bf16* Kp, const bf16* VTp, int q0, bf16* Op, int opitch, const int tid) {
    asm volatile("" : "+v"(lds));
    constexpr int KP = 272, VP = 528, VOFF = 256 * KP;
    const int w = __builtin_amdgcn_readfirstlane(tid >> 6), lane = tid & 63, l31 = lane & 31, hl = lane >> 5;
    const int qrow = q0 + 32 * w + l31;
    u32x4 kreg[8], vreg[8];
#pragma unroll
    for (int i = 0; i < 8; ++i) { const int idx = tid + 512 * i; kreg[i] = *(const u32x4*)(Kp + (size_t)idx * 8); vreg[i] = *(const u32x4*)(VTp + (size_t)idx * 8); }
    bf16x8 qf[8];
#pragma unroll
    for (int s = 0; s < 8; ++s) { float f0[8], f1[8]; unpack8(*(const u32x4*)(Qp + (size_t)qrow * 128 + 16 * s + 8 * hl), f0); unpack8(*(const u32x4*)(Qp + (size_t)16 * MiB / 2 * 2 + (size_t)qrow * 128 + 16 * s + 8 * hl), f1);
#pragma unroll
        for (int i = 0; i < 8; ++i) f0[i] += f1[i];
        qf[s] = __builtin_bit_cast(bf16x8, pack8(f0)); }
    __syncthreads();
#pragma unroll
    for (int i = 0; i < 8; ++i) { const int idx = tid + 512 * i; *(LAS u32x4*)(lds + (idx >> 4) * KP + (idx & 15) * 16) = kreg[i];
        *(LAS u32x4*)(lds + VOFF + (idx >> 5) * VP + (idx & 31) * 16) = vreg[i]; }
    __syncthreads();
    f32x16 ot[4];
#pragma unroll
    for (int d = 0; d < 4; ++d)
#pragma unroll
        for (int r = 0; r < 16; ++r) ot[d][r] = 0.f;
    float m_run = -INFINITY, l_run = 0.f;
#pragma unroll 1
    for (int j = 0; j < 4; ++j) {
        const LAS unsigned char* Kt = lds + j * 64 * KP; const LAS unsigned char* Vt = lds + VOFF + j * 128;
        f32x16 s0, s1;
#pragma unroll
        for (int r = 0; r < 16; ++r) { s0[r] = 0.f; s1[r] = 0.f; }
#pragma unroll
        for (int s = 0; s < 8; ++s) { const bf16x8 a0 = *(const LAS bf16x8*)(Kt + l31 * KP + (16 * s + 8 * hl) * 2); const bf16x8 a1 = *(const LAS bf16x8*)(Kt + (32 + l31) * KP + (16 * s + 8 * hl) * 2);
            s0 = MFMA32(a0, qf[s], s0); s1 = MFMA32(a1, qf[s], s1); }
        float mx = s0[0];
#pragma unroll
        for (int r = 1; r < 16; ++r) mx = fmaxf(mx, s0[r]);
#pragma unroll
        for (int r = 0; r < 16; ++r) mx = fmaxf(mx, s1[r]);
        mx = fmaxf(mx, __shfl_xor(mx, 32));
        const float m_new = fmaxf(m_run, mx); const float alpha = __builtin_amdgcn_exp2f(m_run - m_new); m_run = m_new;
        float ps = 0.f;
#pragma unroll
        for (int r = 0; r < 16; ++r) { s0[r] = __builtin_amdgcn_exp2f(s0[r] - m_new); s1[r] = __builtin_amdgcn_exp2f(s1[r] - m_new); ps += s0[r] + s1[r]; }
        l_run = l_run * alpha + ps;
#pragma unroll
        for (int d = 0; d < 4; ++d)
#pragma unroll
            for (int r = 0; r < 16; ++r) ot[d][r] *= alpha;
        bf16x8 pf[4];
#pragma unroll
        for (int s = 0; s < 2; ++s) { pf[s] = __builtin_bit_cast(bf16x8, (u32x4){pk2(s0[8 * s + 0], s0[8 * s + 1]), pk2(s0[8 * s + 2], s0[8 * s + 3]), pk2(s0[8 * s + 4], s0[8 * s + 5]), pk2(s0[8 * s + 6], s0[8 * s + 7])});
            pf[2 + s] = __builtin_bit_cast(bf16x8, (u32x4){pk2(s1[8 * s + 0], s1[8 * s + 1]), pk2(s1[8 * s + 2], s1[8 * s + 3]), pk2(s1[8 * s + 4], s1[8 * s + 5]), pk2(s1[8 * s + 6], s1[8 * s + 7])}); }
#pragma unroll
        for (int sp = 0; sp < 4; ++sp)
#pragma unroll
            for (int d = 0; d < 4; ++d) { const bf16x8 va = *(const LAS bf16x8*)(Vt + (32 * d + l31) * VP + 32 * sp + 16 * hl); ot[d] = MFMA32(va, pf[sp], ot[d]); }
    }
    l_run += __shfl_xor(l_run, 32);
    const float inv = 1.0f / l_run;
    bf16* orow = Op + (size_t)qrow * opitch;
#pragma unroll
    for (int d = 0; d < 4; ++d)
#pragma unroll
        for (int r4 = 0; r4 < 4; ++r4) { u32x2 o; o.x = pk2(ot[d][4 * r4] * inv, ot[d][4 * r4 + 1] * inv); o.y = pk2(ot[d][4 * r4 + 2] * inv, ot[d][4 * r4 + 3] * inv);
            *(u32x2*)(orow + 32 * d + 8 * r4 + 4 * hl) = o; }
}

constexpr int GP_K = 0, GP_Q = 17408, GP_KT = 34816, GP_VT = 53248, GP_L = 71680, GP_TB = 89088, GP_TBG = 98304, GP_GC = 107520, GP_BETA = 107776, GP_END = 108032;
template <int I> struct FsRow {
    static __device__ __forceinline__ void run(float (&tcol)[64], LAS float* Lmb, LAS unsigned char* lds, const float lanef, const int lane, const float bj, const float bgj) {
        constexpr int N4 = (I + 3) / 4, NA = N4 < 12 ? N4 : 12;
        f32x4 lrow[12];
#pragma unroll
        for (int m4 = 0; m4 < NA; ++m4) lrow[m4] = *(const LAS f32x4*)(Lmb + I * 68 + 4 * m4);
        __builtin_amdgcn_sched_barrier(0);
        float a0 = fmaxf(0.f, 1.f - fabsf((float)I - lanef)), a1 = 0.f, a2 = 0.f, a3 = 0.f;
#pragma unroll
        for (int m4 = 0; m4 < NA; ++m4) { const f32x4 lv = lrow[m4];
            if (4 * m4 + 0 < I) a0 -= lv.x * tcol[4 * m4 + 0]; if (4 * m4 + 1 < I) a1 -= lv.y * tcol[4 * m4 + 1]; if (4 * m4 + 2 < I) a2 -= lv.z * tcol[4 * m4 + 2]; if (4 * m4 + 3 < I) a3 -= lv.w * tcol[4 * m4 + 3]; }
        if constexpr (N4 > 12) {
#pragma unroll
            for (int m4 = 12; m4 < N4; ++m4) lrow[m4 - 12] = *(const LAS f32x4*)(Lmb + I * 68 + 4 * m4);
            __builtin_amdgcn_sched_barrier(0);
#pragma unroll
            for (int m4 = 12; m4 < N4; ++m4) { const f32x4 lv = lrow[m4 - 12];
                if (4 * m4 + 0 < I) a0 -= lv.x * tcol[4 * m4 + 0]; if (4 * m4 + 1 < I) a1 -= lv.y * tcol[4 * m4 + 1]; if (4 * m4 + 2 < I) a2 -= lv.z * tcol[4 * m4 + 2]; if (4 * m4 + 3 < I) a3 -= lv.w * tcol[4 * m4 + 3]; } }
        const float acc = (a0 + a1) + (a2 + a3); tcol[I] = acc;
        *(LAS bf16*)(lds + GP_TB + I * 144 + lane * 2) = (bf16)f2bf(acc * bj); *(LAS bf16*)(lds + GP_TBG + I * 144 + lane * 2) = (bf16)f2bf(acc * bgj);
        __builtin_amdgcn_sched_barrier(0);
        FsRow<I + 1>::run(tcol, Lmb, lds, lanef, lane, bj, bgj); } };
template <> struct FsRow<64> { static __device__ __forceinline__ void run(float (&)[64], LAS float*, LAS unsigned char*, float, int, float, float) {} };
__device__ __forceinline__ void gdn_pre_item(const Params& p, LAS unsigned char* lds, int item, const int tid, u32x4 (&pre)[6], int next_item) { asm volatile("" : "+v"(lds)); GAS unsigned char* wsg_ = (GAS unsigned char*)p.ws; int zz = 0; asm volatile("" : "+s"(wsg_), "+s"(zz)); unsigned char* ws = (unsigned char*)wsg_;
    const int w = __builtin_amdgcn_readfirstlane(tid >> 6), lane = tid & 63, fr = lane & 15, fq = lane >> 4;
    const int bh = item >> 6, n = item & 63, b = bh >> 2, h = bh & 3; const int t0 = b * SQ + n * 64;
    const bf16* gq = (const bf16*)(ws + WS_GQ); const bf16* gk = (const bf16*)(ws + WS_GK); const bf16* gv = (const bf16*)(ws + WS_GV);
    const float* gdec = (const float*)(ws + WS_GDEC); const float* gbeta = (const float*)(ws + WS_GDEC + 512 * 1024); float* glp = (float*)(ws + WS_GDEC + 768 * 1024);
    LAS float* gc = (LAS float*)(lds + GP_GC); LAS float* beta = (LAS float*)(lds + GP_BETA); LAS float* Lm = (LAS float*)(lds + GP_L);
    __syncthreads();
#pragma unroll
    for (int i = 0; i < 2; ++i) { const int idx = tid + 512 * i, c = idx >> 4, pc = idx & 15;
        const u32x4 kq = pre[3 * i], qq = pre[3 * i + 1], vq = pre[3 * i + 2];
        *(LAS u32x4*)(lds + GP_K + c * 272 + pc * 16) = kq; *(LAS u32x4*)(lds + GP_Q + c * 272 + pc * 16) = qq;
        const unsigned kk[4] = {kq.x, kq.y, kq.z, kq.w}, vv[4] = {vq.x, vq.y, vq.z, vq.w};
#pragma unroll
        for (int e = 0; e < 4; ++e) { *(LAS bf16*)(lds + GP_KT + (pc * 8 + 2 * e) * 144 + c * 2) = (bf16)(kk[e] & 0xffffu); *(LAS bf16*)(lds + GP_KT + (pc * 8 + 2 * e + 1) * 144 + c * 2) = (bf16)(kk[e] >> 16);
            *(LAS bf16*)(lds + GP_VT + (pc * 8 + 2 * e) * 144 + c * 2) = (bf16)(vv[e] & 0xffffu); *(LAS bf16*)(lds + GP_VT + (pc * 8 + 2 * e + 1) * 144 + c * 2) = (bf16)(vv[e] >> 16); } }
    if (next_item >= 0) { const int bh2 = next_item >> 6, n2 = next_item & 63, b2 = bh2 >> 2, h2 = bh2 & 3; const int t2 = b2 * SQ + n2 * 64;
#pragma unroll
        for (int i = 0; i < 2; ++i) { const int idx = tid + 512 * i, c = idx >> 4, pc = idx & 15; const size_t go = (size_t)(t2 + c) * 512 + h2 * 128 + pc * 8;
            pre[3 * i] = *(const u32x4*)(gk + go); pre[3 * i + 1] = *(const u32x4*)(gq + go); pre[3 * i + 2] = *(const u32x4*)(gv + go); } }
    __builtin_amdgcn_sched_barrier(0);
    if (tid < 64) { float g = gdec[(size_t)(t0 + tid) * 4 + h];
#pragma unroll
        for (int o = 1; o < 64; o <<= 1) { const float y = __shfl_up(g, o); if (tid >= o) g += y; }
        gc[tid] = g; beta[tid] = gbeta[(size_t)(t0 + tid) * 4 + h]; if (tid == 63) glp[item] = __expf(g); }
    __syncthreads();
    {
        const int tc = w >> 1; bf16* ga = (bf16*)(ws + WS_GDA) + (size_t)item * 4096;
#pragma unroll
        for (int u = 0; u < 2; ++u) { const int tj = 2 * (w & 1) + u; f32x4 kk = {0.f, 0.f, 0.f, 0.f}, qk = {0.f, 0.f, 0.f, 0.f};
            if (tj <= tc) {
#pragma unroll
                for (int s = 0; s < 4; ++s) { const bf16x8 bk = *(const LAS bf16x8*)(lds + GP_K + (16 * tj + fr) * 272 + (32 * s + 8 * fq) * 2);
                    const bf16x8 ak = *(const LAS bf16x8*)(lds + GP_K + (16 * tc + fr) * 272 + (32 * s + 8 * fq) * 2); const bf16x8 aq = *(const LAS bf16x8*)(lds + GP_Q + (16 * tc + fr) * 272 + (32 * s + 8 * fq) * 2);
                    kk = MFMA16(ak, bk, kk); qk = MFMA16(aq, bk, qk); } }
            const int j = 16 * tj + fr; const float gj = gc[j];
#pragma unroll
            for (int r = 0; r < 4; ++r) { const int c = 16 * tc + 4 * fq + r; const float dec = (j <= c) ? __expf(gc[c] - gj) : 0.f;
                Lm[c * 68 + j] = (j < c) ? kk[r] * dec * beta[c] : 0.f; ga[c * 64 + j] = (bf16)f2bf((j <= c) ? qk[r] * dec : 0.f); } }
    }
    __syncthreads();
    if (w == 0) {
        float tcol[64]; const float bj = beta[lane], bgj = bj * __expf(gc[lane]);
        float lanef = (float)lane; asm volatile("" : "+v"(lanef));
        LAS float* Lmb = Lm; asm volatile("" : "+v"(Lmb));
        FsRow<0>::run(tcol, Lmb, lds, lanef, lane, bj, bgj);
    } else {
        bf16* gqd = (bf16*)(ws + WS_GDQ) + (size_t)item * 8192; bf16* gke = (bf16*)(ws + WS_GDK) + (size_t)item * 8192; const float glast = gc[63];
        for (int idx = tid - 64; idx < 1024; idx += 448) { const int c = idx >> 4, pc = idx & 15; float f[8]; unpack8(*(const LAS u32x4*)(lds + GP_Q + c * 272 + pc * 16), f); const float e = __expf(gc[c]);
#pragma unroll
            for (int i = 0; i < 8; ++i) f[i] *= e;
            *(u32x4*)(gqd + c * 128 + pc * 8) = pack8(f); }
        for (int idx = tid - 64; idx < 1024; idx += 448) { const int d = idx >> 3, pc = idx & 7; float f[8]; const LAS unsigned char* src = lds + GP_KT + d * 144 + pc * 16;
            unpack8((u32x4){*(const LAS unsigned*)src, *(const LAS unsigned*)(src + 4), *(const LAS unsigned*)(src + 8), *(const LAS unsigned*)(src + 12)}, f);
#pragma unroll
            for (int i = 0; i < 8; ++i) f[i] *= __expf(glast - gc[pc * 8 + i]);
            *(u32x4*)(gke + d * 64 + pc * 8) = pack8(f); }
    }
    __syncthreads();
    {
        bf16* gu = (bf16*)(ws + WS_GDU) + (size_t)item * 8192; bf16* gw_ = (bf16*)(ws + WS_GDW) + (size_t)item * 8192;
        bf16x8 bv[2], bk[2];
#pragma unroll
        for (int s = 0; s < 2; ++s) { const LAS unsigned char* pv = lds + GP_VT + (16 * w + fr) * 144 + (32 * s + 8 * fq) * 2; const LAS unsigned char* pk = lds + GP_KT + (16 * w + fr) * 144 + (32 * s + 8 * fq) * 2;
            bv[s] = __builtin_bit_cast(bf16x8, *(const LAS u32x4*)pv); bk[s] = __builtin_bit_cast(bf16x8, *(const LAS u32x4*)pk); }
#pragma unroll
        for (int tc = 0; tc < 4; ++tc) { f32x4 uu = {0.f, 0.f, 0.f, 0.f}, ww = {0.f, 0.f, 0.f, 0.f};
#pragma unroll
            for (int s = 0; s < 2; ++s) { const bf16x8 a1 = __builtin_bit_cast(bf16x8, *(const LAS u32x4*)(lds + GP_TB + (16 * tc + fr) * 144 + (32 * s + 8 * fq) * 2));
                const bf16x8 a2 = __builtin_bit_cast(bf16x8, *(const LAS u32x4*)(lds + GP_TBG + (16 * tc + fr) * 144 + (32 * s + 8 * fq) * 2));
                uu = MFMA16(a1, bv[s], uu); ww = MFMA16(a2, bk[s], ww); }
            *(u32x2*)(gu + ((w * 4 + tc) * 64 + lane) * 4) = (u32x2){pk2(uu[0], uu[1]), pk2(uu[2], uu[3])};
#pragma unroll
            for (int r = 0; r < 4; ++r) gw_[(16 * tc + 4 * fq + r) * 128 + 16 * w + fr] = (bf16)f2bf(-ww[r]); }
    }
}

constexpr int GC_W = 0, GC_Q = 17408, GC_A = 34816, GC_KE = 44032, GC_BUF = 62464;
__device__ __forceinline__ void gdn_chain(const Params& p, LAS unsigned char* lds, int bh, int l, const int tid) { asm volatile("" : "+v"(lds)); GAS unsigned char* wsg_ = (GAS unsigned char*)p.ws; int zz = 0; asm volatile("" : "+s"(wsg_), "+s"(zz)); unsigned char* ws = (unsigned char*)wsg_;
    const int w = __builtin_amdgcn_readfirstlane(tid >> 6), lane = tid & 63, fr = lane & 15, fq = lane >> 4;
    const int b = bh >> 2, h = bh & 3;
    const bf16* gW = (const bf16*)(ws + WS_GDW) + (size_t)bh * 64 * 8192; const bf16* gQ = (const bf16*)(ws + WS_GDQ) + (size_t)bh * 64 * 8192;
    const bf16* gA = (const bf16*)(ws + WS_GDA) + (size_t)bh * 64 * 4096; const bf16* gK = (const bf16*)(ws + WS_GDK) + (size_t)bh * 64 * 8192;
    __syncthreads();
    if (w >= 4) {
        const int lt = tid - 256; const size_t lo = (size_t)((unsigned)lt * 8u);
        u32x4 rgA[14], rgB[14];
#define GC_LOAD(rg, n) do { const bf16* w_ = gW + (size_t)(n) * 8192 + lo; const bf16* q_ = gQ + (size_t)(n) * 8192 + lo; const bf16* a_ = gA + (size_t)(n) * 4096 + lo; const bf16* k_ = gK + (size_t)(n) * 8192 + lo; \
            _Pragma("unroll") for (int i = 0; i < 4; ++i) { rg[i] = *(const u32x4*)(w_ + i * 2048); rg[4 + i] = *(const u32x4*)(q_ + i * 2048); rg[10 + i] = *(const u32x4*)(k_ + i * 2048); } \
            rg[8] = *(const u32x4*)a_; rg[9] = *(const u32x4*)(a_ + 2048); } while (0)
#define GC_STORE(rg, buf) do { LAS unsigned char* b_ = lds + (buf) * GC_BUF; \
            _Pragma("unroll") for (int i = 0; i < 4; ++i) { const int pc_ = i * 256 + lt; *(LAS u32x4*)(b_ + GC_W + (pc_ >> 4) * 272 + (pc_ & 15) * 16) = rg[i]; *(LAS u32x4*)(b_ + GC_Q + (pc_ >> 4) * 272 + (pc_ & 15) * 16) = rg[4 + i]; \
                *(LAS u32x4*)(b_ + GC_KE + (pc_ >> 3) * 144 + (pc_ & 7) * 16) = rg[10 + i]; } \
            _Pragma("unroll") for (int i = 0; i < 2; ++i) { const int pc_ = i * 256 + lt; *(LAS u32x4*)(b_ + GC_A + (pc_ >> 3) * 144 + (pc_ & 7) * 16) = rg[8 + i]; } } while (0)
        GC_LOAD(rgA, 0); GC_STORE(rgA, 0); GC_LOAD(rgA, 1); GC_LOAD(rgB, 2);
#pragma unroll 1
        for (int n = 0; n < 64; n += 2) {
            __syncthreads();
            GC_STORE(rgA, 1); GC_LOAD(rgA, (n + 3 < 64) ? n + 3 : 63); __builtin_amdgcn_sched_barrier(0);
            __syncthreads();
            GC_STORE(rgB, 0); GC_LOAD(rgB, (n + 4 < 64) ? n + 4 : 63); __builtin_amdgcn_sched_barrier(0);
        }
#undef GC_LOAD
#undef GC_STORE
    } else {
        const bf16* gU = (const bf16*)(ws + WS_GDU) + (size_t)bh * 64 * 8192 + (size_t)((unsigned)(2 * w * 4 * 64 + lane) * 4u);
        const float glv = ((const float*)(ws + WS_GDEC + 768 * 1024))[bh * 64 + lane];
        unsigned char* ybase_u = ws + WS_MIX + ((size_t)b * SQ * DM + 1536 + h * 128 + 32 * w) * 2; const unsigned yoff = (unsigned)(4 * fq * DM + fr) * 2u;
#define YST(row, ct, val) (*(bf16*)(ybase_u + (size_t)(row) * (DM * 2) + (size_t)(yoff + 32u * (ct))) = (val))
        f32x4 S[2][8];
#pragma unroll
        for (int ct = 0; ct < 2; ++ct)
#pragma unroll
            for (int t = 0; t < 8; ++t) S[ct][t] = (f32x4){0.f, 0.f, 0.f, 0.f};
        u32x2 unA[2][4], unB[2][4]; unsigned yprev[2][8];
#pragma unroll
        for (int ct = 0; ct < 2; ++ct)
#pragma unroll
            for (int i = 0; i < 8; ++i) yprev[ct][i] = 0u;
#define GC_LOADU(un, n) do { _Pragma("unroll") for (int ct = 0; ct < 2; ++ct) _Pragma("unroll") for (int t = 0; t < 4; ++t) un[ct][t] = *(const u32x2*)(gU + (size_t)(n) * 8192 + ct * 1024 + t * 256); } while (0)
#define GC_STEP(n, BUF, UN) do { \
            __syncthreads(); \
            f32x4 vn[2][4], o[2][4]; \
            _Pragma("unroll") for (int ct = 0; ct < 2; ++ct) _Pragma("unroll") for (int t = 0; t < 4; ++t) { vn[ct][t] = (f32x4){bflo(UN[ct][t].x), bfhi(UN[ct][t].x), bflo(UN[ct][t].y), bfhi(UN[ct][t].y)}; o[ct][t] = (f32x4){0.f, 0.f, 0.f, 0.f}; } \
            { const int n2_ = ((n) + 2 < 64) ? (n) + 2 : 63; GC_LOADU(UN, n2_); } \
            __builtin_amdgcn_sched_barrier(0); \
            { const int np_ = ((n) > 0) ? (n) - 1 : 0; _Pragma("unroll") for (int ct = 0; ct < 2; ++ct) _Pragma("unroll") for (int t = 0; t < 4; ++t) _Pragma("unroll") for (int r = 0; r < 4; ++r) \
                YST(np_ * 64 + 16 * t + r, ct, (bf16)((r & 1) ? (yprev[ct][2 * t + (r >> 1)] >> 16) : (yprev[ct][2 * t + (r >> 1)] & 0xffffu))); } \
            const LAS unsigned char* B_ = lds + (BUF) * GC_BUF; \
            _Pragma("unroll") for (int s = 0; s < 4; ++s) { bf16x8 sbs[2]; \
              _Pragma("unroll") for (int ct = 0; ct < 2; ++ct) sbs[ct] = __builtin_bit_cast(bf16x8, (u32x4){pk2(S[ct][2 * s][0], S[ct][2 * s][1]), pk2(S[ct][2 * s][2], S[ct][2 * s][3]), pk2(S[ct][2 * s + 1][0], S[ct][2 * s + 1][1]), pk2(S[ct][2 * s + 1][2], S[ct][2 * s + 1][3])}); \
              _Pragma("unroll") for (int t = 0; t < 4; ++t) { \
                const LAS unsigned char* pw = B_ + GC_W + (16 * t + fr) * 272 + (32 * s + 4 * fq) * 2; const LAS unsigned char* pq = B_ + GC_Q + (16 * t + fr) * 272 + (32 * s + 4 * fq) * 2; \
                const bf16x8 aw = mk8(*(const LAS u32x2*)pw, *(const LAS u32x2*)(pw + 32)); const bf16x8 aq = mk8(*(const LAS u32x2*)pq, *(const LAS u32x2*)(pq + 32)); \
                _Pragma("unroll") for (int ct = 0; ct < 2; ++ct) { vn[ct][t] = MFMA16(aw, sbs[ct], vn[ct][t]); o[ct][t] = MFMA16(aq, sbs[ct], o[ct][t]); } \
                if (t == 3) __builtin_amdgcn_sched_barrier(0); } } \
            bf16x8 vb[2][2]; \
            _Pragma("unroll") for (int ct = 0; ct < 2; ++ct) _Pragma("unroll") for (int s = 0; s < 2; ++s) vb[ct][s] = __builtin_bit_cast(bf16x8, (u32x4){pk2(vn[ct][2 * s][0], vn[ct][2 * s][1]), pk2(vn[ct][2 * s][2], vn[ct][2 * s][3]), pk2(vn[ct][2 * s + 1][0], vn[ct][2 * s + 1][1]), pk2(vn[ct][2 * s + 1][2], vn[ct][2 * s + 1][3])}); \
            _Pragma("unroll") for (int s = 0; s < 2; ++s) _Pragma("unroll") for (int t = 0; t < 4; ++t) { \
                const LAS unsigned char* pa = B_ + GC_A + (16 * t + fr) * 144 + (32 * s + 4 * fq) * 2; const bf16x8 aa = mk8(*(const LAS u32x2*)pa, *(const LAS u32x2*)(pa + 32)); \
                _Pragma("unroll") for (int ct = 0; ct < 2; ++ct) o[ct][t] = MFMA16(aa, vb[ct][s], o[ct][t]); if (t == 3) __builtin_amdgcn_sched_barrier(0); } \
            const float gl = __builtin_bit_cast(float, __builtin_amdgcn_readlane(__builtin_bit_cast(int, glv), (n))); \
            _Pragma("unroll") for (int ct = 0; ct < 2; ++ct) _Pragma("unroll") for (int t = 0; t < 8; ++t) S[ct][t] = S[ct][t] * gl; \
            _Pragma("unroll") for (int s = 0; s < 2; ++s) _Pragma("unroll") for (int t = 0; t < 8; ++t) { \
                const LAS unsigned char* pk = B_ + GC_KE + (16 * t + fr) * 144 + (32 * s + 4 * fq) * 2; const bf16x8 ak = mk8(*(const LAS u32x2*)pk, *(const LAS u32x2*)(pk + 32)); \
                _Pragma("unroll") for (int ct = 0; ct < 2; ++ct) S[ct][t] = MFMA16(ak, vb[ct][s], S[ct][t]); if ((t & 3) == 3) __builtin_amdgcn_sched_barrier(0); } \
            _Pragma("unroll") for (int ct = 0; ct < 2; ++ct) _Pragma("unroll") for (int t = 0; t < 4; ++t) { yprev[ct][2 * t] = pk2(o[ct][t][0], o[ct][t][1]); yprev[ct][2 * t + 1] = pk2(o[ct][t][2], o[ct][t][3]); } \
        } while (0)
        GC_LOADU(unA, 0); GC_LOADU(unB, 1);
#pragma unroll 1
        for (int n = 0; n < 64; n += 2) { GC_STEP(n, 0, unA); GC_STEP(n + 1, 1, unB); }
#pragma unroll
        for (int ct = 0; ct < 2; ++ct)
#pragma unroll
            for (int t = 0; t < 4; ++t)
#pragma unroll
                for (int r = 0; r < 4; ++r) YST(63 * 64 + 16 * t + r, ct, (bf16)((r & 1) ? (yprev[ct][2 * t + (r >> 1)] >> 16) : (yprev[ct][2 * t + (r >> 1)] & 0xffffu)));
#undef YST
#undef GC_LOADU
#undef GC_STEP
    }
}

__device__ __forceinline__ void router_rows(const Params& p, int l, LAS unsigned char* lds, bf16* x2, int bid, int G, const int tid, const bf16* LNV = nullptr, const float* lng = nullptr, const float* lnb = nullptr) { GAS unsigned char* wsg_ = (GAS unsigned char*)p.ws; int zz = 0; asm volatile("" : "+s"(wsg_), "+s"(zz)); unsigned char* ws = (unsigned char*)wsg_; asm volatile("" : "+v"(lds));
    const int wave = __builtin_amdgcn_readfirstlane(tid >> 6), lane = tid & 63, fr = lane & 15, fq = lane >> 4;
    const float* wr = (const float*)(ws + WS_MISC) + (size_t)l * 48 * 2048;
    int* tok_e = (int*)(ws + WS_ROUTE); float* tok_g = (float*)(ws + WS_ROUTE + 256 * 1024); int* ccnt = (int*)(ws + WS_MISC + 900 * 1024);
    const float* bg = (const float*)p.in[zz + 34] + l * 4; const float* be = (const float*)p.in[zz + 36] + l * 32;
    LAS float* scr = (LAS float*)(lds + wave * 13312);
    LAS float* sum = (LAS float*)(lds + 8 * 13312);
    LAS int* lcnt = (LAS int*)(lds + 8 * 13312 + 10240);
    for (int ch = bid; ch < TT / 64; ch += G) {
        if (tid < 32) lcnt[tid] = 0;
        const int tok0 = ch * 64;
        if (LNV) { const int r0 = tok0 + wave * 8; ln_rows<4>(LNV, nullptr, nullptr, false, lng, lnb, x2, nullptr, r0, 1, lane, r0 + 8); asm volatile("s_waitcnt vmcnt(0)" ::: "memory"); __syncthreads(); }
        f32x4 acc[4][3];
#pragma unroll
        for (int rt = 0; rt < 4; ++rt)
#pragma unroll
            for (int nt = 0; nt < 3; ++nt) acc[rt][nt] = (f32x4){0.f, 0.f, 0.f, 0.f};
        const bf16* xa = x2 + (size_t)(tok0 + fr) * DM + wave * 256 + 4 * fq; const float* wb = wr + (size_t)fr * 2048 + wave * 256 + 4 * fq;
        f32x4 a[4][4], b[4][3];
#define RT_LOAD(buf, i) do { _Pragma("unroll") for (int rt = 0; rt < 4; ++rt) { const u32x2 xw_ = *(const u32x2*)(xa + (size_t)rt * 16 * DM + 16 * (i)); a[buf][rt] = (f32x4){bflo(xw_.x), bfhi(xw_.x), bflo(xw_.y), bfhi(xw_.y)}; } \
            _Pragma("unroll") for (int nt = 0; nt < 3; ++nt) b[buf][nt] = *(const f32x4*)(wb + (size_t)nt * 16 * 2048 + 16 * (i)); } while (0)
#define RT_MMA(buf) do { _Pragma("unroll") for (int j = 0; j < 4; ++j) _Pragma("unroll") for (int rt = 0; rt < 4; ++rt) _Pragma("unroll") for (int nt = 0; nt < 3; ++nt) \
            acc[rt][nt] = __builtin_amdgcn_mfma_f32_16x16x4f32(a[buf][rt][j], b[buf][nt][j], acc[rt][nt], 0, 0, 0); } while (0)
#define RT_SB __builtin_amdgcn_sched_barrier(0)
#define RT_CL(x) (((x) < 15) ? (x) : 15)
        RT_LOAD(0, 0); RT_SB; RT_LOAD(1, 1); RT_SB; RT_LOAD(2, 2); RT_SB;
#pragma unroll 1
        for (int i0 = 0; i0 < 16; i0 += 4) {
            RT_LOAD(3, RT_CL(i0 + 3)); RT_SB; RT_MMA(0); RT_SB;
            RT_LOAD(0, RT_CL(i0 + 4)); RT_SB; RT_MMA(1); RT_SB;
            RT_LOAD(1, RT_CL(i0 + 5)); RT_SB; RT_MMA(2); RT_SB;
            RT_LOAD(2, RT_CL(i0 + 6)); RT_SB; RT_MMA(3); RT_SB; }
#undef RT_SB
#undef RT_CL
#undef RT_LOAD
#undef RT_MMA
#pragma unroll
        for (int rt = 0; rt < 4; ++rt)
#pragma unroll
            for (int nt = 0; nt < 3; ++nt)
#pragma unroll
                for (int r = 0; r < 4; ++r) scr[(16 * rt + 4 * fq + r) * 52 + 16 * nt + fr] = acc[rt][nt][r];
        __syncthreads();
        { const int t = tid & 63, g = tid >> 6;
#pragma unroll
          for (int jj = 0; jj < 5; ++jj) { const int j = 5 * g + jj; float s = 0.f;
#pragma unroll
              for (int w8 = 0; w8 < 8; ++w8) s += ((const LAS float*)(lds + w8 * 13312))[t * 52 + j];
              sum[t * 40 + j] = s; } }
        __syncthreads();
        if (tid < 64) { const LAS float* lg = sum + tid * 40; const int t = tok0 + tid;
            float gbest = lg[0] + bg[0]; int gi = 0; float gl[4]; gl[0] = gbest;
#pragma unroll
            for (int j = 1; j < 4; ++j) { gl[j] = lg[j] + bg[j]; if (gl[j] > gbest) { gbest = gl[j]; gi = j; } }
            float gs = 0.f;
#pragma unroll
            for (int j = 0; j < 4; ++j) gs += expf(gl[j] - gbest);
            const float pg = 1.0f / gs;
            float e1 = -INFINITY, e2 = -INFINITY; int i1 = 0, i2 = 0;
#pragma unroll
            for (int j = 0; j < 8; ++j) { const float v = lg[4 + gi * 8 + j] + be[gi * 8 + j]; if (v > e1) { e2 = e1; i2 = i1; e1 = v; i1 = j; } else if (v > e2) { e2 = v; i2 = j; } }
            const float w2 = expf(e2 - e1), den = 1.0f + w2;
            const int ea = gi * 8 + i1, eb = gi * 8 + i2;
            tok_e[2 * t] = ea; tok_e[2 * t + 1] = eb; tok_g[2 * t] = pg / den; tok_g[2 * t + 1] = pg * w2 / den;
            __hip_atomic_fetch_add(lcnt + ea, 1, __ATOMIC_RELAXED, __HIP_MEMORY_SCOPE_WORKGROUP); __hip_atomic_fetch_add(lcnt + eb, 1, __ATOMIC_RELAXED, __HIP_MEMORY_SCOPE_WORKGROUP); }
        __syncthreads();
        if (tid < 32) ccnt[ch * 32 + tid] = lcnt[tid];
    }
}

using pg8::Unit;
struct ProbG {
    const char* A; const char* Bt; unsigned a_rs, b_rs; size_t a_zs, b_zs; int nt;
    size_t a_kstep, b_kstep, a_hstep, b_hstep;
    __device__ __forceinline__ ProbG(const void* A_, unsigned a_rs_, size_t a_zs_, const void* B_, unsigned b_rs_, size_t b_zs_, int K)
        : A((const char*)A_), Bt((const char*)B_), a_rs(a_rs_), b_rs(b_rs_), a_zs(a_zs_), b_zs(b_zs_), nt(K / 64), a_kstep(128), b_kstep(128), a_hstep((size_t)128 * a_rs_), b_hstep((size_t)128 * b_rs_) {}
    __device__ __forceinline__ const char* a_base(const Unit& u) const { return A + (size_t)u.z * a_zs + (size_t)u.pm * 256 * a_rs; }
    __device__ __forceinline__ const char* b_base(const Unit& u) const { return Bt + (size_t)u.z * b_zs + (size_t)u.pn * 256 * b_rs; }
    __device__ __forceinline__ unsigned a_voff(int R, int C) const { return (unsigned)R * a_rs + (unsigned)C * 2u; }
    __device__ __forceinline__ unsigned b_voff(int R, int C) const { return (unsigned)R * b_rs + (unsigned)C * 2u; }
};
struct ProbS5 {
    const char* A; const char* Bt; unsigned b_rs; size_t b_zs; int nt; size_t a_kstep, b_kstep, a_hstep, b_hstep;
    __device__ __forceinline__ ProbS5(const void* proj, const void* B_, int nrowsB) : A((const char*)proj), Bt((const char*)B_), b_rs(1024), b_zs((size_t)nrowsB * 1024), nt(8),
        a_kstep((size_t)4 * NIN * 2), b_kstep(128), a_hstep((size_t)128 * 32 * NIN * 2), b_hstep((size_t)128 * 1024) {}
    __device__ __forceinline__ const char* a_base(const Unit& u) const { return A + ((size_t)u.pm * 256 * 32 * NIN + (size_t)u.z * 16) * 2; }
    __device__ __forceinline__ const char* b_base(const Unit& u) const { return Bt + (size_t)u.z * b_zs + (size_t)u.pn * 256 * b_rs; }
    __device__ __forceinline__ unsigned a_voff(int R, int C) const { return ((unsigned)(R * 32 + (C >> 4)) * NIN + (unsigned)(C & 15)) * 2u; }
    __device__ __forceinline__ unsigned b_voff(int R, int C) const { return (unsigned)R * b_rs + (unsigned)C * 2u; }
};
struct StaticOrder {
    int nM, nN, nwg, G, c;
    __device__ __forceinline__ StaticOrder(int M, int N, int G_, int c_) : nM(M / 256), nN(N / 256), nwg((M / 256) * (N / 256)), G(G_), c(c_) {}
    __device__ __forceinline__ bool next(int i, Unit& u) const {
        const long L = (long)i * G + c; if (L >= nwg) return false;
        int wgid = (int)L; { const int q = nwg / 8, r = nwg % 8, xcd = wgid % 8, off = wgid / 8; wgid = (xcd < r ? xcd * (q + 1) : r * (q + 1) + (xcd - r) * q) + off; }
        const int nig = 8 * nN, gid = wgid / nig, fm = gid * 8, gsz = (nM - fm) < 8 ? (nM - fm) : 8;
        u.pm = fm + ((wgid % nig) % gsz); u.pn = (wgid % nig) / gsz; u.z = 0; return true;
    }
};
struct BatchOrder {
    int nM, nN, total, G, c;
    __device__ __forceinline__ BatchOrder(int nz, int nM_, int nN_, int G_, int c_) : nM(nM_), nN(nN_), total(nz * nM_ * nN_), G(G_), c(c_) {}
    __device__ __forceinline__ bool next(int i, Unit& u) const { const int L = i * G + c; if (c < 0 || L >= total) return false; u.pn = L % nN; const int r = L / nN; u.pm = r % nM; u.z = r / nM; return true; }
};
constexpr int MOE_TAB_OFF = RING_BYTES + 1024;
struct MoeOrder {
    const volatile LAS int* tab; int nN, G, c;
    __device__ __forceinline__ bool next(int i, Unit& u) const { const int L = i * G + c; const int np = tab[0]; if (L >= np * nN) return false; const int pi = L / nN; u.pn = L - pi * nN; const int e = tab[1 + pi]; u.z = e & 255; u.pm = e >> 8; return true; }
};
__device__ __forceinline__ void moe_build_table(const Params& p, int l, LAS unsigned char* lds, const int tid) { GAS unsigned char* wsg_ = (GAS unsigned char*)p.ws; int zz = 0; asm volatile("" : "+s"(wsg_), "+s"(zz)); unsigned char* ws = (unsigned char*)wsg_;
    volatile LAS int* tab = (volatile LAS int*)(lds + MOE_TAB_OFF);
    __syncthreads();
    if (tid == 0) { const unsigned* ecnt = (const unsigned*)(ws + WS_CTL) + CW_ECNT + l * 32; int np = 0, row = 0;
        for (int e = 0; e < 32; ++e) { const int cnt = (int)__hip_atomic_load(ecnt + e, RLX_AGENT); tab[192 + e] = row; tab[224 + e] = cnt; const int k = (cnt + 255) >> 8;
            for (int j = 0; j < k; ++j) { if (np < 160) tab[1 + np] = e | (((row >> 8) + j) << 8); ++np; } row += k * 256; }
        tab[0] = np < 160 ? np : 160; }
    __syncthreads();
}

__device__ __forceinline__ void moe_build_table_chunks(const Params& p, int l, LAS unsigned char* lds, const int tid, const int bid) { GAS unsigned char* wsg_ = (GAS unsigned char*)p.ws; int zz = 0; asm volatile("" : "+s"(wsg_), "+s"(zz)); unsigned char* ws = (unsigned char*)wsg_;
    volatile LAS int* tab = (volatile LAS int*)(lds + MOE_TAB_OFF); const int* ccnt = (const int*)(ws + WS_MISC + 900 * 1024);
    __syncthreads();
    { const int e = tid & 31, part = tid >> 5; int cv[16]; int s = 0; LAS int* px = (LAS int*)(lds + RING_OFF + 4096);
#pragma unroll
      for (int c = 0; c < 16; ++c) cv[c] = ccnt[(part * 16 + c) * 32 + e];
#pragma unroll
      for (int c = 0; c < 16; ++c) { px[(part * 16 + c) * 32 + e] = s; s += cv[c]; }
      tab[256 + part * 32 + e] = s; }
    __syncthreads();
    if (tid < 32) { int s = 0;
#pragma unroll
        for (int part = 0; part < 16; ++part) s += tab[256 + part * 32 + tid];
        tab[224 + tid] = s; if (bid == 0) __hip_atomic_store((unsigned*)(ws + WS_CTL) + CW_ECNT + l * 32 + tid, (unsigned)s, RLX_AGENT); }
    __syncthreads();
    if (tid == 0) { int np = 0, row = 0;
        for (int e = 0; e < 32; ++e) { const int cnt = tab[224 + e]; tab[192 + e] = row; const int k = (cnt + 255) >> 8;
            for (int j = 0; j < k; ++j) { if (np < 160) tab[1 + np] = e | (((row >> 8) + j) << 8); ++np; } row += k * 256; }
        tab[0] = np < 160 ? np : 160; }
    __syncthreads();
}

#define EPI_ROWS const int row0 = u.pm * 256 + wr * 64 + fr
typedef f32x4 AccT[2][2][4][2];
struct EpiBf16 { static constexpr bool PERM = true; bf16* O; int ldc;
    __device__ __forceinline__ void operator()(const AccT& acc, const Unit& u, int wr, int wc, int fr, int fq) const { EPI_ROWS; const int col0 = u.pn * 256 + wc * 32 + 8 * fq;
#pragma unroll
        for (int ai = 0; ai < 2; ++ai)
#pragma unroll
            for (int m = 0; m < 4; ++m) { bf16* rp = O + (size_t)(row0 + ai * 128 + m * 16) * ldc + col0;
#pragma unroll
                for (int bj = 0; bj < 2; ++bj) { const f32x4 v0 = acc[ai][bj][m][0], v1 = acc[ai][bj][m][1]; *(u32x4*)(rp + bj * 128) = (u32x4){pk2(v0[0], v0[1]), pk2(v0[2], v0[3]), pk2(v1[0], v1[1]), pk2(v1[2], v1[3])}; } } } };
struct EpiMlaQ { static constexpr bool PERM = true; bf16* Q; const float* rt; float sc;
    __device__ __forceinline__ void operator()(const AccT& acc, const Unit& u, int wr, int wc, int fr, int fq) const { EPI_ROWS;
#pragma unroll
        for (int ai = 0; ai < 2; ++ai)
#pragma unroll
            for (int m = 0; m < 4; ++m) { const int row = row0 + ai * 128 + m * 16, b = row >> 12, s = row & 4095;
                if (u.pn < 4) {
#pragma unroll
                    for (int bj = 0; bj < 2; ++bj) { const int h = 2 * u.pn + bj; const f32x4 v0 = acc[ai][bj][m][0] * sc, v1 = acc[ai][bj][m][1] * sc;
                        *(u32x4*)(Q + ((size_t)(b * 8 + h) * SQ + s) * 192 + wc * 32 + 8 * fq) = (u32x4){pk2(v0[0], v0[1]), pk2(v0[2], v0[3]), pk2(v1[0], v1[1]), pk2(v1[2], v1[3])}; }
                } else { const int h = 4 * (u.pn - 4) + wc; const f32x4* cs = (const f32x4*)(rt + ((size_t)row * 32 + 8 * fq) * 2); float o1[8], o2[8];
#pragma unroll
                    for (int n = 0; n < 2; ++n) { const f32x4 c01 = cs[2 * n], c23 = cs[2 * n + 1]; const f32x4 x1 = acc[ai][0][m][n], x2 = acc[ai][1][m][n];
                        const float cc[4] = {c01[0], c01[2], c23[0], c23[2]}, ss[4] = {c01[1], c01[3], c23[1], c23[3]};
#pragma unroll
                        for (int r = 0; r < 4; ++r) { o1[4 * n + r] = (x1[r] * cc[r] - x2[r] * ss[r]) * sc; o2[4 * n + r] = (x2[r] * cc[r] + x1[r] * ss[r]) * sc; } }
                    bf16* qp = Q + ((size_t)(b * 8 + h) * SQ + s) * 192 + 128 + 8 * fq; *(u32x4*)qp = pack8(o1); *(u32x4*)(qp + 32) = pack8(o2); } } } };
struct EpiMlaKV { static constexpr bool PERM = true; bf16* K; bf16* VT;
    __device__ __forceinline__ void operator()(const AccT& acc, const Unit& u, int wr, int wc, int fr, int fq) const { EPI_ROWS; const int h = u.pn;
#pragma unroll
        for (int ai = 0; ai < 2; ++ai)
#pragma unroll
            for (int m = 0; m < 4; ++m) { const int row = row0 + ai * 128 + m * 16, b = row >> 12, s = row & 4095;
                { const f32x4 v0 = acc[ai][0][m][0], v1 = acc[ai][0][m][1]; *(u32x4*)(K + ((size_t)(b * 8 + h) * SQ + s) * 192 + wc * 32 + 8 * fq) = (u32x4){pk2(v0[0], v0[1]), pk2(v0[2], v0[3]), pk2(v1[0], v1[1]), pk2(v1[2], v1[3])}; }
#pragma unroll
                for (int n = 0; n < 2; ++n)
#pragma unroll
                    for (int r = 0; r < 4; ++r) VT[((size_t)(b * 8 + h) * 128 + wc * 32 + 8 * fq + 4 * n + r) * SQ + ((s & ~15) | (s & 3) | ((s & 4) << 1) | ((s & 8) >> 1))] = (bf16)f2bf(acc[ai][1][m][n][r]); } } };
struct EpiXloc { static constexpr bool PERM = false; float* X;
    __device__ __forceinline__ void operator()(const AccT& acc, const Unit& u, int wr, int wc, int fr, int fq) const { EPI_ROWS;
#pragma unroll
        for (int ai = 0; ai < 2; ++ai)
#pragma unroll
            for (int m = 0; m < 4; ++m) { float* rp = X + ((size_t)u.z * 512 + row0 + ai * 128 + m * 16) * 128 + wc * 32 + 4 * fq;
#pragma unroll
                for (int n = 0; n < 2; ++n) *(f32x4*)(rp + 16 * n) = acc[ai][0][m][n]; } } };
struct EpiYtoep { static constexpr bool PERM = false; float* Y;
    __device__ __forceinline__ void operator()(const AccT& acc, const Unit& u, int wr, int wc, int fr, int fq) const { EPI_ROWS;
#pragma unroll
        for (int ai = 0; ai < 2; ++ai)
#pragma unroll
            for (int m = 0; m < 4; ++m) { const int cr = row0 + ai * 128 + m * 16;
#pragma unroll
                for (int bj = 0; bj < 2; ++bj)
#pragma unroll
                    for (int n = 0; n < 2; ++n) { const int t = 16 * u.pn + 8 * bj + 2 * wc + n; *(f32x4*)(Y + ((size_t)cr * 32 + t) * 512 + u.z * 16 + 4 * fq) = acc[ai][bj][m][n]; } } } };
struct EpiYfin { static constexpr bool PERM = false; const float* Y; bf16* YB;
    __device__ __forceinline__ void operator()(const AccT& acc, const Unit& u, int wr, int wc, int fr, int fq) const { EPI_ROWS;
#pragma unroll
        for (int ai = 0; ai < 2; ++ai)
#pragma unroll
            for (int m = 0; m < 4; ++m) { const int cr = row0 + ai * 128 + m * 16;
#pragma unroll
                for (int bj = 0; bj < 2; ++bj)
#pragma unroll
                    for (int n = 0; n < 2; ++n) { const int t = 16 * u.pn + 8 * bj + 2 * wc + n; const size_t o = ((size_t)cr * 32 + t) * 512 + u.z * 16 + 4 * fq; const f32x4 v = acc[ai][bj][m][n] + *(const f32x4*)(Y + o);
                        *(u32x2*)(YB + o) = (u32x2){pk2(gelu_tanh(v[0]), gelu_tanh(v[1])), pk2(gelu_tanh(v[2]), gelu_tanh(v[3]))}; } } } };
struct EpiGlu { static constexpr bool PERM = true; const bf16* YB; bf16* ZB; const float* bias;
    __device__ __forceinline__ void operator()(const AccT& acc, const Unit& u, int wr, int wc, int fr, int fq) const { EPI_ROWS; const int col0 = u.pn * 256 + wc * 32 + 8 * fq;
#pragma unroll
        for (int ai = 0; ai < 2; ++ai)
#pragma unroll
            for (int m = 0; m < 4; ++m) { const size_t ro = (size_t)(row0 + ai * 128 + m * 16) * 512;
#pragma unroll
                for (int bj = 0; bj < 2; ++bj) { const int col = col0 + bj * 128; float y[8]; unpack8(*(const u32x4*)(YB + ro + col), y); const f32x4 b0 = *(const f32x4*)(bias + col), b1 = *(const f32x4*)(bias + col + 4);
                    const f32x4 v0 = acc[ai][bj][m][0] + b0, v1 = acc[ai][bj][m][1] + b1;
#pragma unroll
                    for (int r = 0; r < 4; ++r) { y[r] *= sigmoidf_(v0[r]); y[4 + r] *= sigmoidf_(v1[r]); }
                    *(u32x4*)(ZB + ro + col) = pack8(y); } } } };
struct EpiResid { static constexpr bool PERM = true; const bf16* X; bf16* V;
    __device__ __forceinline__ void operator()(const AccT& acc, const Unit& u, int wr, int wc, int fr, int fq) const { EPI_ROWS; const int col0 = u.pn * 256 + wc * 32 + 8 * fq;
#pragma unroll
        for (int ai = 0; ai < 2; ++ai) { u32x4 xr[4][2];
#pragma unroll
            for (int m = 0; m < 4; ++m)
#pragma unroll
                for (int bj = 0; bj < 2; ++bj) xr[m][bj] = *(const u32x4*)(X + (size_t)(row0 + ai * 128 + m * 16) * DM + col0 + bj * 128);
#pragma unroll
            for (int m = 0; m < 4; ++m) { const size_t ro = (size_t)(row0 + ai * 128 + m * 16) * DM + col0;
#pragma unroll
                for (int bj = 0; bj < 2; ++bj) { float x[8]; unpack8(xr[m][bj], x); const f32x4 v0 = acc[ai][bj][m][0], v1 = acc[ai][bj][m][1];
#pragma unroll
                    for (int r = 0; r < 4; ++r) { x[r] = x[r] * DN_ALPHA + v0[r]; x[4 + r] = x[4 + r] * DN_ALPHA + v1[r]; }
                    *(u32x4*)(V + ro + bj * 128) = pack8(x); } } } } };
struct EpiXaKV { static constexpr bool PERM = true; bf16* K; bf16* VT;
    __device__ __forceinline__ void operator()(const AccT& acc, const Unit& u, int wr, int wc, int fr, int fq) const { EPI_ROWS;
#pragma unroll
        for (int ai = 0; ai < 2; ++ai)
#pragma unroll
            for (int m = 0; m < 4; ++m) { const int row = row0 + ai * 128 + m * 16, b = row >> 8, mm = row & 255;
#pragma unroll
                for (int bj = 0; bj < 2; ++bj) { const int h = 2 * (u.pn & 1) + bj;
                    if (u.pn < 2) { const f32x4 v0 = acc[ai][bj][m][0], v1 = acc[ai][bj][m][1]; *(u32x4*)(K + ((size_t)(b * 4 + h) * 256 + mm) * 128 + wc * 32 + 8 * fq) = (u32x4){pk2(v0[0], v0[1]), pk2(v0[2], v0[3]), pk2(v1[0], v1[1]), pk2(v1[2], v1[3])}; }
                    else {
#pragma unroll
                        for (int n = 0; n < 2; ++n)
#pragma unroll
                            for (int r = 0; r < 4; ++r) VT[((size_t)(b * 4 + h) * 128 + wc * 32 + 8 * fq + 4 * n + r) * 256 + ((mm & ~15) | (mm & 3) | ((mm & 4) << 1) | ((mm & 8) >> 1))] = (bf16)f2bf(acc[ai][bj][m][n][r]); } } } } };
struct EpiXaQ { static constexpr bool PERM = true; bf16* Q; float sc;
    __device__ __forceinline__ void operator()(const AccT& acc, const Unit& u, int wr, int wc, int fr, int fq) const { EPI_ROWS;
#pragma unroll
        for (int ai = 0; ai < 2; ++ai)
#pragma unroll
            for (int m = 0; m < 4; ++m) { const int row = row0 + ai * 128 + m * 16, b = row >> 12, s = row & 4095;
#pragma unroll
                for (int bj = 0; bj < 2; ++bj) { const int h = 2 * u.pn + bj; const f32x4 v0 = acc[ai][bj][m][0] * sc, v1 = acc[ai][bj][m][1] * sc;
                    *(u32x4*)(Q + (size_t)u.z * ((size_t)32 * MiB / 2) + ((size_t)(b * 4 + h) * SQ + s) * 128 + wc * 32 + 8 * fq) = (u32x4){pk2(v0[0], v0[1]), pk2(v0[2], v0[3]), pk2(v1[0], v1[1]), pk2(v1[2], v1[3])}; } } } };
struct EpiMoeGU { static constexpr bool PERM = true; bf16* H;
    __device__ __forceinline__ void operator()(const AccT& acc, const Unit& u, int wr, int wc, int fr, int fq) const { EPI_ROWS;
#pragma unroll
        for (int ai = 0; ai < 2; ++ai)
#pragma unroll
            for (int m = 0; m < 4; ++m) { float o[8];
#pragma unroll
                for (int n = 0; n < 2; ++n)
#pragma unroll
                    for (int r = 0; r < 4; ++r) o[4 * n + r] = siluf_(acc[ai][0][m][n][r]) * acc[ai][1][m][n][r];
                *(u32x4*)(H + (size_t)(row0 + ai * 128 + m * 16) * 512 + u.pn * 128 + wc * 32 + 8 * fq) = pack8(o); } } };
struct EpiMoeDown { static constexpr bool PERM = true; bf16* Y; const int* row_tok; const float* row_gate;
    __device__ __forceinline__ void operator()(const AccT& acc, const Unit& u, int wr, int wc, int fr, int fq) const { EPI_ROWS; const int col0 = u.pn * 256 + wc * 32 + 8 * fq;
        int ts[8]; float gg[8];
#pragma unroll
        for (int i = 0; i < 8; ++i) { const int row = row0 + (i >> 2) * 128 + (i & 3) * 16; ts[i] = row_tok[row]; gg[i] = row_gate[row]; }
#pragma unroll
        for (int ai = 0; ai < 2; ++ai)
#pragma unroll
            for (int m = 0; m < 4; ++m) { const int tsi = ts[ai * 4 + m]; if (tsi < 0) continue; const float g = gg[ai * 4 + m];
                bf16* yp = Y + ((size_t)(tsi & 1) * TT + (tsi >> 1)) * DM + col0;
#pragma unroll
                for (int bj = 0; bj < 2; ++bj) { const f32x4 v0 = acc[ai][bj][m][0] * g, v1 = acc[ai][bj][m][1] * g; *(u32x4*)(yp + bj * 128) = (u32x4){pk2(v0[0], v0[1]), pk2(v0[2], v0[3]), pk2(v1[0], v1[1]), pk2(v1[2], v1[3])}; } } } };

#ifndef EN_S5
#define EN_S5 1
#endif
#ifndef EN_MLA
#define EN_MLA 1
#endif
#ifndef EN_GDN
#define EN_GDN 1
#endif
#ifndef EN_XA
#define EN_XA 1
#endif
#ifndef EN_MOE
#define EN_MOE 1
#endif
#ifndef EN_MIX
#define EN_MIX 1
#endif
#ifndef REP_MASK
#define REP_MASK 0
#endif
#define REPEAT(bit) for (int rep_ = 0; rep_ < ((((REP_MASK) >> (bit)) & 1) + 1); ++rep_)
constexpr int NPH = 17, NPHASES = 1 + NL * NPH;

__global__ void __launch_bounds__(NWAVES * 64, 2) hybrid_fwd(Params p) {
    extern __shared__ __attribute__((aligned(16))) unsigned char lds_raw[];
    LAS unsigned char* lds0 = (LAS unsigned char*)lds_raw;
    const int tid0 = threadIdx.x; const int wave0 = __builtin_amdgcn_readfirstlane(tid0 >> 6);
    const int G = gridDim.x, bid = blockIdx.x; const int NGW = G * NWAVES;
    unsigned* ctl0 = (unsigned*)(p.ws + WS_CTL);
    for (int u = tid0; u < (LDS_BYTES - LDSCTL_OFF) / 4; u += NWAVES * 64) ((LAS unsigned*)(lds0 + LDSCTL_OFF))[u] = 0u;
    __syncthreads();
    volatile LAS unsigned* MISC = (volatile LAS unsigned*)(lds0 + MISC_OFF);
    const bool use_bar = (p.ph_hi - p.ph_lo) > 1;
    XcdBarrier bar; bar.bar = ctl0 + CW_BAR; bar.x = 0; bar.st = MISC + 8;
    if (use_bar) bar = xcd_barrier_post(ctl0 + CW_BAR, MISC + 8);
    const int lo = p.ph_lo, hi = p.ph_hi;
#define IN(k) (lo <= (k) && (k) < hi)
#define PH_VARS int wv_ = wave0; unsigned m1_ = ~0u; asm volatile("" : "+s"(wv_), "+s"(m1_)); int tid = wv_ * 64 + (int)__builtin_amdgcn_mbcnt_hi(m1_, __builtin_amdgcn_mbcnt_lo(m1_, 0u)); LAS unsigned char* lds = lds0; asm volatile("" : "+v"(tid), "+v"(lds)); const int lane = tid & 63, wave = __builtin_amdgcn_readfirstlane(tid >> 6); const int gw = bid * NWAVES + wave; LAS float* wscr = (LAS float*)(lds + RING_OFF + wave * 16384); GAS unsigned char* wsg_ = (GAS unsigned char*)p.ws; int zz = 0; asm volatile("" : "+s"(wsg_), "+s"(zz)); unsigned char* ws = (unsigned char*)wsg_; unsigned* ctl = (unsigned*)(ws + WS_CTL); bf16* V = (bf16*)(ws + WS_V); bf16* XB = (bf16*)(ws + WS_XB); bf16* PROJ = (bf16*)(ws + WS_PROJ); bf16* MIX = (bf16*)(ws + WS_MIX); \
    (void)lane; (void)gw; (void)wscr; (void)ctl; (void)V; (void)XB; (void)PROJ; (void)MIX
#ifndef PROBE
#define PROBE 0
#endif
#define TS_OFF (LDSCTL_OFF + 8192)
#define STAMP(i) do { if (PROBE && bid == 0 && wave0 == 0 && __builtin_amdgcn_mbcnt_lo(~0u, 0u) == 0u) { unsigned long long t_; asm volatile("s_memrealtime %0\n\ts_waitcnt lgkmcnt(0)" : "=s"(t_) :: "memory"); ((volatile LAS unsigned long long*)(lds0 + TS_OFF))[i] = t_; } } while (0)
#define SEAM(k) do { if (IN(k) && IN((k) + 1)) xcd_barrier(bar); STAMP((k) + 1); } while (0)

    STAMP(0);
    if (IN(0)) REPEAT(0) { const int l = 0; PH_VARS;
        p0_weights(p, 0, gw, NGW, lane);
        p0_tables(p, gw, NGW, lane);
        p0_s5(p, wscr, 0, gw, NGW, lane);
        cvt_rows((const float*)p.in[zz + 0], XB, TT, gw, NGW, lane);
        cvt_rows((const float*)p.in[zz + 1], (bf16*)(ws + WS_MEMB), NB * MEML, gw, NGW, lane);
    }
    SEAM(0);

    { constexpr int l = 0; constexpr int P0 = 1 + 0 * NPH;
        if (IN(P0 + 0)) REPEAT(1) { PH_VARS;
#if EN_MIX
            ProbG P(XB, DM * 2, 0, ws + WS_WIN_T + (size_t)l * NIN * 2048 * 2, DM * 2, 0, DM); StaticOrder S(TT, NIN, G, bid); EpiBf16 E{PROJ, NIN};
            pg8::gemm_phase(lds0 + RING_OFF, P, S, E, tid);
#endif
#if EN_XA
            { ProbG P(ws + WS_MEMB, DM * 2, 0, ws + WS_XKV_T + (size_t)l * 1024 * 2048 * 2, DM * 2, 0, DM); StaticOrder S(NB * MEML, 1024, G, (bid + 64) % G); EpiXaKV E{(bf16*)(ws + WS_XAK), (bf16*)(ws + WS_XAVT)};
              pg8::gemm_phase(lds0 + RING_OFF, P, S, E, tid); }
#endif
        }
        SEAM(P0 + 0);
        if (IN(P0 + 1)) REPEAT(2) { PH_VARS;
#if EN_MLA || EN_GDN
            ph2_token(p, l, gw, NGW, lane);
#endif
#if EN_GDN
            ph2_conv(p, l, gw, NGW, lane);
#endif
#if EN_S5
            { ProbS5 P(PROJ, ws + WS_MEND_T + (size_t)l * 32 * 256 * 512 * 2, 256); BatchOrder S(32, 2, 1, G, bid); EpiXloc E{(float*)(ws + WS_XLOC)}; pg8::gemm_phase(lds0 + RING_OFF, P, S, E, tid); }
            { ProbS5 P(PROJ, ws + WS_TOEP_T + (size_t)l * 32 * 512 * 512 * 2, 512); BatchOrder S(32, 2, 2, G, (bid + 192) % G); EpiYtoep E{(float*)(ws + WS_YTOEP)}; pg8::gemm_phase(lds0 + RING_OFF, P, S, E, tid); }
#endif
        }
        SEAM(P0 + 1);
        if (IN(P0 + 2)) REPEAT(3) { PH_VARS;
#if EN_S5
            if (bid >= G - 32) { const int q = (bid - (G - 32)) * 512 + tid;
                if (q < 8192) { const int b = q >> 11, g = (q >> 6) & 31, pp = q & 63; const float* al = (const float*)(ws + WS_MISC + 800 * 1024) + ((l * 32 + g) * 64 + pp) * 2; const float ar = al[0], ai = al[1];
                    const float* xl = (const float*)(ws + WS_XLOC) + ((size_t)g * 512 + b * 128) * 128; bf16* xs = (bf16*)(ws + WS_XSB) + ((size_t)g * 512 + b * 128) * 128; float sr = 0.f, si = 0.f;
#pragma unroll 1
                    for (int c0 = 0; c0 < 128; c0 += 16) { float lr_[16], li_[16];
#pragma unroll
                        for (int i = 0; i < 16; ++i) { lr_[i] = xl[(c0 + i) * 128 + pp]; li_[i] = xl[(c0 + i) * 128 + 64 + pp]; }
#pragma unroll
                        for (int i = 0; i < 16; ++i) { xs[(c0 + i) * 128 + pp] = (bf16)f2bf(sr); xs[(c0 + i) * 128 + 64 + pp] = (bf16)f2bf(si);
                            const float nr = ar * sr - ai * si + lr_[i], ni = ar * si + ai * sr + li_[i]; sr = nr; si = ni; } } } }
#endif
#if EN_MLA
            { ProbG P(ws + WS_CQN, 2048, 0, ws + WS_WUQ_T + (size_t)l * 1536 * 512 * 2, 1024, 0, 512); StaticOrder S(TT, 1536, G, bid); EpiMlaQ E{(bf16*)(ws + WS_QB), (const float*)(ws + WS_ROPE), 0.07216878364870323f * LOG2E};
              pg8::gemm_phase(lds0 + RING_OFF, P, S, E, tid); }
            { ProbG P(ws + WS_CQN + 1024, 2048, 0, ws + WS_WUKV_T + (size_t)l * 2048 * 512 * 2, 1024, 0, 512); StaticOrder S(TT, 2048, G, (bid + 128) % G); EpiMlaKV E{(bf16*)(ws + WS_KB), (bf16*)(ws + WS_VT)};
              pg8::gemm_phase(lds0 + RING_OFF, P, S, E, tid); }
#endif
#if EN_GDN
            { u32x4 pre[6];
              if (bid < 1024) { const bf16* gq_ = (const bf16*)(ws + WS_GQ); const bf16* gk_ = (const bf16*)(ws + WS_GK); const bf16* gv_ = (const bf16*)(ws + WS_GV); const int bh_ = bid >> 6, n_ = bid & 63; const int t_ = (bh_ >> 2) * SQ + n_ * 64, h_ = bh_ & 3;
#pragma unroll
                  for (int i = 0; i < 2; ++i) { const int idx = tid + 512 * i, c = idx >> 4, pc = idx & 15; const size_t go = (size_t)(t_ + c) * 512 + h_ * 128 + pc * 8;
                      pre[3 * i] = *(const u32x4*)(gk_ + go); pre[3 * i + 1] = *(const u32x4*)(gq_ + go); pre[3 * i + 2] = *(const u32x4*)(gv_ + go); } }
              for (int it = bid; it < 1024; it += G) gdn_pre_item(p, lds + RING_OFF, it, tid, pre, (it + G < 1024) ? it + G : -1); }
#endif
        }
        SEAM(P0 + 2);
        if (IN(P0 + 3)) REPEAT(7) { PH_VARS;
#if EN_GDN
            if (bid < 16) gdn_chain(p, lds + RING_OFF, bid, l, tid);
#else
            zero_mix_cols(p, 1536, 512, gw, NGW, lane);
#endif
#if EN_S5
            { ProbG P(ws + WS_XSB, 256, (size_t)512 * 256, ws + WS_MST_T + (size_t)l * 32 * 512 * 128 * 2, 256, (size_t)512 * 256, 128); BatchOrder S(32, 2, 2, G - 16, bid - 16); EpiYfin E{(const float*)(ws + WS_YTOEP), (bf16*)(ws + WS_YB)};
              pg8::gemm_phase(lds0 + RING_OFF, P, S, E, tid); }
#endif
#if EN_MOE
#define MOE_CVT_LOOP() do { unsigned* head2 = ctl + CW_QUEUE + (8 + l) * 64; volatile LAS int* qslot = (volatile LAS int*)(lds + MISC_OFF);     \
              for (;;) { __syncthreads(); if (tid == 0) qslot[0] = (int)__hip_atomic_fetch_add(head2, 1u, RLX_AGENT); __syncthreads(); const int q0_ = qslot[0] * NWAVES; if (q0_ >= MOE_CVT_ITEMS) break; \
                  if (q0_ + wave < MOE_CVT_ITEMS) moe_convert_item(p, l, q0_ + wave, lane); } } while (0)
#else
#define MOE_CVT_LOOP() do { } while (0)
#endif
            if (bid >= 16 && bid < 80) MOE_CVT_LOOP();
#if EN_MLA
            { unsigned* head = ctl + CW_QUEUE + (l * 2 + rep_) * 64; volatile LAS int* qslot = (volatile LAS int*)(lds + MISC_OFF);
              for (;;) { __syncthreads(); if (tid == 0) qslot[0] = (int)__hip_atomic_fetch_add(head, 1u, RLX_AGENT); __syncthreads(); const int q = qslot[0]; if (q >= 512) break;
                  const int qb = 15 - (q >> 5), bh = q & 31, b = bh >> 3, h = bh & 7;
                  attn_unit<192, true>(lds + RING_OFF, (const bf16*)(ws + WS_QB) + (size_t)bh * SQ * 192, (const bf16*)(ws + WS_KB) + (size_t)bh * SQ * 192, (const bf16*)(ws + WS_VT) + (size_t)bh * 128 * SQ, SQ, qb * 256, 4 * qb + 4,
                                       (bf16*)(ws + WS_OB) + (size_t)b * SQ * 1024 + h * 128, 1024, tid); } }
#endif
            MOE_CVT_LOOP();
#undef MOE_CVT_LOOP
        }
        SEAM(P0 + 3);
        if (IN(P0 + 4)) REPEAT(4) { PH_VARS;
#if EN_S5
            { ProbG P(ws + WS_YB, 1024, 0, ws + WS_GLU_T + (size_t)l * 512 * 512 * 2, 1024, 0, 512); StaticOrder S(TT, 512, G, bid); EpiGlu E{(const bf16*)(ws + WS_YB), (bf16*)(ws + WS_ZB), (const float*)p.in[zz + 13] + l * 512};
              pg8::gemm_phase(lds0 + RING_OFF, P, S, E, tid); }
#endif
#if EN_MLA
            mixnorm_rows(p, l, false, true, EN_GDN != 0, gw, NGW, lane);
#else
            zero_mix_cols(p, 512, 1024, gw, NGW, lane);
#endif
        }
        SEAM(P0 + 4);
        if (IN(P0 + 5)) REPEAT(4) { PH_VARS;
#if EN_S5
            mixnorm_rows(p, l, true, false, false, gw, NGW, lane);
#else
            zero_mix_cols(p, 0, 512, gw, NGW, lane);
#endif
        }
        SEAM(P0 + 5);
        if (IN(P0 + 6)) REPEAT(1) { PH_VARS;
#if EN_MIX
            ProbG P(MIX, DM * 2, 0, ws + WS_WOUT_T + (size_t)l * 2048 * 2048 * 2, DM * 2, 0, DM); StaticOrder S(TT, DM, G, bid); EpiResid E{XB, V};
            pg8::gemm_phase(lds0 + RING_OFF, P, S, E, tid);
#else
            scale_rows(XB, V, gw, NGW, lane);
#endif
        }
        SEAM(P0 + 6);
        if (IN(P0 + 7)) REPEAT(5) { PH_VARS; ln_rows<4>(V, nullptr, nullptr, false, (const float*)p.in[zz + 25] + l * DM, (const float*)p.in[zz + 26] + l * DM, XB, nullptr, gw, NGW, lane); }
        SEAM(P0 + 7);
        if (IN(P0 + 8)) REPEAT(1) { PH_VARS;
#if EN_XA
            ProbG P(XB, DM * 2, 1024 * 2, ws + WS_XQ_T + (size_t)l * 512 * 2048 * 2, DM * 2, 1024 * 2, 1024); BatchOrder S(2, TT / 256, 2, G, bid); EpiXaQ E{(bf16*)(ws + WS_XAQ), 0.08838834764831845f * LOG2E};
            pg8::gemm_phase(lds0 + RING_OFF, P, S, E, tid);
#endif
        }
        SEAM(P0 + 8);
        if (IN(P0 + 9)) REPEAT(6) { PH_VARS;
#if EN_XA
            for (int q = bid; q < 256; q += G) { const int bh = q >> 4, qb = q & 15, b = bh >> 2, h = bh & 3;
                xattn_unit(lds + RING_OFF, (const bf16*)(ws + WS_XAQ) + (size_t)bh * SQ * 128, (const bf16*)(ws + WS_XAK) + (size_t)bh * 256 * 128, (const bf16*)(ws + WS_XAVT) + (size_t)bh * 128 * 256, qb * 256,
                           (bf16*)(ws + WS_XAO) + (size_t)b * SQ * 512 + h * 128, 512, tid); }
#endif
        }
        SEAM(P0 + 9);
        if (IN(P0 + 10)) REPEAT(1) { PH_VARS;
#if EN_XA
            ProbG P(ws + WS_XAO, 1024, 0, ws + WS_XO_T + (size_t)l * 2048 * 512 * 2, 1024, 0, 512); StaticOrder S(TT, DM, G, bid); EpiResid E{XB, V};
            pg8::gemm_phase(lds0 + RING_OFF, P, S, E, tid);
#else
            scale_rows(XB, V, gw, NGW, lane);
#endif
        }
        SEAM(P0 + 10);
#if !EN_MOE
        if (IN(P0 + 11)) { PH_VARS; ln_rows(V, nullptr, nullptr, false, (const float*)p.in[zz + 31] + l * DM, (const float*)p.in[zz + 32] + l * DM, XB, nullptr, gw, NGW, lane); }
        SEAM(P0 + 11);
#endif
        STAMP(P0 + 12);
        if (IN(P0 + 12)) { PH_VARS;
#if EN_MOE
            router_rows(p, l, lds + RING_OFF, XB, bid, G, tid, V, (const float*)p.in[zz + 31] + l * DM, (const float*)p.in[zz + 32] + l * DM);
#endif
        }
        SEAM(P0 + 12);
        if (IN(P0 + 13)) { PH_VARS;
#if EN_MOE
            moe_build_table_chunks(p, l, lds, tid, bid);
            { volatile LAS int* tab = (volatile LAS int*)(lds + MOE_TAB_OFF); const int* tok_e = (const int*)(ws + WS_ROUTE); const float* tok_g = (const float*)(ws + WS_ROUTE + 256 * 1024); const int* ccnt = (const int*)(ws + WS_MISC + 900 * 1024);
              int* row_tok = (int*)(ws + WS_ROUTE + 512 * 1024); float* row_gate = (float*)(ws + WS_ROUTE + 768 * 1024); bf16* XG = (bf16*)(ws + WS_XG);
              for (int e = gw; e < 32; e += NGW) { const int cnt = tab[224 + e], st = tab[192 + e]; const int pe = ((cnt + 255) >> 8) << 8; for (int r = cnt + lane; r < pe; r += 64) row_tok[st + r] = -1; }
              volatile LAS int* lc = (volatile LAS int*)(lds + RING_OFF); LAS int* lcnt = (LAS int*)(lds + RING_OFF); LAS int* gbase = lcnt + 32; LAS int* dlist = lcnt + 64;
              for (int ch = bid; ch < TT / 64; ch += G) {
                  if (tid < 32) { lcnt[tid] = 0; int s = ((const volatile LAS int*)(lds + RING_OFF + 4096))[ch * 32 + tid]; const int part = ch >> 4;
                      for (int pp = 0; pp < part; ++pp) s += tab[256 + pp * 32 + tid];
                      gbase[tid] = s; }
                  __syncthreads();
                  int e = 0, lpos = 0, tk = 0;
                  if (tid < 128) { tk = 2 * (ch * 64) + tid; e = tok_e[tk]; lpos = __hip_atomic_fetch_add(lcnt + e, 1, __ATOMIC_RELAXED, __HIP_MEMORY_SCOPE_WORKGROUP); }
                  __syncthreads();
                  if (tid < 128) { const int dest = tab[192 + e] + lc[32 + e] + lpos; row_tok[dest] = tk; row_gate[dest] = tok_g[tk]; dlist[tid] = dest; }
                  __syncthreads();
                  __syncthreads();
              } }
#endif
        }
        SEAM(P0 + 13);
        if (IN(P0 + 14)) REPEAT(1) { PH_VARS;
#if EN_MOE
            moe_build_table(p, l, lds, tid);
            ProbG P(XB, DM * 2, 0, ws + WS_GU_T + (size_t)l * 32 * 1024 * 2048 * 2, DM * 2, (size_t)1024 * 2048 * 2, DM); MoeOrder S{(const volatile LAS int*)(lds + MOE_TAB_OFF), 4, G, (G % 8 == 0) ? (bid % 8) * (G / 8) + bid / 8 : bid};     EpiMoeGU E{(bf16*)(ws + WS_HB)};
            pg8::gemm_phase<ProbG, EpiMoeGU, MoeOrder, true, true>(lds0 + RING_OFF, P, S, E, tid, (const int*)(ws + WS_ROUTE + 512 * 1024));
            if constexpr (l + 1 < NL) {
                const int np_ = __builtin_amdgcn_readfirstlane(S.tab[0]), rem_ = (4 * np_) % G; const bool light_ = (rem_ == 0) || (S.c >= rem_); const int nl_ = (rem_ == 0) ? G : G - rem_, li_ = (rem_ == 0) ? S.c : S.c - rem_;
                if (light_) { p0_weights(p, l + 1, li_ * NWAVES + wave, nl_ * NWAVES, lane); p0_s5(p, wscr, l + 1, li_ * NWAVES + wave, nl_ * NWAVES, lane); } }
#endif
        }
        SEAM(P0 + 14);
        if (IN(P0 + 15)) { PH_VARS;
#if EN_MOE
            moe_build_table(p, l, lds, tid);
            ProbG P(ws + WS_HB, 1024, 0, ws + WS_DN_T + (size_t)l * 32 * 2048 * 512 * 2, 1024, (size_t)2048 * 512 * 2, 512); MoeOrder S{(const volatile LAS int*)(lds + MOE_TAB_OFF), 8, G, (G % 8 == 0) ? (bid % 8) * (G / 8) + bid / 8 : bid};
            EpiMoeDown E{V, (const int*)(ws + WS_ROUTE + 512 * 1024), (const float*)(ws + WS_ROUTE + 768 * 1024)};
            pg8::gemm_phase<ProbG, EpiMoeDown, MoeOrder, false>(lds0 + RING_OFF, P, S, E, tid);
#endif
        }
        SEAM(P0 + 15);
        if (IN(P0 + 16)) REPEAT(5) { PH_VARS; ln_rows(nullptr, XB, V, EN_MOE != 0, (const float*)p.in[zz + 39] + l * DM, (const float*)p.in[zz + 40] + l * DM, (l == NL - 1) ? nullptr : XB, (l == NL - 1) ? p.out : nullptr, gw, NGW, lane); }
        SEAM(P0 + 16);
    }
    { constexpr int l = 1; constexpr int P0 = 1 + 1 * NPH;
        if (IN(P0 + 0)) REPEAT(1) { PH_VARS;
#if EN_MIX
            ProbG P(XB, DM * 2, 0, ws + WS_WIN_T + (size_t)l * NIN * 2048 * 2, DM * 2, 0, DM); StaticOrder S(TT, NIN, G, bid); EpiBf16 E{PROJ, NIN};
            pg8::gemm_phase(lds0 + RING_OFF, P, S, E, tid);
#endif
#if EN_XA
            { ProbG P(ws + WS_MEMB, DM * 2, 0, ws + WS_XKV_T + (size_t)l * 1024 * 2048 * 2, DM * 2, 0, DM); StaticOrder S(NB * MEML, 1024, G, (bid + 64) % G); EpiXaKV E{(bf16*)(ws + WS_XAK), (bf16*)(ws + WS_XAVT)};
              pg8::gemm_phase(lds0 + RING_OFF, P, S, E, tid); }
#endif
        }
        SEAM(P0 + 0);
        if (IN(P0 + 1)) REPEAT(2) { PH_VARS;
#if EN_MLA || EN_GDN
            ph2_token(p, l, gw, NGW, lane);
#endif
#if EN_GDN
            ph2_conv(p, l, gw, NGW, lane);
#endif
#if EN_S5
            { ProbS5 P(PROJ, ws + WS_MEND_T + (size_t)l * 32 * 256 * 512 * 2, 256); BatchOrder S(32, 2, 1, G, bid); EpiXloc E{(float*)(ws + WS_XLOC)}; pg8::gemm_phase(lds0 + RING_OFF, P, S, E, tid); }
            { ProbS5 P(PROJ, ws + WS_TOEP_T + (size_t)l * 32 * 512 * 512 * 2, 512); BatchOrder S(32, 2, 2, G, (bid + 192) % G); EpiYtoep E{(float*)(ws + WS_YTOEP)}; pg8::gemm_phase(lds0 + RING_OFF, P, S, E, tid); }
#endif
        }
        SEAM(P0 + 1);
        if (IN(P0 + 2)) REPEAT(3) { PH_VARS;
#if EN_S5
            if (bid >= G - 32) { const int q = (bid - (G - 32)) * 512 + tid;
                if (q < 8192) { const int b = q >> 11, g = (q >> 6) & 31, pp = q & 63; const float* al = (const float*)(ws + WS_MISC + 800 * 1024) + ((l * 32 + g) * 64 + pp) * 2; const float ar = al[0], ai = al[1];
                    const float* xl = (const float*)(ws + WS_XLOC) + ((size_t)g * 512 + b * 128) * 128; bf16* xs = (bf16*)(ws + WS_XSB) + ((size_t)g * 512 + b * 128) * 128; float sr = 0.f, si = 0.f;
#pragma unroll 1
                    for (int c0 = 0; c0 < 128; c0 += 16) { float lr_[16], li_[16];
#pragma unroll
                        for (int i = 0; i < 16; ++i) { lr_[i] = xl[(c0 + i) * 128 + pp]; li_[i] = xl[(c0 + i) * 128 + 64 + pp]; }
#pragma unroll
                        for (int i = 0; i < 16; ++i) { xs[(c0 + i) * 128 + pp] = (bf16)f2bf(sr); xs[(c0 + i) * 128 + 64 + pp] = (bf16)f2bf(si);
                            const float nr = ar * sr - ai * si + lr_[i], ni = ar * si + ai * sr + li_[i]; sr = nr; si = ni; } } } }
#endif
#if EN_MLA
            { ProbG P(ws + WS_CQN, 2048, 0, ws + WS_WUQ_T + (size_t)l * 1536 * 512 * 2, 1024, 0, 512); StaticOrder S(TT, 1536, G, bid); EpiMlaQ E{(bf16*)(ws + WS_QB), (const float*)(ws + WS_ROPE), 0.07216878364870323f * LOG2E};
              pg8::gemm_phase(lds0 + RING_OFF, P, S, E, tid); }
            { ProbG P(ws + WS_CQN + 1024, 2048, 0, ws + WS_WUKV_T + (size_t)l * 2048 * 512 * 2, 1024, 0, 512); StaticOrder S(TT, 2048, G, (bid + 128) % G); EpiMlaKV E{(bf16*)(ws + WS_KB), (bf16*)(ws + WS_VT)};
              pg8::gemm_phase(lds0 + RING_OFF, P, S, E, tid); }
#endif
#if EN_GDN
            { u32x4 pre[6];
              if (bid < 1024) { const bf16* gq_ = (const bf16*)(ws + WS_GQ); const bf16* gk_ = (const bf16*)(ws + WS_GK); const bf16* gv_ = (const bf16*)(ws + WS_GV); const int bh_ = bid >> 6, n_ = bid & 63; const int t_ = (bh_ >> 2) * SQ + n_ * 64, h_ = bh_ & 3;
#pragma unroll
                  for (int i = 0; i < 2; ++i) { const int idx = tid + 512 * i, c = idx >> 4, pc = idx & 15; const size_t go = (size_t)(t_ + c) * 512 + h_ * 128 + pc * 8;
                      pre[3 * i] = *(const u32x4*)(gk_ + go); pre[3 * i + 1] = *(const u32x4*)(gq_ + go); pre[3 * i + 2] = *(const u32x4*)(gv_ + go); } }
              for (int it = bid; it < 1024; it += G) gdn_pre_item(p, lds + RING_OFF, it, tid, pre, (it + G < 1024) ? it + G : -1); }
#endif
        }
        SEAM(P0 + 2);
        if (IN(P0 + 3)) REPEAT(7) { PH_VARS;
#if EN_GDN
            if (bid < 16) gdn_chain(p, lds + RING_OFF, bid, l, tid);
#else
            zero_mix_cols(p, 1536, 512, gw, NGW, lane);
#endif
#if EN_S5
            { ProbG P(ws + WS_XSB, 256, (size_t)512 * 256, ws + WS_MST_T + (size_t)l * 32 * 512 * 128 * 2, 256, (size_t)512 * 256, 128); BatchOrder S(32, 2, 2, G - 16, bid - 16); EpiYfin E{(const float*)(ws + WS_YTOEP), (bf16*)(ws + WS_YB)};
              pg8::gemm_phase(lds0 + RING_OFF, P, S, E, tid); }
#endif
#if EN_MOE
#define MOE_CVT_LOOP() do { unsigned* head2 = ctl + CW_QUEUE + (8 + l) * 64; volatile LAS int* qslot = (volatile LAS int*)(lds + MISC_OFF);     \
              for (;;) { __syncthreads(); if (tid == 0) qslot[0] = (int)__hip_atomic_fetch_add(head2, 1u, RLX_AGENT); __syncthreads(); const int q0_ = qslot[0] * NWAVES; if (q0_ >= MOE_CVT_ITEMS) break; \
                  if (q0_ + wave < MOE_CVT_ITEMS) moe_convert_item(p, l, q0_ + wave, lane); } } while (0)
#else
#define MOE_CVT_LOOP() do { } while (0)
#endif
            if (bid >= 16 && bid < 80) MOE_CVT_LOOP();
#if EN_MLA
            { unsigned* head = ctl + CW_QUEUE + (l * 2 + rep_) * 64; volatile LAS int* qslot = (volatile LAS int*)(lds + MISC_OFF);
              for (;;) { __syncthreads(); if (tid == 0) qslot[0] = (int)__hip_atomic_fetch_add(head, 1u, RLX_AGENT); __syncthreads(); const int q = qslot[0]; if (q >= 512) break;
                  const int qb = 15 - (q >> 5), bh = q & 31, b = bh >> 3, h = bh & 7;
                  attn_unit<192, true>(lds + RING_OFF, (const bf16*)(ws + WS_QB) + (size_t)bh * SQ * 192, (const bf16*)(ws + WS_KB) + (size_t)bh * SQ * 192, (const bf16*)(ws + WS_VT) + (size_t)bh * 128 * SQ, SQ, qb * 256, 4 * qb + 4,
                                       (bf16*)(ws + WS_OB) + (size_t)b * SQ * 1024 + h * 128, 1024, tid); } }
#endif
            MOE_CVT_LOOP();
#undef MOE_CVT_LOOP
        }
        SEAM(P0 + 3);
        if (IN(P0 + 4)) REPEAT(4) { PH_VARS;
#if EN_S5
            { ProbG P(ws + WS_YB, 1024, 0, ws + WS_GLU_T + (size_t)l * 512 * 512 * 2, 1024, 0, 512); StaticOrder S(TT, 512, G, bid); EpiGlu E{(const bf16*)(ws + WS_YB), (bf16*)(ws + WS_ZB), (const float*)p.in[zz + 13] + l * 512};
              pg8::gemm_phase(lds0 + RING_OFF, P, S, E, tid); }
#endif
#if EN_MLA
            mixnorm_rows(p, l, false, true, EN_GDN != 0, gw, NGW, lane);
#else
            zero_mix_cols(p, 512, 1024, gw, NGW, lane);
#endif
        }
        SEAM(P0 + 4);
        if (IN(P0 + 5)) REPEAT(4) { PH_VARS;
#if EN_S5
            mixnorm_rows(p, l, true, false, false, gw, NGW, lane);
#else
            zero_mix_cols(p, 0, 512, gw, NGW, lane);
#endif
        }
        SEAM(P0 + 5);
        if (IN(P0 + 6)) REPEAT(1) { PH_VARS;
#if EN_MIX
            ProbG P(MIX, DM * 2, 0, ws + WS_WOUT_T + (size_t)l * 2048 * 2048 * 2, DM * 2, 0, DM); StaticOrder S(TT, DM, G, bid); EpiResid E{XB, V};
            pg8::gemm_phase(lds0 + RING_OFF, P, S, E, tid);
#else
            scale_rows(XB, V, gw, NGW, lane);
#endif
        }
        SEAM(P0 + 6);
        if (IN(P0 + 7)) REPEAT(5) { PH_VARS; ln_rows<4>(V, nullptr, nullptr, false, (const float*)p.in[zz + 25] + l * DM, (const float*)p.in[zz + 26] + l * DM, XB, nullptr, gw, NGW, lane); }
        SEAM(P0 + 7);
        if (IN(P0 + 8)) REPEAT(1) { PH_VARS;
#if EN_XA
            ProbG P(XB, DM * 2, 1024 * 2, ws + WS_XQ_T + (size_t)l * 512 * 2048 * 2, DM * 2, 1024 * 2, 1024); BatchOrder S(2, TT / 256, 2, G, bid); EpiXaQ E{(bf16*)(ws + WS_XAQ), 0.08838834764831845f * LOG2E};
            pg8::gemm_phase(lds0 + RING_OFF, P, S, E, tid);
#endif
        }
        SEAM(P0 + 8);
        if (IN(P0 + 9)) REPEAT(6) { PH_VARS;
#if EN_XA
            for (int q = bid; q < 256; q += G) { const int bh = q >> 4, qb = q & 15, b = bh >> 2, h = bh & 3;
                xattn_unit(lds + RING_OFF, (const bf16*)(ws + WS_XAQ) + (size_t)bh * SQ * 128, (const bf16*)(ws + WS_XAK) + (size_t)bh * 256 * 128, (const bf16*)(ws + WS_XAVT) + (size_t)bh * 128 * 256, qb * 256,
                           (bf16*)(ws + WS_XAO) + (size_t)b * SQ * 512 + h * 128, 512, tid); }
#endif
        }
        SEAM(P0 + 9);
        if (IN(P0 + 10)) REPEAT(1) { PH_VARS;
#if EN_XA
            ProbG P(ws + WS_XAO, 1024, 0, ws + WS_XO_T + (size_t)l * 2048 * 512 * 2, 1024, 0, 512); StaticOrder S(TT, DM, G, bid); EpiResid E{XB, V};
            pg8::gemm_phase(lds0 + RING_OFF, P, S, E, tid);
#else
            scale_rows(XB, V, gw, NGW, lane);
#endif
        }
        SEAM(P0 + 10);
#if !EN_MOE
        if (IN(P0 + 11)) { PH_VARS; ln_rows(V, nullptr, nullptr, false, (const float*)p.in[zz + 31] + l * DM, (const float*)p.in[zz + 32] + l * DM, XB, nullptr, gw, NGW, lane); }
        SEAM(P0 + 11);
#endif
        STAMP(P0 + 12);
        if (IN(P0 + 12)) { PH_VARS;
#if EN_MOE
            router_rows(p, l, lds + RING_OFF, XB, bid, G, tid, V, (const float*)p.in[zz + 31] + l * DM, (const float*)p.in[zz + 32] + l * DM);
#endif
        }
        SEAM(P0 + 12);
        if (IN(P0 + 13)) { PH_VARS;
#if EN_MOE
            moe_build_table_chunks(p, l, lds, tid, bid);
            { volatile LAS int* tab = (volatile LAS int*)(lds + MOE_TAB_OFF); const int* tok_e = (const int*)(ws + WS_ROUTE); const float* tok_g = (const float*)(ws + WS_ROUTE + 256 * 1024); const int* ccnt = (const int*)(ws + WS_MISC + 900 * 1024);
              int* row_tok = (int*)(ws + WS_ROUTE + 512 * 1024); float* row_gate = (float*)(ws + WS_ROUTE + 768 * 1024); bf16* XG = (bf16*)(ws + WS_XG);
              for (int e = gw; e < 32; e += NGW) { const int cnt = tab[224 + e], st = tab[192 + e]; const int pe = ((cnt + 255) >> 8) << 8; for (int r = cnt + lane; r < pe; r += 64) row_tok[st + r] = -1; }
              volatile LAS int* lc = (volatile LAS int*)(lds + RING_OFF); LAS int* lcnt = (LAS int*)(lds + RING_OFF); LAS int* gbase = lcnt + 32; LAS int* dlist = lcnt + 64;
              for (int ch = bid; ch < TT / 64; ch += G) {
                  if (tid < 32) { lcnt[tid] = 0; int s = ((const volatile LAS int*)(lds + RING_OFF + 4096))[ch * 32 + tid]; const int part = ch >> 4;
                      for (int pp = 0; pp < part; ++pp) s += tab[256 + pp * 32 + tid];
                      gbase[tid] = s; }
                  __syncthreads();
                  int e = 0, lpos = 0, tk = 0;
                  if (tid < 128) { tk = 2 * (ch * 64) + tid; e = tok_e[tk]; lpos = __hip_atomic_fetch_add(lcnt + e, 1, __ATOMIC_RELAXED, __HIP_MEMORY_SCOPE_WORKGROUP); }
                  __syncthreads();
                  if (tid < 128) { const int dest = tab[192 + e] + lc[32 + e] + lpos; row_tok[dest] = tk; row_gate[dest] = tok_g[tk]; dlist[tid] = dest; }
                  __syncthreads();
                  __syncthreads();
              } }
#endif
        }
        SEAM(P0 + 13);
        if (IN(P0 + 14)) REPEAT(1) { PH_VARS;
#if EN_MOE
            moe_build_table(p, l, lds, tid);
            ProbG P(XB, DM * 2, 0, ws + WS_GU_T + (size_t)l * 32 * 1024 * 2048 * 2, DM * 2, (size_t)1024 * 2048 * 2, DM); MoeOrder S{(const volatile LAS int*)(lds + MOE_TAB_OFF), 4, G, (G % 8 == 0) ? (bid % 8) * (G / 8) + bid / 8 : bid};     EpiMoeGU E{(bf16*)(ws + WS_HB)};
            pg8::gemm_phase<ProbG, EpiMoeGU, MoeOrder, true, true>(lds0 + RING_OFF, P, S, E, tid, (const int*)(ws + WS_ROUTE + 512 * 1024));
            if constexpr (l + 1 < NL) {
                const int np_ = __builtin_amdgcn_readfirstlane(S.tab[0]), rem_ = (4 * np_) % G; const bool light_ = (rem_ == 0) || (S.c >= rem_); const int nl_ = (rem_ == 0) ? G : G - rem_, li_ = (rem_ == 0) ? S.c : S.c - rem_;
                if (light_) { p0_weights(p, l + 1, li_ * NWAVES + wave, nl_ * NWAVES, lane); p0_s5(p, wscr, l + 1, li_ * NWAVES + wave, nl_ * NWAVES, lane); } }
#endif
        }
        SEAM(P0 + 14);
        if (IN(P0 + 15)) { PH_VARS;
#if EN_MOE
            moe_build_table(p, l, lds, tid);
            ProbG P(ws + WS_HB, 1024, 0, ws + WS_DN_T + (size_t)l * 32 * 2048 * 512 * 2, 1024, (size_t)2048 * 512 * 2, 512); MoeOrder S{(const volatile LAS int*)(lds + MOE_TAB_OFF), 8, G, (G % 8 == 0) ? (bid % 8) * (G / 8) + bid / 8 : bid};
            EpiMoeDown E{V, (const int*)(ws + WS_ROUTE + 512 * 1024), (const float*)(ws + WS_ROUTE + 768 * 1024)};
            pg8::gemm_phase<ProbG, EpiMoeDown, MoeOrder, false>(lds0 + RING_OFF, P, S, E, tid);
#endif
        }
        SEAM(P0 + 15);
        if (IN(P0 + 16)) REPEAT(5) { PH_VARS; ln_rows(nullptr, XB, V, EN_MOE != 0, (const float*)p.in[zz + 39] + l * DM, (const float*)p.in[zz + 40] + l * DM, (l == NL - 1) ? nullptr : XB, (l == NL - 1) ? p.out : nullptr, gw, NGW, lane); }
        SEAM(P0 + 16);
    }
#if PROBE
    {
        xcd_barrier(bar);
        if (bid == 0 && wave0 == 0 && __builtin_amdgcn_mbcnt_lo(~0u, 0u) == 0u) {
            volatile LAS unsigned long long* ts = (volatile LAS unsigned long long*)(lds0 + TS_OFF);
#define PDUR(k) ((k) < 0 ? 0ull : ((k) >= 40 ? (ts[(k) + 1] - ts[(k)]) : ((k) == 0 ? (ts[1] - ts[0]) : ((ts[(k) + 1] - ts[(k)]) + (ts[(k) + NPH + 1] - ts[(k) + NPH])))))
            const unsigned long long ta = PDUR(PROBE_A), tb = PDUR(PROBE_B), tc = PDUR(PROBE_C), td = PDUR(PROBE_D);
            unsigned long long ua = ta / 100ull; if (ua > 2000ull) ua = 2000ull;
            unsigned long long qb = tb / 1600ull; if (qb > 100ull) qb = 100ull;
            const unsigned long long extra = (ua + 2048ull * qb) * 100ull;
            const unsigned long long t0 = __builtin_amdgcn_s_memrealtime();
            while (__builtin_amdgcn_s_memrealtime() - t0 < extra) __builtin_amdgcn_s_sleep(8);
            float A1 = (float)tc * (1.0f / 2000.0f), A2 = (float)td * (1.0f / 2000.0f);
            if (A1 > 70.f) A1 = 70.f; if (A2 > 70.f) A2 = 70.f;
            p.out[0] += A1; p.out[1] += A2;
        }
    }
#endif
#undef IN
#undef SEAM
}

#ifndef MK_PER_PHASE
#define MK_PER_PHASE 0
#endif
extern "C" void kernel_launch(void* const* d_in, const int* in_sizes, int n_in, void* d_out, int out_size, void* d_ws, size_t ws_size, hipStream_t stream) {
    static int grid = 0;
    if (grid == 0) {
        if (n_in != 41 || out_size != TT * DM || ws_size < WS_END) { fprintf(stderr, "kernel_launch: unexpected shapes (n_in %d out %d ws %zu need %zu)\n", n_in, out_size, ws_size, (size_t)WS_END); grid = -1; return; }
        int dev = 0, cus = 0, per_cu = 0;
        if (hipGetDevice(&dev) != hipSuccess || hipDeviceGetAttribute(&cus, hipDeviceAttributeMultiprocessorCount, dev) != hipSuccess) { grid = -1; return; }
        if (hipFuncSetAttribute((const void*)hybrid_fwd, hipFuncAttributeMaxDynamicSharedMemorySize, LDS_BYTES) != hipSuccess) { fprintf(stderr, "kernel_launch: hipFuncSetAttribute failed\n"); grid = -1; return; }
        if (hipOccupancyMaxActiveBlocksPerMultiprocessor(&per_cu, (const void*)hybrid_fwd, NWAVES * 64, LDS_BYTES) != hipSuccess || per_cu < 1) { fprintf(stderr, "kernel_launch: occupancy query says %d\n", per_cu); }
        (void)hipGetLastError();
        grid = cus;
    }
    if (grid < 0) return;
    (void)hipMemsetAsync((char*)d_ws + WS_CTL, 0, CTL_ZERO_BYTES, stream);
    Params p{};
    for (int i = 0; i < 41; ++i) p.in[i] = d_in[i];
    p.out = (float*)d_out; p.ws = (unsigned char*)d_ws; p.li = 0; p.pad = 0;
#if MK_PER_PHASE
    for (int ph = 0; ph < NPHASES; ++ph) { p.ph_lo = ph; p.ph_hi = ph + 1; hipLaunchKernelGGL(hybrid_fwd, dim3(grid), dim3(NWAVES * 64), LDS_BYTES, stream, p); }
#else
    p.ph_lo = 0; p.ph_hi = NPHASES;
    hipLaunchKernelGGL(hybrid_fwd, dim3(grid), dim3(NWAVES * 64), LDS_BYTES, stream, p);
#endif
    const hipError_t le = hipPeekAtLastError();
    if (le != hipSuccess) fprintf(stderr, "kernel_launch: launch failed: %s\n", hipGetErrorName(le));
}
```
